# Optimizing an MI355X kernel written in HIP

```python
import math
import jax, jax.numpy as jnp
from jax import lax
import numpy as np

D_MODEL = 1024
BATCH = 2
SEQ = 8192
DEPTH = 2

GRID_W = 64
CTX_LEN = 256

S5_WIDTH = 512
S5_GROUP_CH = 16
S5_GROUPS = S5_WIDTH // S5_GROUP_CH
S5_STATE = 64
S5_DT_MIN = 0.001
S5_DT_MAX = 0.1
SG_WIDTH = 512
SG_HEADS = 8
SG_CHUNK = 128
N_HEADS = 16
N_KV_HEADS = 4
HEAD_DIM = 64
WINDOW = 128
ATT_BLOCK = 128
ROPE_BASE = 10000.0
NEG_INF = -1e30

LN_EPS = 1e-5
DEEPNORM_ALPHA = (2 * DEPTH) ** 0.25
DEEPNORM_BETA = (8 * DEPTH) ** -0.25

EVEN_IN_WIDTH = 2 * S5_WIDTH + 3 * SG_WIDTH
EVEN_MIX_WIDTH = S5_WIDTH + SG_WIDTH
ODD_IN_WIDTH = 2 * N_HEADS * HEAD_DIM + 2 * N_KV_HEADS * HEAD_DIM
ODD_MIX_WIDTH = N_HEADS * HEAD_DIM
N_EVEN = (DEPTH + 1) // 2
N_ODD = DEPTH // 2

kernel_name = "hybrid_s5_gmlp_swa_prefix_dit"


def _layer_norm(x, g, b):
    xf = x.astype(jnp.float32)
    mu = jnp.mean(xf, axis=-1, keepdims=True)
    var = jnp.mean(jnp.square(xf - mu), axis=-1, keepdims=True)
    y = (xf - mu) * lax.rsqrt(var + LN_EPS) * g.astype(jnp.float32) + b.astype(jnp.float32)
    return y.astype(x.dtype)


def _flip_segments(a, n_ctx):
    return jnp.concatenate([a[:, :n_ctx][:, ::-1], a[:, n_ctx:][:, ::-1]], axis=1)


def _s5_scan(u, lam_re, lam_im, log_dt, b_re, b_im, c_re, c_im):
    dt = jnp.exp(log_dt)[:, None]
    mag = jnp.exp(lam_re * dt)
    ang = lam_im * dt
    a_re = mag * jnp.cos(ang)
    a_im = mag * jnp.sin(ang)
    den = lam_re * lam_re + lam_im * lam_im
    nr = a_re - 1.0
    ni = a_im
    f_re = (nr * lam_re + ni * lam_im) / den
    f_im = (ni * lam_re - nr * lam_im) / den
    bb_re = f_re[..., None] * b_re - f_im[..., None] * b_im
    bb_im = f_re[..., None] * b_im + f_im[..., None] * b_re
    bu_re = jnp.einsum('bngh,gph->bngp', u, bb_re)
    bu_im = jnp.einsum('bngh,gph->bngp', u, bb_im)
    ar = jnp.broadcast_to(a_re, bu_re.shape)
    ai = jnp.broadcast_to(a_im, bu_re.shape)

    def combine(e1, e2):
        a1r, a1i, b1r, b1i = e1
        a2r, a2i, b2r, b2i = e2
        return (a2r * a1r - a2i * a1i,
                a2r * a1i + a2i * a1r,
                a2r * b1r - a2i * b1i + b2r,
                a2r * b1i + a2i * b1r + b2i)

    _, _, s_re, s_im = lax.associative_scan(combine, (ar, ai, bu_re, bu_im), axis=1)
    return (jnp.einsum('bngp,ghp->bngh', s_re, c_re)
            - jnp.einsum('bngp,ghp->bngh', s_im, c_im))


def _s5_bidirectional(xa, n_ctx, lam_re, lam_im, log_dt, b_re, b_im, c_re, c_im, d_skip):
    bsz, n, w = xa.shape
    f = lambda t: t.astype(jnp.float32)
    u = f(xa).reshape(bsz, n, S5_GROUPS, S5_GROUP_CH)
    y_fwd = _s5_scan(u, f(lam_re[0]), f(lam_im[0]), f(log_dt[0]),
                     f(b_re[0]), f(b_im[0]), f(c_re[0]), f(c_im[0]))
    y_bwd = _flip_segments(
        _s5_scan(_flip_segments(u, n_ctx), f(lam_re[1]), f(lam_im[1]), f(log_dt[1]),
                 f(b_re[1]), f(b_im[1]), f(c_re[1]), f(c_im[1])), n_ctx)
    y = y_fwd + y_bwd + f(d_skip).reshape(S5_GROUPS, S5_GROUP_CH) * u
    return y.reshape(bsz, n, w).astype(xa.dtype)


def _spatial_gate(u, v, ln_g, ln_b, w_s, b_s):
    bsz, n, w = v.shape
    vn = _layer_norm(v, ln_g, ln_b)
    vc = vn.reshape(bsz, n // SG_CHUNK, SG_CHUNK, SG_HEADS, w // SG_HEADS)
    s = jnp.einsum('hqk,bckhd->bcqhd', w_s, vc) + jnp.transpose(b_s)[None, None, :, :, None]
    return u * s.reshape(bsz, n, w)


def _even_mixer(h, n_ctx, w_in, w_out, lam_re, lam_im, log_dt, b_re, b_im, c_re, c_im,
                d_skip, glu_w, glu_b, sg_ln_g, sg_ln_b, sg_w, sg_b):
    p = h @ w_in
    xa, ga, u, v, gb = jnp.split(
        p, [S5_WIDTH, 2 * S5_WIDTH, 2 * S5_WIDTH + SG_WIDTH, 2 * S5_WIDTH + 2 * SG_WIDTH], axis=-1)
    ya = _s5_bidirectional(xa, n_ctx, lam_re, lam_im, log_dt, b_re, b_im, c_re, c_im, d_skip)
    ya = jax.nn.gelu(ya)
    ya = ya * jax.nn.sigmoid(ya @ glu_w + glu_b)
    ya = ya * jax.nn.silu(ga)
    yb = _spatial_gate(u, v, sg_ln_g, sg_ln_b, sg_w, sg_b) * jax.nn.silu(gb)
    return jnp.concatenate([ya, yb], axis=-1) @ w_out


def _axial_rope(t, row_pos, col_pos):
    half = HEAD_DIM // 2
    nf = half // 2
    inv = ROPE_BASE ** (-jnp.arange(nf, dtype=jnp.float32) / nf)

    def rot(xh, pos):
        ang = pos.astype(jnp.float32)[:, None] * inv[None, :]
        cos = jnp.cos(ang)[None, :, None, :]
        sin = jnp.sin(ang)[None, :, None, :]
        x1, x2 = xh[..., :nf], xh[..., nf:]
        return jnp.concatenate([x1 * cos - x2 * sin, x2 * cos + x1 * sin], axis=-1)

    tf = t.astype(jnp.float32)
    out = jnp.concatenate([rot(tf[..., :half], row_pos), rot(tf[..., half:], col_pos)], axis=-1)
    return out.astype(t.dtype)


def _softmax_with_sink(logits, sink):
    full = jnp.concatenate([logits, jnp.broadcast_to(sink, logits.shape[:-1] + (1,))], axis=-1)
    return jax.nn.softmax(full, axis=-1)[..., :-1]


def _window_attention(q, k, v, sink, n_ctx):
    bsz, n, _, _ = q.shape
    n_lat = n - n_ctx
    grp = N_HEADS // N_KV_HEADS
    q = (q * (HEAD_DIM ** -0.5)).reshape(bsz, n, N_KV_HEADS, grp, HEAD_DIM)
    qc, ql = q[:, :n_ctx], q[:, n_ctx:]
    kc, kl = k[:, :n_ctx], k[:, n_ctx:]
    vc, vl = v[:, :n_ctx], v[:, n_ctx:]
    sink_f = sink.astype(jnp.float32).reshape(N_KV_HEADS, grp)[None, :, :, None, None]

    lc = jnp.einsum('bqhgd,bshd->bhgqs', qc, kc, preferred_element_type=jnp.float32)
    pc = _softmax_with_sink(lc, sink_f)
    oc = jnp.einsum('bhgqs,bshd->bqhgd', pc.astype(vc.dtype), vc)

    nblk = n_lat // ATT_BLOCK
    qb = jnp.moveaxis(ql.reshape(bsz, nblk, ATT_BLOCK, N_KV_HEADS, grp, HEAD_DIM), 1, 0)

    def windows(t):
        tp = jnp.pad(t, ((0, 0), (ATT_BLOCK, ATT_BLOCK), (0, 0), (0, 0)))
        tp = tp.reshape(bsz, nblk + 2, ATT_BLOCK, N_KV_HEADS, HEAD_DIM)
        tw = jnp.concatenate([tp[:, :-2], tp[:, 1:-1], tp[:, 2:]], axis=2)
        return jnp.moveaxis(tw, 1, 0)

    kw, vw = windows(kl), windows(vl)
    offs_q = jnp.arange(ATT_BLOCK)
    offs_k = jnp.arange(3 * ATT_BLOCK) - ATT_BLOCK
    rel_ok = jnp.abs(offs_k[None, :] - offs_q[:, None]) <= WINDOW

    def block(args):
        qi, ki, vi, bi = args
        kpos = bi * ATT_BLOCK + offs_k
        ok = rel_ok & ((kpos >= 0) & (kpos < n_lat))[None, :]
        ll = jnp.einsum('bqhgd,bshd->bhgqs', qi, ki, preferred_element_type=jnp.float32)
        ll = jnp.where(ok, ll, NEG_INF)
        lx = jnp.einsum('bqhgd,bshd->bhgqs', qi, kc, preferred_element_type=jnp.float32)
        p = _softmax_with_sink(jnp.concatenate([ll, lx], axis=-1), sink_f)
        pl = p[..., :3 * ATT_BLOCK].astype(vi.dtype)
        px = p[..., 3 * ATT_BLOCK:].astype(vc.dtype)
        return (jnp.einsum('bhgqs,bshd->bqhgd', pl, vi)
                + jnp.einsum('bhgqs,bshd->bqhgd', px, vc))

    ob = lax.map(block, (qb, kw, vw, jnp.arange(nblk)))
    ol = jnp.moveaxis(ob, 0, 1).reshape(bsz, n_lat, N_HEADS * HEAD_DIM)
    return jnp.concatenate([oc.reshape(bsz, n_ctx, N_HEADS * HEAD_DIM), ol], axis=1)


def _odd_mixer(h, n_ctx, row_pos, col_pos, w_in, w_out, sink):
    bsz, n, _ = h.shape
    dq = N_HEADS * HEAD_DIM
    dkv = N_KV_HEADS * HEAD_DIM
    p = h @ w_in
    q, k, v, g = jnp.split(p, [dq, dq + dkv, dq + 2 * dkv], axis=-1)
    q = q.reshape(bsz, n, N_HEADS, HEAD_DIM)
    k = k.reshape(bsz, n, N_KV_HEADS, HEAD_DIM)
    v = v.reshape(bsz, n, N_KV_HEADS, HEAD_DIM)
    q = jnp.concatenate([q[:, :n_ctx], _axial_rope(q[:, n_ctx:], row_pos, col_pos)], axis=1)
    k = jnp.concatenate([k[:, :n_ctx], _axial_rope(k[:, n_ctx:], row_pos, col_pos)], axis=1)
    o = _window_attention(q, k, v, sink, n_ctx)
    return (o * jax.nn.silu(g)) @ w_out


def setup_inputs(seed: int = 0) -> dict:
    key = jax.random.key(seed)
    ks = jax.random.split(key, 32)
    f32 = jnp.float32

    def nrm(k, shape, scale):
        return scale * jax.random.normal(k, shape, f32)

    D = D_MODEL
    lam_im_base = jnp.pi * jnp.arange(S5_STATE, dtype=f32)
    return {
        "x": nrm(ks[0], (BATCH, SEQ, D), 1.0),
        "c": nrm(ks[1], (BATCH, D), 1.0),
        "ctx": nrm(ks[2], (BATCH, CTX_LEN, D), 1.0),
        "c_ctx": nrm(ks[3], (D,), 1.0),
        "mod_w": nrm(ks[4], (DEPTH, D, 3 * D), 0.5 * D ** -0.5),
        "mod_b": nrm(ks[5], (DEPTH, 3 * D), 0.01),
        "ln_g": 1.0 + nrm(ks[6], (DEPTH, D), 0.02),
        "ln_b": nrm(ks[7], (DEPTH, D), 0.02),
        "e_w_in": nrm(ks[8], (N_EVEN, D, EVEN_IN_WIDTH), D ** -0.5),
        "e_w_out": nrm(ks[9], (N_EVEN, EVEN_MIX_WIDTH, D), DEEPNORM_BETA * EVEN_MIX_WIDTH ** -0.5),
        "s5_lam_re": -0.5 + nrm(ks[10], (N_EVEN, 2, S5_GROUPS, S5_STATE), 0.01),
        "s5_lam_im": lam_im_base + nrm(ks[11], (N_EVEN, 2, S5_GROUPS, S5_STATE), 0.01),
        "s5_log_dt": jax.random.uniform(ks[12], (N_EVEN, 2, S5_GROUPS), f32,
                                        minval=math.log(S5_DT_MIN), maxval=math.log(S5_DT_MAX)),
        "s5_b_re": nrm(ks[13], (N_EVEN, 2, S5_GROUPS, S5_STATE, S5_GROUP_CH), (2 * S5_GROUP_CH) ** -0.5),
        "s5_b_im": nrm(ks[14], (N_EVEN, 2, S5_GROUPS, S5_STATE, S5_GROUP_CH), (2 * S5_GROUP_CH) ** -0.5),
        "s5_c_re": nrm(ks[15], (N_EVEN, 2, S5_GROUPS, S5_GROUP_CH, S5_STATE), S5_STATE ** -0.5),
        "s5_c_im": nrm(ks[16], (N_EVEN, 2, S5_GROUPS, S5_GROUP_CH, S5_STATE), S5_STATE ** -0.5),
        "s5_d": nrm(ks[17], (N_EVEN, S5_WIDTH), 1.0),
        "glu_w": nrm(ks[18], (N_EVEN, S5_WIDTH, S5_WIDTH), S5_WIDTH ** -0.5),
        "glu_b": nrm(ks[19], (N_EVEN, S5_WIDTH), 0.01),
        "sg_ln_g": 1.0 + nrm(ks[20], (N_EVEN, SG_WIDTH), 0.02),
        "sg_ln_b": nrm(ks[21], (N_EVEN, SG_WIDTH), 0.02),
        "sg_w": nrm(ks[22], (N_EVEN, SG_HEADS, SG_CHUNK, SG_CHUNK), 0.5 * SG_CHUNK ** -0.5),
        "sg_b": 1.0 + nrm(ks[23], (N_EVEN, SG_HEADS, SG_CHUNK), 0.1),
        "o_w_in": nrm(ks[24], (N_ODD, D, ODD_IN_WIDTH), D ** -0.5),
        "o_w_out": nrm(ks[25], (N_ODD, ODD_MIX_WIDTH, D), DEEPNORM_BETA * ODD_MIX_WIDTH ** -0.5),
        "o_sink": nrm(ks[26], (N_ODD, N_HEADS), 0.5),
    }


def reference(x, c, ctx, c_ctx, mod_w, mod_b, ln_g, ln_b, e_w_in, e_w_out,
              s5_lam_re, s5_lam_im, s5_log_dt, s5_b_re, s5_b_im, s5_c_re, s5_c_im, s5_d,
              glu_w, glu_b, sg_ln_g, sg_ln_b, sg_w, sg_b, o_w_in, o_w_out, o_sink):
    n_ctx = ctx.shape[1]
    n_lat = x.shape[1]
    ROWS = n_lat // GRID_W
    row_pos = jnp.repeat(jnp.arange(ROWS), GRID_W)
    col_pos = jnp.arange(ROWS * GRID_W) % GRID_W

    z = jnp.concatenate([ctx, x], axis=1)
    silu_c = jax.nn.silu(c)
    silu_cc = jax.nn.silu(c_ctx)
    for i in range(DEPTH):
        mod_l = silu_c @ mod_w[i] + mod_b[i]
        mod_c = silu_cc @ mod_w[i] + mod_b[i]
        sh_l, sc_l, g_l = jnp.split(mod_l, 3, axis=-1)
        sh_c, sc_c, g_c = jnp.split(mod_c, 3, axis=-1)
        h = jnp.concatenate([z[:, :n_ctx] * (1.0 + sc_c) + sh_c,
                             z[:, n_ctx:] * (1.0 + sc_l[:, None]) + sh_l[:, None]], axis=1)
        j = i // 2
        if i % 2 == 0:
            y = _even_mixer(h, n_ctx, e_w_in[j], e_w_out[j], s5_lam_re[j], s5_lam_im[j],
                            s5_log_dt[j], s5_b_re[j], s5_b_im[j], s5_c_re[j], s5_c_im[j],
                            s5_d[j], glu_w[j], glu_b[j], sg_ln_g[j], sg_ln_b[j], sg_w[j], sg_b[j])
        else:
            y = _odd_mixer(h, n_ctx, row_pos, col_pos, o_w_in[j], o_w_out[j], o_sink[j])
        y = jnp.concatenate([y[:, :n_ctx] * g_c, y[:, n_ctx:] * g_l[:, None]], axis=1)
        z = _layer_norm(DEEPNORM_ALPHA * z + y, ln_g[i], ln_b[i])
    return z[:, n_ctx:]
```

```cpp
#include <hip/hip_runtime.h>
#include <math.h>

constexpr int D = 1024, BATCH = 2, SEQ = 8192, CTX = 256, NTOK = SEQ + CTX, M = BATCH * NTOK;
constexpr int PW = 2560;
constexpr int MLAT = BATCH * SEQ;
constexpr float ALPHA = 1.41421356237309515f;
constexpr float LN_EPS = 1e-5f;

constexpr size_t OFF_MODV = 0;
constexpr size_t OFF_S5A = 32768;
constexpr size_t OFF_S5BB = 65536;
constexpr size_t OFF_STAT = 65536 + 131072;
constexpr size_t OFF_BIG = 262144;
constexpr size_t SZ_P = (size_t)M * PW;
constexpr size_t SZ_R = (size_t)M * D;

__device__ __forceinline__ float silu_f(float v) { return v / (1.f + expf(-v)); }
__device__ __forceinline__ float sigmoid_f(float v) { return 1.f / (1.f + expf(-v)); }
__device__ __forceinline__ float gelu_tanh_f(float v) { return 0.5f * v * (1.f + tanhf(0.7978845608028654f * (v + 0.044715f * v * v * v))); }

__global__ void __launch_bounds__(256) mod_kernel(const float* c, const float* c_ctx, const float* mod_w, const float* mod_b, float* modv) {
    __shared__ float sv[3][1024];
    for (int i = threadIdx.x; i < 1024; i += 256) { sv[0][i] = silu_f(c[i]); sv[1][i] = silu_f(c[1024 + i]); sv[2][i] = silu_f(c_ctx[i]); }
    __syncthreads();
    const int gid = blockIdx.x * 256 + threadIdx.x;
    const int layer = gid / 3072, n = gid % 3072;
    const float* w = mod_w + (size_t)layer * 1024 * 3072 + n;
    float a0 = 0.f, a1 = 0.f, a2 = 0.f;
    for (int k = 0; k < 1024; ++k) { const float wv = w[(size_t)k * 3072]; a0 += sv[0][k] * wv; a1 += sv[1][k] * wv; a2 += sv[2][k] * wv; }
    const float bb = mod_b[layer * 3072 + n];
    modv[(layer * 3 + 0) * 3072 + n] = a0 + bb; modv[(layer * 3 + 1) * 3072 + n] = a1 + bb; modv[(layer * 3 + 2) * 3072 + n] = a2 + bb;
}

__global__ void __launch_bounds__(64) s5_param_kernel(const float* lam_re, const float* lam_im, const float* log_dt, const float* b_re, const float* b_im, float* A, float* BB) {
    const int dg = blockIdx.x;
    const int p = threadIdx.x;
    const double lr = lam_re[dg * 64 + p], li = lam_im[dg * 64 + p], dt = exp((double)log_dt[dg]);
    const double mag = exp(lr * dt), ang = li * dt;
    const double ar = mag * cos(ang), ai = mag * sin(ang);
    const double den = lr * lr + li * li, nr = ar - 1.0, ni = ai;
    const double fr = (nr * lr + ni * li) / den, fi = (ni * lr - nr * li) / den;
    A[(dg * 64 + p) * 2] = (float)ar; A[(dg * 64 + p) * 2 + 1] = (float)ai;
    for (int h = 0; h < 16; ++h) {
        const double br = b_re[(dg * 64 + p) * 16 + h], bi = b_im[(dg * 64 + p) * 16 + h];
        BB[((dg * 64 + p) * 16 + h) * 2] = (float)(fr * br - fi * bi);
        BB[((dg * 64 + p) * 16 + h) * 2 + 1] = (float)(fr * bi + fi * br);
    }
}

template <class AL, class EP>
__global__ void __launch_bounds__(256) gemm_naive(int N, int K, const float* B, AL al, EP ep) {
    __shared__ float As[16][68];
    __shared__ float Bs[16][68];
    const int tx = threadIdx.x & 15, ty = threadIdx.x >> 4;
    const int m0 = blockIdx.y * 64, n0 = blockIdx.x * 64;
    float acc[4][4];
#pragma unroll
    for (int i = 0; i < 4; ++i)
#pragma unroll
        for (int j = 0; j < 4; ++j) acc[i][j] = 0.f;
    for (int k0 = 0; k0 < K; k0 += 16) {
#pragma unroll
        for (int i = 0; i < 4; ++i) { const int idx = threadIdx.x + i * 256; const int r = idx >> 4, kk = idx & 15; As[kk][r] = al(m0 + r, k0 + kk); }
#pragma unroll
        for (int i = 0; i < 4; ++i) { const int idx = threadIdx.x + i * 256; const int kk = idx >> 6, cc = idx & 63; Bs[kk][cc] = B[(size_t)(k0 + kk) * N + n0 + cc]; }
        __syncthreads();
#pragma unroll
        for (int kk = 0; kk < 16; ++kk) {
            float a[4], b[4];
#pragma unroll
            for (int i = 0; i < 4; ++i) { a[i] = As[kk][ty * 4 + i]; b[i] = Bs[kk][tx * 4 + i]; }
#pragma unroll
            for (int i = 0; i < 4; ++i)
#pragma unroll
                for (int j = 0; j < 4; ++j) acc[i][j] += a[i] * b[j];
        }
        __syncthreads();
    }
#pragma unroll
    for (int i = 0; i < 4; ++i)
#pragma unroll
        for (int j = 0; j < 4; ++j) ep(m0 + ty * 4 + i, n0 + tx * 4 + j, acc[i][j]);
}

struct ALModX {
    const float* x; const float* ctx; const float* modv;
    __device__ float operator()(int m, int k) const {
        const int b = m / NTOK, t = m % NTOK; float z; int vec;
        if (t < CTX) { z = ctx[((size_t)b * CTX + t) * D + k]; vec = 2; } else { z = x[((size_t)b * SEQ + (t - CTX)) * D + k]; vec = b; }
        const float* mv = modv + vec * 3072;
        return z * (1.f + mv[D + k]) + mv[k];
    }
};
struct ALModZ {
    const float* z; const float* modv;
    __device__ float operator()(int m, int k) const {
        const int b = m / NTOK, t = m % NTOK; const int vec = (t < CTX) ? 2 : b;
        const float* mv = modv + vec * 3072;
        return z[(size_t)m * D + k] * (1.f + mv[D + k]) + mv[k];
    }
};
struct ALPlain { const float* a; int lda; __device__ float operator()(int m, int k) const { return a[(size_t)m * lda + k]; } };
struct ALGelu { const float* a; int lda; __device__ float operator()(int m, int k) const { return gelu_tanh_f(a[(size_t)m * lda + k]); } };
struct ALLat {
    const float* a; int lda;
    __device__ float operator()(int m, int k) const { const int b = m / SEQ, t = m % SEQ; return a[((size_t)b * NTOK + CTX + t) * lda + k]; }
};
struct EPStore { float* c; int ldc; __device__ void operator()(int m, int n, float v) const { c[(size_t)m * ldc + n] = v; } };
struct EPGlu {
    const float* ya; const float* glu_b; const float* p; float* mix;
    __device__ void operator()(int m, int n, float v) const {
        const float y = gelu_tanh_f(ya[(size_t)m * 512 + n]);
        mix[(size_t)m * D + n] = y * sigmoid_f(v + glu_b[n]) * silu_f(p[(size_t)m * PW + 512 + n]);
    }
};

__global__ void __launch_bounds__(64) s5_naive(const float* P, const float* A, const float* BB, const float* c_re, const float* c_im, const float* dskip, float* YA) {
    const int b = blockIdx.x / 32, g = blockIdx.x % 32, p = threadIdx.x, hh = p & 15;
    __shared__ float sre[64], sim[64];
    for (int dir = 0; dir < 2; ++dir) {
        const int dg = dir * 32 + g;
        const float ar = A[(dg * 64 + p) * 2], ai = A[(dg * 64 + p) * 2 + 1];
        float bbr[16], bbi[16];
#pragma unroll
        for (int h = 0; h < 16; ++h) { bbr[h] = BB[((dg * 64 + p) * 16 + h) * 2]; bbi[h] = BB[((dg * 64 + p) * 16 + h) * 2 + 1]; }
        float cre[64], cim[64];
#pragma unroll
        for (int q = 0; q < 64; ++q) { cre[q] = c_re[(dg * 16 + hh) * 64 + q]; cim[q] = c_im[(dg * 16 + hh) * 64 + q]; }
        const float dsk = dskip[g * 16 + hh];
        float sr = 0.f, si = 0.f;
        for (int j = 0; j < NTOK; ++j) {
            const int t = (dir == 0) ? j : (j < CTX ? CTX - 1 - j : NTOK + CTX - 1 - j);
            const float* up = P + (size_t)(b * NTOK + t) * PW + g * 16;
            float bur = 0.f, bui = 0.f;
#pragma unroll
            for (int h = 0; h < 16; ++h) { const float u = up[h]; bur += bbr[h] * u; bui += bbi[h] * u; }
            const float nr = ar * sr - ai * si + bur, ni = ar * si + ai * sr + bui;
            sr = nr; si = ni;
            sre[p] = sr; sim[p] = si;
            __syncthreads();
            if (p < 16) {
                float y = 0.f;
#pragma unroll
                for (int q = 0; q < 64; ++q) y += cre[q] * sre[q] - cim[q] * sim[q];
                const size_t o = (size_t)(b * NTOK + t) * 512 + g * 16 + p;
                if (dir == 0) YA[o] = y + dsk * up[p]; else YA[o] += y;
            }
            __syncthreads();
        }
    }
}

__global__ void __launch_bounds__(256) vstat_kernel(const float* P, float* stat) {
    const int m = blockIdx.x; const float* v = P + (size_t)m * PW + 1536;
    __shared__ float red[256];
    const float a = v[threadIdx.x], b = v[threadIdx.x + 256];
    red[threadIdx.x] = a + b; __syncthreads();
    for (int s = 128; s > 0; s >>= 1) { if (threadIdx.x < s) red[threadIdx.x] += red[threadIdx.x + s]; __syncthreads(); }
    const float mean = red[0] * (1.f / 512.f); __syncthreads();
    const float da = a - mean, db = b - mean;
    red[threadIdx.x] = da * da + db * db; __syncthreads();
    for (int s = 128; s > 0; s >>= 1) { if (threadIdx.x < s) red[threadIdx.x] += red[threadIdx.x + s]; __syncthreads(); }
    if (threadIdx.x == 0) { stat[m * 2] = mean; stat[m * 2 + 1] = 1.f / sqrtf(red[0] * (1.f / 512.f) + LN_EPS); }
}
__global__ void __launch_bounds__(256) gmlp_naive(const float* P, const float* stat, const float* lng, const float* lnb, const float* w_s, const float* b_s, float* mix) {
    const int cidx = blockIdx.x, h = blockIdx.y;
    const int rb = (cidx / 66) * NTOK + (cidx % 66) * 128;
    const int d = threadIdx.x & 63, qq = threadIdx.x >> 6, c = h * 64 + d;
    const float lg = lng[c], lb = lnb[c];
    float acc[32];
#pragma unroll
    for (int i = 0; i < 32; ++i) acc[i] = 0.f;
    for (int k = 0; k < 128; ++k) {
        const int r = rb + k;
        const float vn = (P[(size_t)r * PW + 1536 + c] - stat[r * 2]) * stat[r * 2 + 1] * lg + lb;
#pragma unroll
        for (int i = 0; i < 32; ++i) acc[i] += w_s[((size_t)h * 128 + (qq + 4 * i)) * 128 + k] * vn;
    }
#pragma unroll
    for (int i = 0; i < 32; ++i) {
        const int q = qq + 4 * i, r = rb + q;
        const float s = acc[i] + b_s[h * 128 + q];
        mix[(size_t)r * D + 512 + c] = P[(size_t)r * PW + 1024 + c] * s * silu_f(P[(size_t)r * PW + 2048 + c]);
    }
}

__device__ __forceinline__ float block_sum256(float v, float* red) {
    red[threadIdx.x] = v; __syncthreads();
    for (int s = 128; s > 0; s >>= 1) { if (threadIdx.x < s) red[threadIdx.x] += red[threadIdx.x + s]; __syncthreads(); }
    const float r = red[0]; __syncthreads(); return r;
}
__global__ void __launch_bounds__(256) ln0_kernel(const float* x, const float* ctx, const float* modv, const float* lng, const float* lnb, float* y) {
    const int m = blockIdx.x, b = m / NTOK, t = m % NTOK;
    const float* z = (t < CTX) ? ctx + ((size_t)b * CTX + t) * D : x + ((size_t)b * SEQ + (t - CTX)) * D;
    const float* gv = modv + ((t < CTX) ? 2 : b) * 3072 + 2 * D;
    __shared__ float red[256];
    float v[4]; float s = 0.f;
#pragma unroll
    for (int i = 0; i < 4; ++i) { const int c = threadIdx.x + i * 256; v[i] = ALPHA * z[c] + y[(size_t)m * D + c] * gv[c]; s += v[i]; }
    const float mean = block_sum256(s, red) * (1.f / D);
    float q = 0.f;
#pragma unroll
    for (int i = 0; i < 4; ++i) { v[i] -= mean; q += v[i] * v[i]; }
    const float rstd = 1.f / sqrtf(block_sum256(q, red) * (1.f / D) + LN_EPS);
#pragma unroll
    for (int i = 0; i < 4; ++i) { const int c = threadIdx.x + i * 256; y[(size_t)m * D + c] = v[i] * rstd * lng[c] + lnb[c]; }
}
__global__ void __launch_bounds__(256) ln1_kernel(const float* z1, const float* modv, const float* lng, const float* lnb, float* out) {
    const int mp = blockIdx.x, b = mp / SEQ, t = mp % SEQ;
    const float* z = z1 + ((size_t)b * NTOK + CTX + t) * D;
    const float* gv = modv + b * 3072 + 2 * D;
    __shared__ float red[256];
    float v[4]; float s = 0.f;
#pragma unroll
    for (int i = 0; i < 4; ++i) { const int c = threadIdx.x + i * 256; v[i] = ALPHA * z[c] + out[(size_t)mp * D + c] * gv[c]; s += v[i]; }
    const float mean = block_sum256(s, red) * (1.f / D);
    float q = 0.f;
#pragma unroll
    for (int i = 0; i < 4; ++i) { v[i] -= mean; q += v[i] * v[i]; }
    const float rstd = 1.f / sqrtf(block_sum256(q, red) * (1.f / D) + LN_EPS);
#pragma unroll
    for (int i = 0; i < 4; ++i) { const int c = threadIdx.x + i * 256; out[(size_t)mp * D + c] = v[i] * rstd * lng[c] + lnb[c]; }
}

__global__ void __launch_bounds__(256) rope_kernel(float* P1) {
    const size_t gid = (size_t)blockIdx.x * 256 + threadIdx.x;
    const int i = gid & 31; const int slot = (gid >> 5) % 20; const int mp = (int)(gid / 640);
    const int b = mp / SEQ, t = mp % SEQ;
    const int half = i >> 4, fi = i & 15;
    const float pos = (float)(half == 0 ? (t >> 6) : (t & 63));
    const float inv = powf(10000.f, -(float)fi / 16.f);
    const float ang = pos * inv;
    const float cs = cosf(ang), sn = sinf(ang);
    float* base = P1 + ((size_t)b * NTOK + CTX + t) * PW + (slot < 16 ? slot * 64 : 1024 + (slot - 16) * 64) + half * 32 + fi;
    const float x1 = base[0], x2 = base[16];
    base[0] = x1 * cs - x2 * sn; base[16] = x2 * cs + x1 * sn;
}

__global__ void __launch_bounds__(256) attn_naive(float* P1, const float* sink) {
    const int gid = blockIdx.x * 256 + threadIdx.x;
    const int hq = gid & 15, m = gid >> 4, kvh = hq >> 2;
    const int b = m / NTOK, t = m % NTOK;
    float* qp = P1 + (size_t)m * PW + hq * 64;
    float q[64];
#pragma unroll
    for (int d = 0; d < 64; ++d) q[d] = qp[d] * 0.125f;
    const float sk = sink[hq];
    const float* kbase = P1 + (size_t)b * NTOK * PW + 1024 + kvh * 64;
    int lo = 0, hi = -1;
    if (t >= CTX) { const int tl = t - CTX; const int a0 = tl - 128 < 0 ? 0 : tl - 128, a1 = tl + 128 > SEQ - 1 ? SEQ - 1 : tl + 128; lo = CTX + a0; hi = CTX + a1; }
    float mx = sk;
    for (int r = 0; r < CTX; ++r) { const float* kp = kbase + (size_t)r * PW; float s = 0.f;
#pragma unroll
        for (int d = 0; d < 64; ++d) s += q[d] * kp[d];
        mx = fmaxf(mx, s); }
    for (int r = lo; r <= hi; ++r) { const float* kp = kbase + (size_t)r * PW; float s = 0.f;
#pragma unroll
        for (int d = 0; d < 64; ++d) s += q[d] * kp[d];
        mx = fmaxf(mx, s); }
    float l = expf(sk - mx);
    float o[64];
#pragma unroll
    for (int d = 0; d < 64; ++d) o[d] = 0.f;
    for (int r = 0; r < CTX; ++r) { const float* kp = kbase + (size_t)r * PW; float s = 0.f;
#pragma unroll
        for (int d = 0; d < 64; ++d) s += q[d] * kp[d];
        const float pr = expf(s - mx); l += pr;
#pragma unroll
        for (int d = 0; d < 64; ++d) o[d] += pr * kp[256 + d]; }
    for (int r = lo; r <= hi; ++r) { const float* kp = kbase + (size_t)r * PW; float s = 0.f;
#pragma unroll
        for (int d = 0; d < 64; ++d) s += q[d] * kp[d];
        const float pr = expf(s - mx); l += pr;
#pragma unroll
        for (int d = 0; d < 64; ++d) o[d] += pr * kp[256 + d]; }
    const float rl = 1.f / l;
    const float* gp = P1 + (size_t)m * PW + 1536 + hq * 64;
#pragma unroll
    for (int d = 0; d < 64; ++d) qp[d] = o[d] * rl * silu_f(gp[d]);
}

extern "C" void kernel_launch(void* const* d_in, const int* in_sizes, int n_in, void* d_out, int out_size, void* d_ws, size_t ws_size, hipStream_t stream) {
    const float* x = (const float*)d_in[0]; const float* c = (const float*)d_in[1]; const float* ctx = (const float*)d_in[2]; const float* c_ctx = (const float*)d_in[3];
    const float* mod_w = (const float*)d_in[4]; const float* mod_b = (const float*)d_in[5]; const float* ln_g = (const float*)d_in[6]; const float* ln_b = (const float*)d_in[7];
    const float* e_w_in = (const float*)d_in[8]; const float* e_w_out = (const float*)d_in[9];
    const float* lam_re = (const float*)d_in[10]; const float* lam_im = (const float*)d_in[11]; const float* log_dt = (const float*)d_in[12];
    const float* b_re = (const float*)d_in[13]; const float* b_im = (const float*)d_in[14]; const float* c_re = (const float*)d_in[15]; const float* c_im = (const float*)d_in[16];
    const float* s5_d = (const float*)d_in[17]; const float* glu_w = (const float*)d_in[18]; const float* glu_b = (const float*)d_in[19];
    const float* sg_ln_g = (const float*)d_in[20]; const float* sg_ln_b = (const float*)d_in[21]; const float* sg_w = (const float*)d_in[22]; const float* sg_b = (const float*)d_in[23];
    const float* o_w_in = (const float*)d_in[24]; const float* o_w_out = (const float*)d_in[25]; const float* o_sink = (const float*)d_in[26];
    float* out = (float*)d_out; float* ws = (float*)d_ws;
    float* modv = ws + OFF_MODV; float* s5a = ws + OFF_S5A; float* s5bb = ws + OFF_S5BB; float* stat = ws + OFF_STAT;
    float* P = ws + OFF_BIG; float* MIX = P + SZ_P; float* Y0 = P; float* P1 = P + SZ_R; float* YA = out;

    mod_kernel<<<24, 256, 0, stream>>>(c, c_ctx, mod_w, mod_b, modv);
    s5_param_kernel<<<64, 64, 0, stream>>>(lam_re, lam_im, log_dt, b_re, b_im, s5a, s5bb);
    gemm_naive<<<dim3(PW / 64, M / 64), 256, 0, stream>>>(PW, D, e_w_in, ALModX{x, ctx, modv}, EPStore{P, PW});
    s5_naive<<<64, 64, 0, stream>>>(P, s5a, s5bb, c_re, c_im, s5_d, YA);
    vstat_kernel<<<M, 256, 0, stream>>>(P, stat);
    gmlp_naive<<<dim3(132, 8), 256, 0, stream>>>(P, stat, sg_ln_g, sg_ln_b, sg_w, sg_b, MIX);
    gemm_naive<<<dim3(512 / 64, M / 64), 256, 0, stream>>>(512, 512, glu_w, ALGelu{YA, 512}, EPGlu{YA, glu_b, P, MIX});
    gemm_naive<<<dim3(D / 64, M / 64), 256, 0, stream>>>(D, D, e_w_out, ALPlain{MIX, D}, EPStore{Y0, D});
    ln0_kernel<<<M, 256, 0, stream>>>(x, ctx, modv, ln_g, ln_b, Y0);
    gemm_naive<<<dim3(PW / 64, M / 64), 256, 0, stream>>>(PW, D, o_w_in, ALModZ{Y0, modv + 3 * 3072}, EPStore{P1, PW});
    rope_kernel<<<(unsigned)((size_t)MLAT * 640 / 256), 256, 0, stream>>>(P1);
    attn_naive<<<M * 16 / 256, 256, 0, stream>>>(P1, o_sink);
    gemm_naive<<<dim3(D / 64, MLAT / 64), 256, 0, stream>>>(D, D, o_w_out, ALLat{P1, PW}, EPStore{out, D});
    ln1_kernel<<<MLAT, 256, 0, stream>>>(Y0, modv + 3 * 3072, ln_g + D, ln_b + D, out);
}
```

```cpp
#include <hip/hip_runtime.h>
#include <hip/hip_cooperative_groups.h>
#include <cstdio>
#include <cstdint>
namespace cg = cooperative_groups;
namespace pg8 {
#define PG8_LAS __attribute__((address_space(3)))
typedef unsigned short bf16_t;
typedef short bf16x8 __attribute__((ext_vector_type(8)));
typedef float f32x4 __attribute__((ext_vector_type(4)));
typedef unsigned u32x4 __attribute__((ext_vector_type(4)));
constexpr int BM = 256, BK = 64, HALF = 128, HTB = HALF * BK * 2  , STAGE_BYTES = 8 * HTB, NXCD = 8, WGM = 8;

__host__ __device__ __forceinline__ int lds_byte(int r, int c) { const int st = (r >> 4) * 2 + (c >> 5), rr = r & 15, cc = c & 31, ob = rr * 64 + cc * 2; return st * 1024 + (ob ^ (((ob >> 9) & 1) << 5)); }
__host__ __device__ __forceinline__ void stage_rc(int b, int& R, int& C) { const int st = b / 1024, sb = b % 1024, swz = sb ^ (((sb >> 9) & 1) << 5); R = (st >> 1) * 16 + swz / 64; C = (st & 1) * 32 + (swz % 64) / 2; }
__host__ __device__ __forceinline__ int perm32(int rho) { const int n = rho >> 4, i = rho & 15; return 8 * (i >> 2) + 4 * n + (i & 3); }

struct Unit { int pm, pn; };
struct Gemm { const bf16_t* A; const bf16_t* Bt; int M, N, K; };

struct StaticOrder {
    int nM, nN, nwg, G, c;
    __host__ __device__ void init(int M, int N, int G_, int c_) { nM = M / BM; nN = N / BM; nwg = nM * nN; G = G_; c = c_; }
    __host__ __device__ bool next(int i, Unit& u) const {
        const long L = (long)i * G + c; if (L >= nwg) return false;
        int wgid = (int)L; { const int q = nwg / NXCD, r = nwg % NXCD, xcd = wgid % NXCD, off = wgid / NXCD; wgid = (xcd < r ? xcd * (q + 1) : r * (q + 1) + (xcd - r) * q) + off; }
        const int nig = WGM * nN, gid = wgid / nig, fm = gid * WGM, gsz = (nM - fm) < WGM ? (nM - fm) : WGM;
        u.pm = fm + ((wgid % nig) % gsz); u.pn = (wgid % nig) / gsz; return true;
    }
    __device__ __forceinline__ void a_ready(const Unit&) const {}
    __device__ __forceinline__ void done(const Unit&) const {}
};

__device__ __forceinline__ unsigned cvt_pk_bf16(float lo, float hi) { unsigned r; asm volatile("v_cvt_pk_bf16_f32 %0, %1, %2" : "=v"(r) : "v"(lo), "v"(hi)); return r; }
typedef float f32x2 __attribute__((ext_vector_type(2)));
__device__ __forceinline__ f32x2 gelu_pk(f32x2 v) {
    const f32x2 av = __builtin_elementwise_abs(v), d = av * 0.2316418882f + 1.0f;
    f32x2 t; t.x = __builtin_amdgcn_rcpf(d.x); t.y = __builtin_amdgcn_rcpf(d.y);
    f32x2 q = t * 0.5307027145f + (-0.7265760135f); q = q * t + 0.7107068705f; q = q * t + (-0.142248368f); q = q * t + 0.127414796f; q = q * t;
    const f32x2 s = (v * v) * (-0.72134752044f);
    f32x2 e; e.x = __builtin_amdgcn_exp2f(s.x); e.y = __builtin_amdgcn_exp2f(s.y);
    const f32x2 m = v * (q * e), r = v - m;
    f32x2 o; o.x = v.x < 0.f ? m.x : r.x; o.y = v.y < 0.f ? m.y : r.y; return o;
}

template <int ACT  > struct EpiBf16 {
    static constexpr bool PERM = true, AFTER_DRAIN = false; static_assert(ACT == 0 || ACT == 1, "EpiBf16: ACT is 0 (none) or 1 (gelu_pk)");
    bf16_t* O; int ldc; const float* bias; int split_cols; size_t split_stride; float scale0;
    __device__ __forceinline__ void operator()(const f32x4 (&acc)[2][2][4][2], const Unit& u, int wr, int wc, int fr, int fq) const {
        const int row0 = u.pm * BM + wr * 64 + fr; int colt = u.pn * BM; bf16_t* base = O;
        float sc = 1.f; if (split_cols) { const int t = colt / split_cols; base += (size_t)t * split_stride; colt -= t * split_cols; if (t == 0) sc = scale0; }
        const int col0 = colt + wc * 32 + 8 * fq, bcol0 = u.pn * BM + wc * 32 + 8 * fq;
        f32x4 bv[2][2];
#pragma unroll
        for (int bj = 0; bj < 2; ++bj)
#pragma unroll
            for (int n = 0; n < 2; ++n) bv[bj][n] = bias ? *(const f32x4*)(bias + bcol0 + bj * HALF + 4 * n) : (f32x4){0.f, 0.f, 0.f, 0.f};
#pragma unroll
        for (int ai = 0; ai < 2; ++ai)
#pragma unroll
            for (int m = 0; m < 4; ++m) { bf16_t* rowp = base + (size_t)(row0 + ai * HALF + m * 16) * ldc + col0;
#pragma unroll
                for (int bj = 0; bj < 2; ++bj) { f32x4 v0 = acc[ai][bj][m][0] + bv[bj][0], v1 = acc[ai][bj][m][1] + bv[bj][1];
                    if (ACT == 1) { f32x2 a = gelu_pk((f32x2){v0[0], v0[1]}), b = gelu_pk((f32x2){v0[2], v0[3]}), c = gelu_pk((f32x2){v1[0], v1[1]}), d = gelu_pk((f32x2){v1[2], v1[3]});
                        v0 = (f32x4){a.x, a.y, b.x, b.y}; v1 = (f32x4){c.x, c.y, d.x, d.y}; }
                    v0 = v0 * sc; v1 = v1 * sc; u32x4 w; w.x = cvt_pk_bf16(v0[0], v0[1]); w.y = cvt_pk_bf16(v0[2], v0[3]); w.z = cvt_pk_bf16(v1[0], v1[1]); w.w = cvt_pk_bf16(v1[2], v1[3]);
                    *(u32x4*)(rowp + bj * HALF) = w; } }
    }
};
}
namespace pg8 {
__device__ __forceinline__ float bf2f_(unsigned short h) { return __builtin_bit_cast(float, (unsigned)h << 16); }
__device__ __forceinline__ float sigm_(float v) { return 1.f / (1.f + __expf(-v)); }
struct EpiGlu {
    static constexpr bool PERM = true, AFTER_DRAIN = false;
    const bf16_t* ya1; const bf16_t* P; const float* glu_b; bf16_t* mix;
    __device__ __forceinline__ void operator()(const f32x4 (&acc)[2][2][4][2], const Unit& u, int wr, int wc, int fr, int fq) const {
        const int row0 = u.pm * BM + wr * 64 + fr, col0 = u.pn * BM + wc * 32 + 8 * fq;
#pragma unroll
        for (int ai = 0; ai < 2; ++ai)
#pragma unroll
            for (int m = 0; m < 4; ++m) { const size_t row = (size_t)(row0 + ai * HALF + m * 16);
#pragma unroll
                for (int bj = 0; bj < 2; ++bj) { const int col = col0 + bj * HALF;
                    const f32x4 b0 = *(const f32x4*)(glu_b + col), b1 = *(const f32x4*)(glu_b + col + 4);
                    const u32x4 yw = *(const u32x4*)(ya1 + row * 512 + col), gw = *(const u32x4*)(P + row * 2560 + 512 + col);
                    float o[8];
#pragma unroll
                    for (int j = 0; j < 8; ++j) { const float a = (j < 4) ? acc[ai][bj][m][0][j] + b0[j] : acc[ai][bj][m][1][j - 4] + b1[j - 4];
                        const unsigned ywj = yw[j >> 1], gwj = gw[j >> 1];
                        const float y = bf2f_((unsigned short)((j & 1) ? (ywj >> 16) : (ywj & 0xffffu))), g = bf2f_((unsigned short)((j & 1) ? (gwj >> 16) : (gwj & 0xffffu)));
                        o[j] = y * sigm_(a) * (g * sigm_(g)); }
                    u32x4 w; w.x = cvt_pk_bf16(o[0], o[1]); w.y = cvt_pk_bf16(o[2], o[3]); w.z = cvt_pk_bf16(o[4], o[5]); w.w = cvt_pk_bf16(o[6], o[7]);
                    *(u32x4*)(mix + row * 1024 + col) = w; } }
    }
};
struct EpiRope {
    static constexpr bool PERM = true, AFTER_DRAIN = false;
    bf16_t* O; const float* cs; float qscale;
    __device__ __forceinline__ void operator()(const f32x4 (&acc)[2][2][4][2], const Unit& u, int wr, int wc, int fr, int fq) const {
        const int row0 = u.pm * BM + wr * 64 + fr, col0 = u.pn * BM + wc * 32 + 8 * fq;
        const bool rope = (u.pm < 64) && (u.pn <= 4);
        const float sc = (u.pn < 4) ? qscale : 1.f;
        const float sgn = (fq < 2) ? -1.f : 1.f;
#pragma unroll
        for (int ai = 0; ai < 2; ++ai)
#pragma unroll
            for (int m = 0; m < 4; ++m) { const int row = row0 + ai * HALF + m * 16; const int t = row & 8191; const int pos = (wc & 1) ? (t & 63) : (t >> 6);
                f32x4 c4[4];
                if (rope) {
#pragma unroll
                    for (int j = 0; j < 4; ++j) c4[j] = *(const f32x4*)(cs + (pos * 16 + 8 * (fq & 1)) * 2 + 4 * j); }
#pragma unroll
                for (int bj = 0; bj < 2; ++bj) { float o[8];
#pragma unroll
                    for (int j = 0; j < 8; ++j) { float v = (j < 4) ? acc[ai][bj][m][0][j] : acc[ai][bj][m][1][j - 4];
                        if (rope) { const float pv = __shfl_xor(v, 32); const float co = c4[j >> 1][(j & 1) * 2], si = c4[j >> 1][(j & 1) * 2 + 1]; v = v * co + sgn * pv * si; }
                        o[j] = v * sc; }
                    u32x4 w; w.x = cvt_pk_bf16(o[0], o[1]); w.y = cvt_pk_bf16(o[2], o[3]); w.z = cvt_pk_bf16(o[4], o[5]); w.w = cvt_pk_bf16(o[6], o[7]);
                    *(u32x4*)(O + (size_t)row * 2560 + col0 + bj * HALF) = w; } }
    }
};
}
namespace pg8 {
template <class Epi, class Sched, bool ALIGN_EPI = false, bool SP2 = false>
__device__ __forceinline__ void gemm_phase(PG8_LAS unsigned char* lds, const Gemm g, const Sched& S, const Epi& E) {
    const int tid = threadIdx.x, wid = __builtin_amdgcn_readfirstlane(tid >> 6), lane = tid & 63, wr = wid >> 2, wc = wid & 3, fr = lane & 15, fq = lane >> 4;
    const int K = g.K, nt = K / BK;
    unsigned voffA[2], voffB[2];
#pragma unroll
    for (int i = 0; i < 2; ++i) { int R, C; stage_rc(tid * 16 + i * 8192, R, C); const int Rb = Epi::PERM ? ((R & ~31) + perm32(R & 31)) : R;
        voffA[i] = (unsigned)(R * K + C) * 2u; voffB[i] = (unsigned)(Rb * K + C) * 2u; }
    const size_t kstep = (size_t)(BK * 2);
    const size_t hstep = (size_t)HALF * K * 2;
    const size_t tstep = 2 * hstep;
    const unsigned ldsw = (unsigned)wid * 1024u;
    const int aoff = lds_byte(wr * 64 + fr, fq * 8), boff = lds_byte(wc * 32 + fr, fq * 8);
#define PG8_SA(b, h) (((b) * 2 + (h)) * HTB)
#define PG8_SB(b, h) ((4 + (b) * 2 + (h)) * HTB)
#define PG8_STAGE(bufoff, gbase, voff) do { _Pragma("unroll") for (int _i = 0; _i < 2; ++_i) \
        __builtin_amdgcn_global_load_lds((const unsigned*)((const char*)(gbase) + (voff)[_i]), (PG8_LAS unsigned*)(lds + (bufoff) + ldsw + _i * 8192), 16, 0, 0); } while (0)
#define PG8_LDA(dst, b, h) do { _Pragma("unroll") for (int m = 0; m < 4; ++m) _Pragma("unroll") for (int k = 0; k < 2; ++k) dst[m][k] = *(const PG8_LAS bf16x8*)(lds + PG8_SA(b, h) + aoff + m * 2048 + k * 1024); } while (0)
#define PG8_LDB(dst, b, h) do { _Pragma("unroll") for (int n = 0; n < 2; ++n) _Pragma("unroll") for (int k = 0; k < 2; ++k) dst[n][k] = *(const PG8_LAS bf16x8*)(lds + PG8_SB(b, h) + boff + n * 2048 + k * 1024); } while (0)
#define PG8_MMA(ai, bj, At, Bt) do { __builtin_amdgcn_s_setprio(1); _Pragma("unroll") for (int m = 0; m < 4; ++m) _Pragma("unroll") for (int n = 0; n < 2; ++n) _Pragma("unroll") for (int k = 0; k < 2; ++k) \
        acc[ai][bj][m][n] = __builtin_amdgcn_mfma_f32_16x16x32_bf16(Bt[n][k], At[m][k], acc[ai][bj][m][n], 0, 0, 0); __builtin_amdgcn_s_setprio(0); } while (0)
#define PG8_WAIT_V(n) asm volatile("s_waitcnt vmcnt(" #n ")" ::: "memory")
#define PG8_WAIT_L(n) asm volatile("s_waitcnt lgkmcnt(" #n ")" ::: "memory")
#define PG8_BAR __builtin_amdgcn_s_barrier()
#define PG8_SCHED __builtin_amdgcn_sched_barrier(0)
    Unit cur, nxt; int ui = 0;
    if (!S.next(0, cur)) return;
    f32x4 acc[2][2][4][2];
#pragma unroll
    for (int a = 0; a < 2; ++a)
#pragma unroll
        for (int b = 0; b < 2; ++b)
#pragma unroll
            for (int m = 0; m < 4; ++m)
#pragma unroll
                for (int n = 0; n < 2; ++n) acc[a][b][m][n] = (f32x4){0.f, 0.f, 0.f, 0.f};
    bf16x8 At[4][2], B0[2][2], B1[2][2];
    const char* cA = (const char*)g.A + (size_t)cur.pm * tstep; const char* cB = (const char*)g.Bt + (size_t)cur.pn * tstep;
    S.a_ready(cur);
    if constexpr (SP2) {
        PG8_STAGE(PG8_SB(0, 0), cB, voffB); PG8_STAGE(PG8_SB(0, 1), cB + hstep, voffB); PG8_STAGE(PG8_SA(0, 0), cA, voffA); PG8_STAGE(PG8_SA(0, 1), cA + hstep, voffA);
        if (wr == 1) PG8_BAR;
        PG8_WAIT_V(2); PG8_BAR;
        PG8_STAGE(PG8_SB(1, 0), cB + kstep, voffB); PG8_STAGE(PG8_SA(1, 0), cA + kstep, voffA); PG8_STAGE(PG8_SB(1, 1), cB + hstep + kstep, voffB);
        PG8_WAIT_V(6); PG8_BAR;
    } else {
        PG8_STAGE(PG8_SB(0, 0), cB, voffB); PG8_STAGE(PG8_SA(0, 0), cA, voffA); PG8_STAGE(PG8_SB(0, 1), cB + hstep, voffB); PG8_STAGE(PG8_SA(0, 1), cA + hstep, voffA);
        if (wr == 1) PG8_BAR;
        PG8_WAIT_V(4); PG8_BAR;
        PG8_STAGE(PG8_SB(1, 0), cB + kstep, voffB); PG8_STAGE(PG8_SA(1, 0), cA + kstep, voffA); PG8_STAGE(PG8_SB(1, 1), cB + hstep + kstep, voffB);
        PG8_WAIT_V(6); PG8_BAR;
    }
    for (;;) {
        const bool has_next = S.next(ui + 1, nxt);
        const char* nA = has_next ? (const char*)g.A + (size_t)nxt.pm * tstep : cA; const char* nB = has_next ? (const char*)g.Bt + (size_t)nxt.pn * tstep : cB;
        for (int t = 0; t < nt; t += 2) {
            const bool last = (t == nt - 2);
            const char* a1 = cA + (size_t)(t + 1) * kstep;
            const char* a2 = last ? nA : cA + (size_t)(t + 2) * kstep; const char* b2 = last ? nB : cB + (size_t)(t + 2) * kstep;
            const char* a3 = a2 + kstep; const char* b3 = b2 + kstep;
            if (last && has_next) S.a_ready(nxt);
            if constexpr (SP2) {
            PG8_LDB(B0, 0, 0); PG8_LDB(B1, 0, 1); PG8_SCHED; PG8_LDA(At, 0, 0); PG8_STAGE(PG8_SA(1, 1), a1 + hstep, voffA);
            PG8_WAIT_V(8); PG8_WAIT_L(0); PG8_BAR; PG8_MMA(0, 0, At, B0); PG8_MMA(0, 1, At, B1); PG8_BAR; PG8_SCHED;
            PG8_LDA(At, 0, 1); PG8_STAGE(PG8_SB(0, 0), b2, voffB); PG8_STAGE(PG8_SB(0, 1), b2 + hstep, voffB); PG8_STAGE(PG8_SA(0, 0), a2, voffA);
            PG8_WAIT_V(8); PG8_WAIT_L(0); PG8_BAR; PG8_MMA(1, 0, At, B0); PG8_MMA(1, 1, At, B1); PG8_BAR; PG8_SCHED;
            PG8_LDB(B0, 1, 0); PG8_LDB(B1, 1, 1); PG8_SCHED; PG8_LDA(At, 1, 0); PG8_STAGE(PG8_SA(0, 1), a2 + hstep, voffA);
            PG8_WAIT_V(8); PG8_WAIT_L(0); PG8_BAR; PG8_MMA(0, 0, At, B0); PG8_MMA(0, 1, At, B1); PG8_BAR; PG8_SCHED;
            PG8_LDA(At, 1, 1); PG8_STAGE(PG8_SB(1, 0), b3, voffB); PG8_STAGE(PG8_SB(1, 1), b3 + hstep, voffB); PG8_STAGE(PG8_SA(1, 0), a3, voffA);
            PG8_WAIT_V(8); PG8_WAIT_L(0); PG8_BAR; PG8_MMA(1, 0, At, B0); PG8_MMA(1, 1, At, B1); PG8_BAR; PG8_SCHED;
            } else {
            PG8_LDB(B0, 0, 0); PG8_SCHED; PG8_LDA(At, 0, 0); PG8_STAGE(PG8_SA(1, 1), a1 + hstep, voffA);
            PG8_WAIT_L(8); PG8_BAR; PG8_WAIT_L(0); PG8_MMA(0, 0, At, B0); PG8_BAR; PG8_SCHED;
            PG8_LDB(B1, 0, 1); PG8_STAGE(PG8_SB(0, 0), b2, voffB);
            PG8_BAR; PG8_WAIT_L(0); PG8_MMA(0, 1, At, B1); PG8_BAR;
            PG8_LDA(At, 0, 1); PG8_STAGE(PG8_SA(0, 0), a2, voffA);
            PG8_BAR; PG8_WAIT_L(0); PG8_MMA(1, 0, At, B0); PG8_BAR; PG8_SCHED;
            PG8_STAGE(PG8_SB(0, 1), b2 + hstep, voffB);
            PG8_WAIT_V(6); PG8_BAR; PG8_MMA(1, 1, At, B1); PG8_BAR;
            PG8_LDB(B0, 1, 0); PG8_SCHED; PG8_LDA(At, 1, 0); PG8_STAGE(PG8_SA(0, 1), a2 + hstep, voffA);
            PG8_WAIT_L(8); PG8_BAR; PG8_WAIT_L(0); PG8_MMA(0, 0, At, B0); PG8_BAR; PG8_SCHED;
            PG8_LDB(B1, 1, 1); PG8_STAGE(PG8_SB(1, 0), b3, voffB);
            PG8_BAR; PG8_WAIT_L(0); PG8_MMA(0, 1, At, B1); PG8_BAR;
            PG8_LDA(At, 1, 1); PG8_STAGE(PG8_SA(1, 0), a3, voffA);
            PG8_BAR; PG8_WAIT_L(0); PG8_MMA(1, 0, At, B0); PG8_BAR; PG8_SCHED;
            PG8_STAGE(PG8_SB(1, 1), b3 + hstep, voffB);
            PG8_WAIT_V(6); PG8_BAR; PG8_MMA(1, 1, At, B1); PG8_BAR;
            }
        }
        if constexpr (ALIGN_EPI) { if (wr == 0) PG8_BAR; }
        if constexpr (!Epi::AFTER_DRAIN) { E(acc, cur, wr, wc, fr, fq); S.done(cur); }
        if (!has_next) break;
#pragma unroll
        for (int a = 0; a < 2; ++a)
#pragma unroll
            for (int b = 0; b < 2; ++b)
#pragma unroll
                for (int m = 0; m < 4; ++m)
#pragma unroll
                    for (int n = 0; n < 2; ++n) acc[a][b][m][n] = (f32x4){0.f, 0.f, 0.f, 0.f};
        cur = nxt; cA = nA; cB = nB; ++ui;
        if constexpr (ALIGN_EPI) { if (wr == 1) PG8_BAR; }
    }
    PG8_WAIT_V(0);
    if constexpr (!ALIGN_EPI) { if (wr == 0) PG8_BAR; }
    PG8_BAR;
    if constexpr (Epi::AFTER_DRAIN) { E.fused(acc, cur, wr, wc, fr, fq, lds, wid, lane); S.done(cur); }
#undef PG8_SA
#undef PG8_SB
#undef PG8_STAGE
#undef PG8_LDA
#undef PG8_LDB
#undef PG8_MMA
#undef PG8_WAIT_V
#undef PG8_WAIT_L
#undef PG8_BAR
#undef PG8_SCHED
}
}
constexpr int D = 1024, SEQ = 8192, CTXN = 256, MLAT = 16384, MCTX = 512, M = MLAT + MCTX, PW = 2560;
constexpr float ALPHA = 1.41421356237309515f, LN_EPS = 1e-5f;
constexpr float LOG2E = 1.4426950408889634f, QSCALE = 0.125f * 1.4426950408889634f;
constexpr int NWAVES = 8, NTHREADS = 512;
constexpr int LDS_BYTES = 147456;
constexpr size_t MiB = 1u << 20;
constexpr size_t WS_MODV = 1 * MiB;
constexpr size_t WS_ROPE = 1 * MiB + 256 * 1024;
constexpr size_t WS_S5A = 1 * MiB + 512 * 1024;
constexpr size_t WS_S5BB = 1 * MiB + 768 * 1024 + 256 * 1024;
constexpr size_t WS_WIN0 = 8 * MiB, WS_WOUT0 = 13 * MiB, WS_WGLU = 15 * MiB, WS_WIN1 = 16 * MiB, WS_WOUT1 = 21 * MiB;
constexpr size_t WS_H = 24 * MiB;
constexpr size_t WS_P = 57 * MiB;
constexpr size_t WS_MIX = 140 * MiB;
constexpr size_t WS_YA1 = 173 * MiB;
constexpr size_t WS_Z1C = 190 * MiB;
constexpr size_t WS_YAF = 192 * MiB;

typedef unsigned short bf16;
typedef float f32x4 __attribute__((ext_vector_type(4)));
typedef unsigned u32x2 __attribute__((ext_vector_type(2)));
typedef unsigned u32x4 __attribute__((ext_vector_type(4)));
#define LAS __attribute__((address_space(3)))
__device__ __forceinline__ unsigned f2bf(float f) { unsigned u = __builtin_bit_cast(unsigned, f); return (u + 0x7fffu + ((u >> 16) & 1u)) >> 16; }
__device__ __forceinline__ unsigned pk2(float lo, float hi) { return f2bf(lo) | (f2bf(hi) << 16); }
__device__ __forceinline__ float bf2f(unsigned h) { return __builtin_bit_cast(float, h << 16); }
__device__ __forceinline__ float bflo(unsigned w) { return __builtin_bit_cast(float, w << 16); }
__device__ __forceinline__ float bfhi(unsigned w) { return __builtin_bit_cast(float, w & 0xffff0000u); }
__device__ __forceinline__ float silu_f(float v) { return v / (1.f + __expf(-v)); }
__device__ __forceinline__ float gelu_tanh_f(float v) { const float u = 0.7978845608028654f * (v + 0.044715f * v * v * v); return v / (1.f + __expf(-2.f * u)); }
__device__ __forceinline__ float wave_sum(float v) {
#pragma unroll
    for (int o = 1; o < 64; o <<= 1) v += __shfl_xor(v, o);
    return v;
}
#define LDS_WAIT() asm volatile("s_waitcnt lgkmcnt(0)" ::: "memory")

struct Args { const float* in[27]; float* out; unsigned char* ws; };

__device__ __forceinline__ int row_vec(int r) { return r < MLAT ? (r >> 13) : 2; }

__device__ __forceinline__ void p0_transpose_item(const float* W, int K, int N, bf16* WT, LAS float* scr, int item, int lane) {
    const int nblk = N / 32, kb = item / nblk, nb = item % nblk, k0 = 64 * kb, n0 = 32 * nb;
#pragma unroll 8
    for (int i = 0; i < 32; ++i) { const int kk = 2 * i + (lane >> 5); scr[kk * 33 + (lane & 31)] = W[(size_t)(k0 + kk) * N + n0 + (lane & 31)]; }
    LDS_WAIT();
    const int c = lane & 7;
#pragma unroll
    for (int j = 0; j < 4; ++j) { const int n = (lane >> 3) + 8 * j; const LAS float* s = scr + (8 * c) * 33 + n;
        u32x4 o; o.x = pk2(s[0 * 33], s[1 * 33]); o.y = pk2(s[2 * 33], s[3 * 33]); o.z = pk2(s[4 * 33], s[5 * 33]); o.w = pk2(s[6 * 33], s[7 * 33]);
        *(u32x4*)(WT + (size_t)(n0 + n) * K + k0 + 8 * c) = o; }
    LDS_WAIT();
}
__device__ __forceinline__ void phase_prologue(const Args& a, LAS unsigned char* lds, int tid, int lane, int wave, int bid, int G) {
    unsigned char* ws = a.ws;
    if (bid < 96) {
        LAS float* sv = (LAS float*)lds;
        LAS float* red = (LAS float*)(lds + 12288);
        const float* c = a.in[1]; const float* cc = a.in[3];
        for (int i = tid; i < 1024; i += NTHREADS) { sv[i] = silu_f(c[i]); sv[1024 + i] = silu_f(c[1024 + i]); sv[2048 + i] = silu_f(cc[i]); }
        __syncthreads();
        const int layer = bid / 48, n = (bid % 48) * 64 + lane;
        const float* w = a.in[4] + (size_t)layer * 1024 * 3072 + (size_t)(wave * 128) * 3072 + n;
        float a0 = 0.f, a1 = 0.f, a2 = 0.f;
#pragma unroll 8
        for (int k = 0; k < 128; ++k) { const float wv = w[(size_t)k * 3072]; const int kk = wave * 128 + k; a0 += sv[kk] * wv; a1 += sv[1024 + kk] * wv; a2 += sv[2048 + kk] * wv; }
        red[(wave * 3 + 0) * 64 + lane] = a0; red[(wave * 3 + 1) * 64 + lane] = a1; red[(wave * 3 + 2) * 64 + lane] = a2;
        __syncthreads();
        if (wave == 0) {
            float* modv = (float*)(ws + WS_MODV); const float bb = a.in[5][layer * 3072 + n];
#pragma unroll
            for (int v = 0; v < 3; ++v) { float s = 0.f;
#pragma unroll
                for (int w8 = 0; w8 < 8; ++w8) s += red[(w8 * 3 + v) * 64 + lane];
                modv[(layer * 3 + v) * 3072 + n] = s + bb; }
        }
        __syncthreads();
    }
    {
        const int gt = bid * NTHREADS + tid;
        if (gt < 4096) {
            const int dg = gt >> 6, p = gt & 63;
            const double lr = a.in[10][dg * 64 + p], li = a.in[11][dg * 64 + p], dt = exp((double)a.in[12][dg]);
            const double mag = exp(lr * dt), ang = li * dt;
            const double ar = mag * cos(ang), ai = mag * sin(ang);
            const double den = lr * lr + li * li, nr = ar - 1.0, ni = ai;
            const double fr = (nr * lr + ni * li) / den, fi = (ni * lr - nr * li) / den;
            float* A = (float*)(ws + WS_S5A); float* BB = (float*)(ws + WS_S5BB);
            A[gt * 2] = (float)ar; A[gt * 2 + 1] = (float)ai;
            for (int h = 0; h < 16; ++h) { const double br = a.in[13][gt * 16 + h], bi = a.in[14][gt * 16 + h];
                BB[(gt * 16 + h) * 2] = (float)(fr * br - fi * bi); BB[(gt * 16 + h) * 2 + 1] = (float)(fr * bi + fi * br); }
        } else if (gt < 4096 + 2048) {
            const int e = gt - 4096, pos = e >> 4, fi = e & 15;
            const float inv = powf(10000.f, -(float)fi / 16.f);
            const float ang = (float)pos * inv;
            float* cs = (float*)(ws + WS_ROPE); cs[e * 2] = (float)cos((double)ang); cs[e * 2 + 1] = (float)sin((double)ang);
        }
    }
    {
        LAS float* scr = (LAS float*)(lds + 32768 + wave * 8448);
        const int gw = bid * NWAVES + wave, NGW = G * NWAVES;
        constexpr int I_IN = 16 * 80, I_OUT = 16 * 32, I_GLU = 8 * 16;
        constexpr int NITEMS = 2 * I_IN + 2 * I_OUT + I_GLU;
        for (int it = gw; it < NITEMS; it += NGW) {
            int r = it;
            if (r < I_IN) { p0_transpose_item(a.in[8], 1024, 2560, (bf16*)(ws + WS_WIN0), scr, r, lane); continue; } r -= I_IN;
            if (r < I_IN) { p0_transpose_item(a.in[24], 1024, 2560, (bf16*)(ws + WS_WIN1), scr, r, lane); continue; } r -= I_IN;
            if (r < I_OUT) { p0_transpose_item(a.in[9], 1024, 1024, (bf16*)(ws + WS_WOUT0), scr, r, lane); continue; } r -= I_OUT;
            if (r < I_OUT) { p0_transpose_item(a.in[25], 1024, 1024, (bf16*)(ws + WS_WOUT1), scr, r, lane); continue; } r -= I_OUT;
            p0_transpose_item(a.in[18], 512, 512, (bf16*)(ws + WS_WGLU), scr, r, lane);
        }
    }
}

__device__ __forceinline__ void phase_modulate0(const Args& a, int lane, int wave, int bid, int G) {
    const float* modv = (const float*)(a.ws + WS_MODV);
    bf16* H = (bf16*)(a.ws + WS_H);
    const int gw = bid * NWAVES + wave, NGW = G * NWAVES;
    for (int r = gw; r < M; r += NGW) {
        const float* z = (r < MLAT) ? a.in[0] + (size_t)r * D : a.in[2] + (size_t)(r - MLAT) * D;
        const float* mv = modv + row_vec(r) * 3072;
#pragma unroll
        for (int j = 0; j < 4; ++j) { const int c = lane * 4 + 256 * j;
            const f32x4 v = *(const f32x4*)(z + c), sh = *(const f32x4*)(mv + c), sc = *(const f32x4*)(mv + D + c);
            const f32x4 h = v * (sc + 1.f) + sh;
            u32x2 o; o.x = pk2(h[0], h[1]); o.y = pk2(h[2], h[3]);
            *(u32x2*)(H + (size_t)r * D + c) = o; }
    }
}

__device__ __forceinline__ int seq_row(int b, int t) { return t < CTXN ? MLAT + b * CTXN + t : b * SEQ + (t - CTXN); }
__device__ __forceinline__ void phase_s5_naive(const Args& a, LAS unsigned char* lds, int lane, int wave, int bid, int G) {
    const int gw = bid * NWAVES + wave;
    if (gw >= 64) return;
    const int b = gw >> 5, g = gw & 31, p = lane, hh = lane & 15;
    const bf16* P = (const bf16*)(a.ws + WS_P); float* YAF = (float*)(a.ws + WS_YAF); bf16* YA1 = (bf16*)(a.ws + WS_YA1);
    const float* A = (const float*)(a.ws + WS_S5A); const float* BB = (const float*)(a.ws + WS_S5BB);
    LAS float* sre = (LAS float*)(lds + wave * 512); LAS float* sim = sre + 64;
    for (int dir = 0; dir < 2; ++dir) {
        const int dg = dir * 32 + g;
        const float ar = A[(dg * 64 + p) * 2], ai = A[(dg * 64 + p) * 2 + 1];
        float bbr[16], bbi[16];
#pragma unroll
        for (int h = 0; h < 16; ++h) { bbr[h] = BB[((dg * 64 + p) * 16 + h) * 2]; bbi[h] = BB[((dg * 64 + p) * 16 + h) * 2 + 1]; }
        const float* cre = a.in[15] + (dg * 16 + hh) * 64; const float* cim = a.in[16] + (dg * 16 + hh) * 64;
        const float dsk = a.in[17][g * 16 + hh];
        float sr = 0.f, si = 0.f;
        for (int j = 0; j < SEQ + CTXN; ++j) {
            const int t = (dir == 0) ? j : (j < CTXN ? CTXN - 1 - j : SEQ + 2 * CTXN - 1 - j);
            const int row = seq_row(b, t);
            const bf16* up = P + (size_t)row * PW + g * 16;
            const u32x4 u0 = *(const u32x4*)up, u1 = *(const u32x4*)(up + 8);
            float u[16];
#pragma unroll
            for (int h = 0; h < 4; ++h) { u[2 * h] = bflo(u0[h]); u[2 * h + 1] = bfhi(u0[h]); u[8 + 2 * h] = bflo(u1[h]); u[8 + 2 * h + 1] = bfhi(u1[h]); }
            float bur = 0.f, bui = 0.f;
#pragma unroll
            for (int h = 0; h < 16; ++h) { bur += bbr[h] * u[h]; bui += bbi[h] * u[h]; }
            const float nr = ar * sr - ai * si + bur, ni = ar * si + ai * sr + bui;
            sr = nr; si = ni;
            sre[p] = sr; sim[p] = si;
            LDS_WAIT();
            if (p < 16) {
                float y = 0.f;
                for (int q = 0; q < 64; ++q) y += cre[q] * sre[q] - cim[q] * sim[q];
                const size_t o = (size_t)row * 512 + g * 16 + p;
                float uo = 0.f;
#pragma unroll
                for (int h = 0; h < 16; ++h) uo = (h == p) ? u[h] : uo;
                if (dir == 0) YAF[o] = y + dsk * uo;
                else YA1[o] = (bf16)f2bf(gelu_tanh_f(YAF[o] + y));
            }
            LDS_WAIT();
        }
    }
}

__device__ __forceinline__ int chunk_row0(int cidx) { const int b = cidx / 66, c = cidx % 66; return c < 2 ? MLAT + b * CTXN + c * 128 : b * SEQ + (c - 2) * 128; }
__device__ __forceinline__ void gmlp_simple_task(const Args& a, LAS unsigned char* lds, int tid, int lane, int wave, int task) {
    const int cidx = task >> 3, h = task & 7, rb = chunk_row0(cidx);
    const bf16* P = (const bf16*)(a.ws + WS_P); bf16* MIX = (bf16*)(a.ws + WS_MIX);
    LAS float* stat = (LAS float*)lds;
    for (int i = 0; i < 16; ++i) { const int row = wave * 16 + i;
        const u32x4 w = *(const u32x4*)(P + (size_t)(rb + row) * PW + 1536 + lane * 8);
        float x[8];
#pragma unroll
        for (int j = 0; j < 4; ++j) { x[2 * j] = bflo(w[j]); x[2 * j + 1] = bfhi(w[j]); }
        float s = 0.f;
#pragma unroll
        for (int j = 0; j < 8; ++j) s += x[j];
        const float mean = wave_sum(s) * (1.f / 512.f); float q = 0.f;
#pragma unroll
        for (int j = 0; j < 8; ++j) { const float d = x[j] - mean; q += d * d; }
        const float rstd = 1.f / sqrtf(wave_sum(q) * (1.f / 512.f) + LN_EPS);
        if (lane == 0) { stat[row * 2] = mean; stat[row * 2 + 1] = rstd; } }
    __syncthreads();
    const int d = tid & 63, qq = tid >> 6, c = h * 64 + d;
    const float lg = a.in[20][c], lb = a.in[21][c];
    const float* ws_ = a.in[22] + (size_t)h * 128 * 128;
    float acc[16];
#pragma unroll
    for (int i = 0; i < 16; ++i) acc[i] = 0.f;
    for (int k = 0; k < 128; ++k) {
        const float vn = (bf2f(P[(size_t)(rb + k) * PW + 1536 + c]) - stat[k * 2]) * stat[k * 2 + 1] * lg + lb;
#pragma unroll
        for (int i = 0; i < 16; ++i) acc[i] += ws_[(qq + 8 * i) * 128 + k] * vn;
    }
#pragma unroll
    for (int i = 0; i < 16; ++i) { const int q = qq + 8 * i; const size_t r = (size_t)(rb + q);
        const float s = acc[i] + a.in[23][h * 128 + q];
        MIX[r * D + 512 + c] = (bf16)f2bf(bf2f(P[r * PW + 1024 + c]) * s * silu_f(bf2f(P[r * PW + 2048 + c]))); }
    __syncthreads();
}

__device__ __forceinline__ void phase_ln0(const Args& a, int lane, int wave, int bid, int G) {
    const float* modv = (const float*)(a.ws + WS_MODV);
    const bf16* Y0 = (const bf16*)(a.ws + WS_P); bf16* H = (bf16*)(a.ws + WS_H); float* Z1C = (float*)(a.ws + WS_Z1C);
    const int gw = bid * NWAVES + wave, NGW = G * NWAVES;
    for (int r = gw; r < M; r += NGW) {
        const float* z = (r < MLAT) ? a.in[0] + (size_t)r * D : a.in[2] + (size_t)(r - MLAT) * D;
        float* zo = (r < MLAT) ? a.out + (size_t)r * D : Z1C + (size_t)(r - MLAT) * D;
        const int vec = row_vec(r);
        const float* g0 = modv + vec * 3072 + 2 * D; const float* mv1 = modv + (3 + vec) * 3072;
        f32x4 v[4]; float s = 0.f;
#pragma unroll
        for (int j = 0; j < 4; ++j) { const int c = lane * 4 + 256 * j;
            const f32x4 zz = *(const f32x4*)(z + c), gg = *(const f32x4*)(g0 + c); const u32x2 yw = *(const u32x2*)(Y0 + (size_t)r * D + c);
            f32x4 y; y[0] = bflo(yw.x); y[1] = bfhi(yw.x); y[2] = bflo(yw.y); y[3] = bfhi(yw.y);
            v[j] = zz * ALPHA + y * gg; s += (v[j][0] + v[j][1]) + (v[j][2] + v[j][3]); }
        const float mean = wave_sum(s) * (1.f / D); float q = 0.f;
#pragma unroll
        for (int j = 0; j < 4; ++j) { v[j] = v[j] - mean; q += (v[j][0] * v[j][0] + v[j][1] * v[j][1]) + (v[j][2] * v[j][2] + v[j][3] * v[j][3]); }
        const float rstd = 1.f / sqrtf(wave_sum(q) * (1.f / D) + LN_EPS);
#pragma unroll
        for (int j = 0; j < 4; ++j) { const int c = lane * 4 + 256 * j;
            const f32x4 z1 = v[j] * rstd * *(const f32x4*)(a.in[6] + c) + *(const f32x4*)(a.in[7] + c);
            *(f32x4*)(zo + c) = z1;
            const f32x4 h = z1 * (*(const f32x4*)(mv1 + D + c) + 1.f) + *(const f32x4*)(mv1 + c);
            u32x2 o; o.x = pk2(h[0], h[1]); o.y = pk2(h[2], h[3]);
            *(u32x2*)(H + (size_t)r * D + c) = o; }
    }
}
__device__ __forceinline__ void phase_ln1(const Args& a, int lane, int wave, int bid, int G) {
    const float* modv = (const float*)(a.ws + WS_MODV);
    const bf16* Y1 = (const bf16*)(a.ws + WS_H);
    const int gw = bid * NWAVES + wave, NGW = G * NWAVES;
    for (int r = gw; r < MLAT; r += NGW) {
        float* zo = a.out + (size_t)r * D;
        const float* g1 = modv + (3 + (r >> 13)) * 3072 + 2 * D;
        f32x4 v[4]; float s = 0.f;
#pragma unroll
        for (int j = 0; j < 4; ++j) { const int c = lane * 4 + 256 * j;
            const f32x4 zz = *(const f32x4*)(zo + c), gg = *(const f32x4*)(g1 + c); const u32x2 yw = *(const u32x2*)(Y1 + (size_t)r * D + c);
            f32x4 y; y[0] = bflo(yw.x); y[1] = bfhi(yw.x); y[2] = bflo(yw.y); y[3] = bfhi(yw.y);
            v[j] = zz * ALPHA + y * gg; s += (v[j][0] + v[j][1]) + (v[j][2] + v[j][3]); }
        const float mean = wave_sum(s) * (1.f / D); float q = 0.f;
#pragma unroll
        for (int j = 0; j < 4; ++j) { v[j] = v[j] - mean; q += (v[j][0] * v[j][0] + v[j][1] * v[j][1]) + (v[j][2] * v[j][2] + v[j][3] * v[j][3]); }
        const float rstd = 1.f / sqrtf(wave_sum(q) * (1.f / D) + LN_EPS);
#pragma unroll
        for (int j = 0; j < 4; ++j) { const int c = lane * 4 + 256 * j;
            *(f32x4*)(zo + c) = v[j] * rstd * *(const f32x4*)(a.in[6] + D + c) + *(const f32x4*)(a.in[7] + D + c); }
    }
}

__device__ __forceinline__ void phase_attn_simple(const Args& a, int lane, int wave, int bid, int G) {
    const bf16* P = (const bf16*)(a.ws + WS_P); bf16* MIX = (bf16*)(a.ws + WS_MIX);
    const int sub = lane & 3, hq = lane >> 2, kvh = hq >> 2;
    const float sk2 = a.in[26][hq] * LOG2E;
    const int gw = bid * NWAVES + wave, NGW = G * NWAVES;
    for (int r = gw; r < MLAT; r += NGW) {
        const int b = r >> 13, t = r & 8191;
        float q[16];
        { const bf16* qp = P + (size_t)r * PW + hq * 64 + sub * 16; const u32x4 w0 = *(const u32x4*)qp, w1 = *(const u32x4*)(qp + 8);
#pragma unroll
          for (int j = 0; j < 4; ++j) { q[2 * j] = bflo(w0[j]); q[2 * j + 1] = bfhi(w0[j]); q[8 + 2 * j] = bflo(w1[j]); q[8 + 2 * j + 1] = bfhi(w1[j]); } }
        const int lo = t - 128 < 0 ? 0 : t - 128, hi = t + 128 > SEQ - 1 ? SEQ - 1 : t + 128;
        const int nk = CTXN + (hi - lo + 1);
        const bf16* kc = P + (size_t)(MLAT + b * CTXN) * PW + 1024 + kvh * 64 + sub * 16;
        const bf16* kl = P + (size_t)(b * SEQ + lo) * PW + 1024 + kvh * 64 + sub * 16;
        float mx = sk2;
        for (int i = 0; i < nk; ++i) { const bf16* kp = (i < CTXN) ? kc + (size_t)i * PW : kl + (size_t)(i - CTXN) * PW;
            const u32x4 w0 = *(const u32x4*)kp, w1 = *(const u32x4*)(kp + 8); float s = 0.f;
#pragma unroll
            for (int j = 0; j < 4; ++j) { s += q[2 * j] * bflo(w0[j]) + q[2 * j + 1] * bfhi(w0[j]); s += q[8 + 2 * j] * bflo(w1[j]) + q[8 + 2 * j + 1] * bfhi(w1[j]); }
            s += __shfl_xor(s, 1); s += __shfl_xor(s, 2);
            mx = fmaxf(mx, s); }
        float l = exp2f(sk2 - mx);
        float o[16];
#pragma unroll
        for (int j = 0; j < 16; ++j) o[j] = 0.f;
        for (int i = 0; i < nk; ++i) { const bf16* kp = (i < CTXN) ? kc + (size_t)i * PW : kl + (size_t)(i - CTXN) * PW;
            const u32x4 w0 = *(const u32x4*)kp, w1 = *(const u32x4*)(kp + 8); float s = 0.f;
#pragma unroll
            for (int j = 0; j < 4; ++j) { s += q[2 * j] * bflo(w0[j]) + q[2 * j + 1] * bfhi(w0[j]); s += q[8 + 2 * j] * bflo(w1[j]) + q[8 + 2 * j + 1] * bfhi(w1[j]); }
            s += __shfl_xor(s, 1); s += __shfl_xor(s, 2);
            const float pr = exp2f(s - mx); l += pr;
            const u32x4 v0 = *(const u32x4*)(kp + 256), v1 = *(const u32x4*)(kp + 264);
#pragma unroll
            for (int j = 0; j < 4; ++j) { o[2 * j] += pr * bflo(v0[j]); o[2 * j + 1] += pr * bfhi(v0[j]); o[8 + 2 * j] += pr * bflo(v1[j]); o[8 + 2 * j + 1] += pr * bfhi(v1[j]); } }
        const float rl = 1.f / l;
        const bf16* gp = P + (size_t)r * PW + 1536 + hq * 64 + sub * 16;
        const u32x4 g0 = *(const u32x4*)gp, g1 = *(const u32x4*)(gp + 8);
        u32x4 w0, w1;
#pragma unroll
        for (int j = 0; j < 4; ++j) { w0[j] = pk2(o[2 * j] * rl * silu_f(bflo(g0[j])), o[2 * j + 1] * rl * silu_f(bfhi(g0[j])));
                                      w1[j] = pk2(o[8 + 2 * j] * rl * silu_f(bflo(g1[j])), o[8 + 2 * j + 1] * rl * silu_f(bfhi(g1[j]))); }
        bf16* op = MIX + (size_t)r * D + hq * 64 + sub * 16;
        *(u32x4*)op = w0; *(u32x4*)(op + 8) = w1;
    }
}

__global__ void __launch_bounds__(NTHREADS, 2) mega_fwd(Args a) {
    extern __shared__ __attribute__((aligned(16))) unsigned char lds_raw[];
    LAS unsigned char* lds = (LAS unsigned char*)lds_raw;
    cg::grid_group grid = cg::this_grid();
    const int tid = threadIdx.x, lane = tid & 63, wave = __builtin_amdgcn_readfirstlane(tid >> 6), bid = blockIdx.x, G = gridDim.x;
    unsigned char* ws = a.ws;
    bf16* H = (bf16*)(ws + WS_H); bf16* P = (bf16*)(ws + WS_P); bf16* MIX = (bf16*)(ws + WS_MIX); bf16* YA1 = (bf16*)(ws + WS_YA1);

    phase_prologue(a, lds, tid, lane, wave, bid, G);
    grid.sync();
    phase_modulate0(a, lane, wave, bid, G);
    grid.sync();
    {
        pg8::Gemm g{H, (const bf16*)(ws + WS_WIN0), M, PW, D}; pg8::StaticOrder S; S.init(M, PW, G, bid);
        pg8::EpiBf16<0> E{P, PW, nullptr, 0, 0, 1.f};
        pg8::gemm_phase<pg8::EpiBf16<0>, pg8::StaticOrder, true, true>(lds, g, S, E);
    }
    grid.sync();
    phase_s5_naive(a, lds, lane, wave, bid, G);
    grid.sync();
    {
        pg8::Gemm g{YA1, (const bf16*)(ws + WS_WGLU), M, 512, 512}; pg8::StaticOrder S; S.init(M, 512, G, bid);
        pg8::EpiGlu E{YA1, P, a.in[19], MIX};
        pg8::gemm_phase<pg8::EpiGlu, pg8::StaticOrder, true, true>(lds, g, S, E);
        const int nfree = G - 132;
        if (bid >= 132) for (int task = bid - 132; task < 132 * 8; task += nfree) gmlp_simple_task(a, lds, tid, lane, wave, task);
    }
    grid.sync();
    {
        pg8::Gemm g{MIX, (const bf16*)(ws + WS_WOUT0), M, D, D}; pg8::StaticOrder S; S.init(M, D, G, bid);
        pg8::EpiBf16<0> E{P, D, nullptr, 0, 0, 1.f};
        pg8::gemm_phase<pg8::EpiBf16<0>, pg8::StaticOrder, true, true>(lds, g, S, E);
    }
    grid.sync();
    phase_ln0(a, lane, wave, bid, G);
    grid.sync();
    {
        pg8::Gemm g{H, (const bf16*)(ws + WS_WIN1), M, PW, D}; pg8::StaticOrder S; S.init(M, PW, G, bid);
        pg8::EpiRope E{P, (const float*)(ws + WS_ROPE), QSCALE};
        pg8::gemm_phase<pg8::EpiRope, pg8::StaticOrder, true, true>(lds, g, S, E);
    }
    grid.sync();
    phase_attn_simple(a, lane, wave, bid, G);
    grid.sync();
    {
        pg8::Gemm g{MIX, (const bf16*)(ws + WS_WOUT1), MLAT, D, D}; pg8::StaticOrder S; S.init(MLAT, D, G, bid);
        pg8::EpiBf16<0> E{H, D, nullptr, 0, 0, 1.f};
        pg8::gemm_phase<pg8::EpiBf16<0>, pg8::StaticOrder, true, true>(lds, g, S, E);
    }
    grid.sync();
    phase_ln1(a, lane, wave, bid, G);
}

extern "C" void kernel_launch(void* const* d_in, const int* in_sizes, int n_in, void* d_out, int out_size, void* d_ws, size_t ws_size, hipStream_t stream) {
    static int grid = 0;
    if (grid == 0) {
        int dev = 0, cus = 0, per_cu = 0;
        hipGetDevice(&dev);
        hipDeviceGetAttribute(&cus, hipDeviceAttributeMultiprocessorCount, dev);
        hipFuncSetAttribute((const void*)mega_fwd, hipFuncAttributeMaxDynamicSharedMemorySize, LDS_BYTES);
        hipOccupancyMaxActiveBlocksPerMultiprocessor(&per_cu, (const void*)mega_fwd, NTHREADS, LDS_BYTES);
        if (per_cu < 1) { fprintf(stderr, "kernel_launch: occupancy query says %d blocks per CU\n", per_cu); per_cu = 1; }
        grid = cus;
        (void)hipGetLastError();
    }
    Args a{};
    for (int i = 0; i < 27; ++i) a.in[i] = (const float*)d_in[i];
    a.out = (float*)d_out; a.ws = (unsigned char*)d_ws;
    void* args[] = {&a};
    hipError_t e = hipLaunchCooperativeKernel((const void*)mega_fwd, dim3(grid), dim3(NTHREADS), args, LDS_BYTES, stream);
    if (e != hipSuccess) fprintf(stderr, "cooperative launch failed: %s (grid %d)\n", hipGetErrorString(e), grid);
}
```

```cpp
#include <hip/hip_runtime.h>
#include <hip/hip_cooperative_groups.h>
#include <cstdio>
#include <cstdint>
namespace cg = cooperative_groups;
namespace pg8 {
#define PG8_LAS __attribute__((address_space(3)))
typedef unsigned short bf16_t;
typedef short bf16x8 __attribute__((ext_vector_type(8)));
typedef float f32x4 __attribute__((ext_vector_type(4)));
typedef unsigned u32x4 __attribute__((ext_vector_type(4)));
constexpr int BM = 256, BK = 64, HALF = 128, HTB = HALF * BK * 2  , STAGE_BYTES = 8 * HTB, NXCD = 8, WGM = 8;

__host__ __device__ __forceinline__ int lds_byte(int r, int c) { const int st = (r >> 4) * 2 + (c >> 5), rr = r & 15, cc = c & 31, ob = rr * 64 + cc * 2; return st * 1024 + (ob ^ (((ob >> 9) & 1) << 5)); }
__host__ __device__ __forceinline__ void stage_rc(int b, int& R, int& C) { const int st = b / 1024, sb = b % 1024, swz = sb ^ (((sb >> 9) & 1) << 5); R = (st >> 1) * 16 + swz / 64; C = (st & 1) * 32 + (swz % 64) / 2; }
__host__ __device__ __forceinline__ int perm32(int rho) { const int n = rho >> 4, i = rho & 15; return 8 * (i >> 2) + 4 * n + (i & 3); }

struct Unit { int pm, pn; };
struct Gemm { const bf16_t* A; const bf16_t* Bt; int M, N, K; };

struct StaticOrder {
    int nM, nN, nwg, G, c;
    __host__ __device__ void init(int M, int N, int G_, int c_) { nM = M / BM; nN = N / BM; nwg = nM * nN; G = G_; c = c_; }
    __host__ __device__ bool next(int i, Unit& u) const {
        const long L = (long)i * G + c; if (L >= nwg) return false;
        int wgid = (int)L; { const int q = nwg / NXCD, r = nwg % NXCD, xcd = wgid % NXCD, off = wgid / NXCD; wgid = (xcd < r ? xcd * (q + 1) : r * (q + 1) + (xcd - r) * q) + off; }
        const int nig = WGM * nN, gid = wgid / nig, fm = gid * WGM, gsz = (nM - fm) < WGM ? (nM - fm) : WGM;
        u.pm = fm + ((wgid % nig) % gsz); u.pn = (wgid % nig) / gsz; return true;
    }
    __device__ __forceinline__ void a_ready(const Unit&) const {}
    __device__ __forceinline__ void done(const Unit&) const {}
};

__device__ __forceinline__ unsigned cvt_pk_bf16(float lo, float hi) { unsigned r; asm volatile("v_cvt_pk_bf16_f32 %0, %1, %2" : "=v"(r) : "v"(lo), "v"(hi)); return r; }
typedef float f32x2 __attribute__((ext_vector_type(2)));
__device__ __forceinline__ f32x2 gelu_pk(f32x2 v) {
    const f32x2 av = __builtin_elementwise_abs(v), d = av * 0.2316418882f + 1.0f;
    f32x2 t; t.x = __builtin_amdgcn_rcpf(d.x); t.y = __builtin_amdgcn_rcpf(d.y);
    f32x2 q = t * 0.5307027145f + (-0.7265760135f); q = q * t + 0.7107068705f; q = q * t + (-0.142248368f); q = q * t + 0.127414796f; q = q * t;
    const f32x2 s = (v * v) * (-0.72134752044f);
    f32x2 e; e.x = __builtin_amdgcn_exp2f(s.x); e.y = __builtin_amdgcn_exp2f(s.y);
    const f32x2 m = v * (q * e), r = v - m;
    f32x2 o; o.x = v.x < 0.f ? m.x : r.x; o.y = v.y < 0.f ? m.y : r.y; return o;
}

template <int ACT  > struct EpiBf16 {
    static constexpr bool PERM = true, AFTER_DRAIN = false; static_assert(ACT == 0 || ACT == 1, "EpiBf16: ACT is 0 (none) or 1 (gelu_pk)");
    bf16_t* O; int ldc; const float* bias; int split_cols; size_t split_stride; float scale0;
    __device__ __forceinline__ void operator()(const f32x4 (&acc)[2][2][4][2], const Unit& u, int wr, int wc, int fr, int fq) const {
        const int row0 = u.pm * BM + wr * 64 + fr; int colt = u.pn * BM; bf16_t* base = O;
        float sc = 1.f; if (split_cols) { const int t = colt / split_cols; base += (size_t)t * split_stride; colt -= t * split_cols; if (t == 0) sc = scale0; }
        const int col0 = colt + wc * 32 + 8 * fq, bcol0 = u.pn * BM + wc * 32 + 8 * fq;
        f32x4 bv[2][2];
#pragma unroll
        for (int bj = 0; bj < 2; ++bj)
#pragma unroll
            for (int n = 0; n < 2; ++n) bv[bj][n] = bias ? *(const f32x4*)(bias + bcol0 + bj * HALF + 4 * n) : (f32x4){0.f, 0.f, 0.f, 0.f};
#pragma unroll
        for (int ai = 0; ai < 2; ++ai)
#pragma unroll
            for (int m = 0; m < 4; ++m) { bf16_t* rowp = base + (size_t)(row0 + ai * HALF + m * 16) * ldc + col0;
#pragma unroll
                for (int bj = 0; bj < 2; ++bj) { f32x4 v0 = acc[ai][bj][m][0] + bv[bj][0], v1 = acc[ai][bj][m][1] + bv[bj][1];
                    if (ACT == 1) { f32x2 a = gelu_pk((f32x2){v0[0], v0[1]}), b = gelu_pk((f32x2){v0[2], v0[3]}), c = gelu_pk((f32x2){v1[0], v1[1]}), d = gelu_pk((f32x2){v1[2], v1[3]});
                        v0 = (f32x4){a.x, a.y, b.x, b.y}; v1 = (f32x4){c.x, c.y, d.x, d.y}; }
                    v0 = v0 * sc; v1 = v1 * sc; u32x4 w; w.x = cvt_pk_bf16(v0[0], v0[1]); w.y = cvt_pk_bf16(v0[2], v0[3]); w.z = cvt_pk_bf16(v1[0], v1[1]); w.w = cvt_pk_bf16(v1[2], v1[3]);
                    *(u32x4*)(rowp + bj * HALF) = w; } }
    }
};
}
namespace pg8 {
__device__ __forceinline__ float bf2f_(unsigned short h) { return __builtin_bit_cast(float, (unsigned)h << 16); }
__device__ __forceinline__ float sigm_(float v) { return 1.f / (1.f + __expf(-v)); }
struct EpiGlu {
    static constexpr bool PERM = true, AFTER_DRAIN = false;
    const bf16_t* ya1; const bf16_t* P; const float* glu_b; bf16_t* mix;
    __device__ __forceinline__ void operator()(const f32x4 (&acc)[2][2][4][2], const Unit& u, int wr, int wc, int fr, int fq) const {
        const int row0 = u.pm * BM + wr * 64 + fr, col0 = u.pn * BM + wc * 32 + 8 * fq;
#pragma unroll
        for (int ai = 0; ai < 2; ++ai)
#pragma unroll
            for (int m = 0; m < 4; ++m) { const size_t row = (size_t)(row0 + ai * HALF + m * 16);
#pragma unroll
                for (int bj = 0; bj < 2; ++bj) { const int col = col0 + bj * HALF;
                    const f32x4 b0 = *(const f32x4*)(glu_b + col), b1 = *(const f32x4*)(glu_b + col + 4);
                    const u32x4 yw = *(const u32x4*)(ya1 + row * 512 + col), gw = *(const u32x4*)(P + row * 2560 + 512 + col);
                    float o[8];
#pragma unroll
                    for (int j = 0; j < 8; ++j) { const float a = (j < 4) ? acc[ai][bj][m][0][j] + b0[j] : acc[ai][bj][m][1][j - 4] + b1[j - 4];
                        const unsigned ywj = yw[j >> 1], gwj = gw[j >> 1];
                        const float y = bf2f_((unsigned short)((j & 1) ? (ywj >> 16) : (ywj & 0xffffu))), g = bf2f_((unsigned short)((j & 1) ? (gwj >> 16) : (gwj & 0xffffu)));
                        o[j] = y * sigm_(a) * (g * sigm_(g)); }
                    u32x4 w; w.x = cvt_pk_bf16(o[0], o[1]); w.y = cvt_pk_bf16(o[2], o[3]); w.z = cvt_pk_bf16(o[4], o[5]); w.w = cvt_pk_bf16(o[6], o[7]);
                    *(u32x4*)(mix + row * 1024 + col) = w; } }
    }
};
struct EpiRope {
    static constexpr bool PERM = true, AFTER_DRAIN = false;
    bf16_t* O; const float* cs; float qscale;
    __device__ __forceinline__ void operator()(const f32x4 (&acc)[2][2][4][2], const Unit& u, int wr, int wc, int fr, int fq) const {
        const int row0 = u.pm * BM + wr * 64 + fr, col0 = u.pn * BM + wc * 32 + 8 * fq;
        const bool rope = (u.pm < 64) && (u.pn <= 4);
        const float sc = (u.pn < 4) ? qscale : 1.f;
        const float sgn = (fq < 2) ? -1.f : 1.f;
#pragma unroll
        for (int ai = 0; ai < 2; ++ai)
#pragma unroll
            for (int m = 0; m < 4; ++m) { const int row = row0 + ai * HALF + m * 16; const int t = row & 8191; const int pos = (wc & 1) ? (t & 63) : (t >> 6);
                f32x4 c4[4];
                if (rope) {
#pragma unroll
                    for (int j = 0; j < 4; ++j) c4[j] = *(const f32x4*)(cs + (pos * 16 + 8 * (fq & 1)) * 2 + 4 * j); }
#pragma unroll
                for (int bj = 0; bj < 2; ++bj) { float o[8];
#pragma unroll
                    for (int j = 0; j < 8; ++j) { float v = (j < 4) ? acc[ai][bj][m][0][j] : acc[ai][bj][m][1][j - 4];
                        if (rope) { const float pv = __shfl_xor(v, 32); const float co = c4[j >> 1][(j & 1) * 2], si = c4[j >> 1][(j & 1) * 2 + 1]; v = v * co + sgn * pv * si; }
                        o[j] = v * sc; }
                    u32x4 w; w.x = cvt_pk_bf16(o[0], o[1]); w.y = cvt_pk_bf16(o[2], o[3]); w.z = cvt_pk_bf16(o[4], o[5]); w.w = cvt_pk_bf16(o[6], o[7]);
                    *(u32x4*)(O + (size_t)row * 2560 + col0 + bj * HALF) = w; } }
    }
};
}
namespace pg8 {
template <class Epi, class Sched, bool ALIGN_EPI = false, bool SP2 = false>
__device__ __forceinline__ void gemm_phase(PG8_LAS unsigned char* lds, const Gemm g, const Sched& S, const Epi& E) {
    const int tid = threadIdx.x, wid = __builtin_amdgcn_readfirstlane(tid >> 6), lane = tid & 63, wr = wid >> 2, wc = wid & 3, fr = lane & 15, fq = lane >> 4;
    const int K = g.K, nt = K / BK;
    unsigned voffA[2], voffB[2];
#pragma unroll
    for (int i = 0; i < 2; ++i) { int R, C; stage_rc(tid * 16 + i * 8192, R, C); const int Rb = Epi::PERM ? ((R & ~31) + perm32(R & 31)) : R;
        voffA[i] = (unsigned)(R * K + C) * 2u; voffB[i] = (unsigned)(Rb * K + C) * 2u; }
    const size_t kstep = (size_t)(BK * 2);
    const size_t hstep = (size_t)HALF * K * 2;
    const size_t tstep = 2 * hstep;
    const unsigned ldsw = (unsigned)wid * 1024u;
    const int aoff = lds_byte(wr * 64 + fr, fq * 8), boff = lds_byte(wc * 32 + fr, fq * 8);
#define PG8_SA(b, h) (((b) * 2 + (h)) * HTB)
#define PG8_SB(b, h) ((4 + (b) * 2 + (h)) * HTB)
#define PG8_STAGE(bufoff, gbase, voff) do { _Pragma("unroll") for (int _i = 0; _i < 2; ++_i) \
        __builtin_amdgcn_global_load_lds((const unsigned*)((const char*)(gbase) + (voff)[_i]), (PG8_LAS unsigned*)(lds + (bufoff) + ldsw + _i * 8192), 16, 0, 0); } while (0)
#define PG8_LDA(dst, b, h) do { _Pragma("unroll") for (int m = 0; m < 4; ++m) _Pragma("unroll") for (int k = 0; k < 2; ++k) dst[m][k] = *(const PG8_LAS bf16x8*)(lds + PG8_SA(b, h) + aoff + m * 2048 + k * 1024); } while (0)
#define PG8_LDB(dst, b, h) do { _Pragma("unroll") for (int n = 0; n < 2; ++n) _Pragma("unroll") for (int k = 0; k < 2; ++k) dst[n][k] = *(const PG8_LAS bf16x8*)(lds + PG8_SB(b, h) + boff + n * 2048 + k * 1024); } while (0)
#define PG8_MMA(ai, bj, At, Bt) do { __builtin_amdgcn_s_setprio(1); _Pragma("unroll") for (int m = 0; m < 4; ++m) _Pragma("unroll") for (int n = 0; n < 2; ++n) _Pragma("unroll") for (int k = 0; k < 2; ++k) \
        acc[ai][bj][m][n] = __builtin_amdgcn_mfma_f32_16x16x32_bf16(Bt[n][k], At[m][k], acc[ai][bj][m][n], 0, 0, 0); __builtin_amdgcn_s_setprio(0); } while (0)
#define PG8_WAIT_V(n) asm volatile("s_waitcnt vmcnt(" #n ")" ::: "memory")
#define PG8_WAIT_L(n) asm volatile("s_waitcnt lgkmcnt(" #n ")" ::: "memory")
#define PG8_BAR __builtin_amdgcn_s_barrier()
#define PG8_SCHED __builtin_amdgcn_sched_barrier(0)
    Unit cur, nxt; int ui = 0;
    if (!S.next(0, cur)) return;
    f32x4 acc[2][2][4][2];
#pragma unroll
    for (int a = 0; a < 2; ++a)
#pragma unroll
        for (int b = 0; b < 2; ++b)
#pragma unroll
            for (int m = 0; m < 4; ++m)
#pragma unroll
                for (int n = 0; n < 2; ++n) acc[a][b][m][n] = (f32x4){0.f, 0.f, 0.f, 0.f};
    bf16x8 At[4][2], B0[2][2], B1[2][2];
    const char* cA = (const char*)g.A + (size_t)cur.pm * tstep; const char* cB = (const char*)g.Bt + (size_t)cur.pn * tstep;
    S.a_ready(cur);
    if constexpr (SP2) {
        PG8_STAGE(PG8_SB(0, 0), cB, voffB); PG8_STAGE(PG8_SB(0, 1), cB + hstep, voffB); PG8_STAGE(PG8_SA(0, 0), cA, voffA); PG8_STAGE(PG8_SA(0, 1), cA + hstep, voffA);
        if (wr == 1) PG8_BAR;
        PG8_WAIT_V(2); PG8_BAR;
        PG8_STAGE(PG8_SB(1, 0), cB + kstep, voffB); PG8_STAGE(PG8_SA(1, 0), cA + kstep, voffA); PG8_STAGE(PG8_SB(1, 1), cB + hstep + kstep, voffB);
        PG8_WAIT_V(6); PG8_BAR;
    } else {
        PG8_STAGE(PG8_SB(0, 0), cB, voffB); PG8_STAGE(PG8_SA(0, 0), cA, voffA); PG8_STAGE(PG8_SB(0, 1), cB + hstep, voffB); PG8_STAGE(PG8_SA(0, 1), cA + hstep, voffA);
        if (wr == 1) PG8_BAR;
        PG8_WAIT_V(4); PG8_BAR;
        PG8_STAGE(PG8_SB(1, 0), cB + kstep, voffB); PG8_STAGE(PG8_SA(1, 0), cA + kstep, voffA); PG8_STAGE(PG8_SB(1, 1), cB + hstep + kstep, voffB);
        PG8_WAIT_V(6); PG8_BAR;
    }
    for (;;) {
        const bool has_next = S.next(ui + 1, nxt);
        const char* nA = has_next ? (const char*)g.A + (size_t)nxt.pm * tstep : cA; const char* nB = has_next ? (const char*)g.Bt + (size_t)nxt.pn * tstep : cB;
        for (int t = 0; t < nt; t += 2) {
            const bool last = (t == nt - 2);
            const char* a1 = cA + (size_t)(t + 1) * kstep;
            const char* a2 = last ? nA : cA + (size_t)(t + 2) * kstep; const char* b2 = last ? nB : cB + (size_t)(t + 2) * kstep;
            const char* a3 = a2 + kstep; const char* b3 = b2 + kstep;
            if (last && has_next) S.a_ready(nxt);
            if constexpr (SP2) {
            PG8_LDB(B0, 0, 0); PG8_LDB(B1, 0, 1); PG8_SCHED; PG8_LDA(At, 0, 0); PG8_STAGE(PG8_SA(1, 1), a1 + hstep, voffA);
            PG8_WAIT_V(8); PG8_WAIT_L(0); PG8_BAR; PG8_MMA(0, 0, At, B0); PG8_MMA(0, 1, At, B1); PG8_BAR; PG8_SCHED;
            PG8_LDA(At, 0, 1); PG8_STAGE(PG8_SB(0, 0), b2, voffB); PG8_STAGE(PG8_SB(0, 1), b2 + hstep, voffB); PG8_STAGE(PG8_SA(0, 0), a2, voffA);
            PG8_WAIT_V(8); PG8_WAIT_L(0); PG8_BAR; PG8_MMA(1, 0, At, B0); PG8_MMA(1, 1, At, B1); PG8_BAR; PG8_SCHED;
            PG8_LDB(B0, 1, 0); PG8_LDB(B1, 1, 1); PG8_SCHED; PG8_LDA(At, 1, 0); PG8_STAGE(PG8_SA(0, 1), a2 + hstep, voffA);
            PG8_WAIT_V(8); PG8_WAIT_L(0); PG8_BAR; PG8_MMA(0, 0, At, B0); PG8_MMA(0, 1, At, B1); PG8_BAR; PG8_SCHED;
            PG8_LDA(At, 1, 1); PG8_STAGE(PG8_SB(1, 0), b3, voffB); PG8_STAGE(PG8_SB(1, 1), b3 + hstep, voffB); PG8_STAGE(PG8_SA(1, 0), a3, voffA);
            PG8_WAIT_V(8); PG8_WAIT_L(0); PG8_BAR; PG8_MMA(1, 0, At, B0); PG8_MMA(1, 1, At, B1); PG8_BAR; PG8_SCHED;
            } else {
            PG8_LDB(B0, 0, 0); PG8_SCHED; PG8_LDA(At, 0, 0); PG8_STAGE(PG8_SA(1, 1), a1 + hstep, voffA);
            PG8_WAIT_L(8); PG8_BAR; PG8_WAIT_L(0); PG8_MMA(0, 0, At, B0); PG8_BAR; PG8_SCHED;
            PG8_LDB(B1, 0, 1); PG8_STAGE(PG8_SB(0, 0), b2, voffB);
            PG8_BAR; PG8_WAIT_L(0); PG8_MMA(0, 1, At, B1); PG8_BAR;
            PG8_LDA(At, 0, 1); PG8_STAGE(PG8_SA(0, 0), a2, voffA);
            PG8_BAR; PG8_WAIT_L(0); PG8_MMA(1, 0, At, B0); PG8_BAR; PG8_SCHED;
            PG8_STAGE(PG8_SB(0, 1), b2 + hstep, voffB);
            PG8_WAIT_V(6); PG8_BAR; PG8_MMA(1, 1, At, B1); PG8_BAR;
            PG8_LDB(B0, 1, 0); PG8_SCHED; PG8_LDA(At, 1, 0); PG8_STAGE(PG8_SA(0, 1), a2 + hstep, voffA);
            PG8_WAIT_L(8); PG8_BAR; PG8_WAIT_L(0); PG8_MMA(0, 0, At, B0); PG8_BAR; PG8_SCHED;
            PG8_LDB(B1, 1, 1); PG8_STAGE(PG8_SB(1, 0), b3, voffB);
            PG8_BAR; PG8_WAIT_L(0); PG8_MMA(0, 1, At, B1); PG8_BAR;
            PG8_LDA(At, 1, 1); PG8_STAGE(PG8_SA(1, 0), a3, voffA);
            PG8_BAR; PG8_WAIT_L(0); PG8_MMA(1, 0, At, B0); PG8_BAR; PG8_SCHED;
            PG8_STAGE(PG8_SB(1, 1), b3 + hstep, voffB);
            PG8_WAIT_V(6); PG8_BAR; PG8_MMA(1, 1, At, B1); PG8_BAR;
            }
        }
        if constexpr (ALIGN_EPI) { if (wr == 0) PG8_BAR; }
        if constexpr (!Epi::AFTER_DRAIN) { E(acc, cur, wr, wc, fr, fq); S.done(cur); }
        if (!has_next) break;
#pragma unroll
        for (int a = 0; a < 2; ++a)
#pragma unroll
            for (int b = 0; b < 2; ++b)
#pragma unroll
                for (int m = 0; m < 4; ++m)
#pragma unroll
                    for (int n = 0; n < 2; ++n) acc[a][b][m][n] = (f32x4){0.f, 0.f, 0.f, 0.f};
        cur = nxt; cA = nA; cB = nB; ++ui;
        if constexpr (ALIGN_EPI) { if (wr == 1) PG8_BAR; }
    }
    PG8_WAIT_V(0);
    if constexpr (!ALIGN_EPI) { if (wr == 0) PG8_BAR; }
    PG8_BAR;
    if constexpr (Epi::AFTER_DRAIN) { E.fused(acc, cur, wr, wc, fr, fq, lds, wid, lane); S.done(cur); }
#undef PG8_SA
#undef PG8_SB
#undef PG8_STAGE
#undef PG8_LDA
#undef PG8_LDB
#undef PG8_MMA
#undef PG8_WAIT_V
#undef PG8_WAIT_L
#undef PG8_BAR
#undef PG8_SCHED
}
}
#ifndef S5_CHECK
#define S5_CHECK 0
#endif
constexpr int D = 1024, SEQ = 8192, CTXN = 256, MLAT = 16384, MCTX = 512, M = MLAT + MCTX, PW = 2560;
constexpr float ALPHA = 1.41421356237309515f, LN_EPS = 1e-5f;
constexpr float LOG2E = 1.4426950408889634f, QSCALE = 0.125f * 1.4426950408889634f;
constexpr int NWAVES = 8, NTHREADS = 512;
constexpr int LDS_BYTES = 147456;
constexpr size_t MiB = 1u << 20;
constexpr size_t WS_MODV = 1 * MiB;
constexpr size_t WS_ROPE = 1 * MiB + 256 * 1024;
constexpr size_t WS_S5A = 1 * MiB + 512 * 1024;
constexpr size_t WS_S5A128 = 1 * MiB + 512 * 1024 + 32 * 1024;
constexpr size_t WS_BBT = 2 * MiB;
constexpr size_t WS_CT = 2 * MiB + 256 * 1024;
constexpr size_t WS_S5BB = 2 * MiB + 512 * 1024;
constexpr size_t WS_E = 3 * MiB;
constexpr size_t WS_WIN0 = 8 * MiB, WS_WOUT0 = 13 * MiB, WS_WGLU = 15 * MiB, WS_WIN1 = 16 * MiB, WS_WOUT1 = 21 * MiB;
constexpr size_t WS_H = 24 * MiB;
constexpr size_t WS_P = 57 * MiB;
constexpr size_t WS_MIX = 140 * MiB;
constexpr size_t WS_YA1 = 173 * MiB;
constexpr size_t WS_Z1C = 190 * MiB;
constexpr size_t WS_YAF = 192 * MiB;

typedef unsigned short bf16;
typedef float f32x4 __attribute__((ext_vector_type(4)));
typedef unsigned u32x2 __attribute__((ext_vector_type(2)));
typedef unsigned u32x4 __attribute__((ext_vector_type(4)));
#define LAS __attribute__((address_space(3)))
__device__ __forceinline__ unsigned f2bf(float f) { unsigned u = __builtin_bit_cast(unsigned, f); return (u + 0x7fffu + ((u >> 16) & 1u)) >> 16; }
__device__ __forceinline__ unsigned pk2(float lo, float hi) { return f2bf(lo) | (f2bf(hi) << 16); }
__device__ __forceinline__ float bf2f(unsigned h) { return __builtin_bit_cast(float, h << 16); }
__device__ __forceinline__ float bflo(unsigned w) { return __builtin_bit_cast(float, w << 16); }
__device__ __forceinline__ float bfhi(unsigned w) { return __builtin_bit_cast(float, w & 0xffff0000u); }
__device__ __forceinline__ float silu_f(float v) { return v / (1.f + __expf(-v)); }
__device__ __forceinline__ float gelu_tanh_f(float v) { const float u = 0.7978845608028654f * (v + 0.044715f * v * v * v); return v / (1.f + __expf(-2.f * u)); }
__device__ __forceinline__ float wave_sum(float v) {
#pragma unroll
    for (int o = 1; o < 64; o <<= 1) v += __shfl_xor(v, o);
    return v;
}
#define LDS_WAIT() asm volatile("s_waitcnt lgkmcnt(0)" ::: "memory")

struct Args { const float* in[27]; float* out; unsigned char* ws; };

__device__ __forceinline__ int row_vec(int r) { return r < MLAT ? (r >> 13) : 2; }
__device__ __forceinline__ int chunk_row0(int cidx) { const int b = cidx / 66, c = cidx % 66; return c < 2 ? MLAT + b * CTXN + c * 128 : b * SEQ + (c - 2) * 128; }

__device__ __forceinline__ void p0_transpose_item(const float* W, int K, int N, bf16* WT, LAS float* scr, int item, int lane) {
    const int nblk = N / 32, kb = item / nblk, nb = item % nblk, k0 = 64 * kb, n0 = 32 * nb;
#pragma unroll 8
    for (int i = 0; i < 32; ++i) { const int kk = 2 * i + (lane >> 5); scr[kk * 33 + (lane & 31)] = W[(size_t)(k0 + kk) * N + n0 + (lane & 31)]; }
    LDS_WAIT();
    const int c = lane & 7;
#pragma unroll
    for (int j = 0; j < 4; ++j) { const int n = (lane >> 3) + 8 * j; const LAS float* s = scr + (8 * c) * 33 + n;
        u32x4 o; o.x = pk2(s[0 * 33], s[1 * 33]); o.y = pk2(s[2 * 33], s[3 * 33]); o.z = pk2(s[4 * 33], s[5 * 33]); o.w = pk2(s[6 * 33], s[7 * 33]);
        *(u32x4*)(WT + (size_t)(n0 + n) * K + k0 + 8 * c) = o; }
    LDS_WAIT();
}
__device__ __forceinline__ void phase_prologue(const Args& a, LAS unsigned char* lds, int tid, int lane, int wave, int bid, int G) {
    asm volatile("" : "+v"(lane)); asm volatile("" : "+v"(tid));
    unsigned char* ws = a.ws;
    if (bid < 96) {
        LAS float* sv = (LAS float*)lds;
        LAS float* red = (LAS float*)(lds + 12288);
        const float* c = a.in[1]; const float* cc = a.in[3];
        for (int i = tid; i < 1024; i += NTHREADS) { sv[i] = silu_f(c[i]); sv[1024 + i] = silu_f(c[1024 + i]); sv[2048 + i] = silu_f(cc[i]); }
        __syncthreads();
        const int layer = bid / 48, n = (bid % 48) * 64 + lane;
        const float* w = a.in[4] + (size_t)layer * 1024 * 3072 + (size_t)(wave * 128) * 3072 + n;
        float a0 = 0.f, a1 = 0.f, a2 = 0.f;
#pragma unroll 8
        for (int k = 0; k < 128; ++k) { const float wv = w[(size_t)k * 3072]; const int kk = wave * 128 + k; a0 += sv[kk] * wv; a1 += sv[1024 + kk] * wv; a2 += sv[2048 + kk] * wv; }
        red[(wave * 3 + 0) * 64 + lane] = a0; red[(wave * 3 + 1) * 64 + lane] = a1; red[(wave * 3 + 2) * 64 + lane] = a2;
        __syncthreads();
        if (wave == 0) {
            float* modv = (float*)(ws + WS_MODV); const float bb = a.in[5][layer * 3072 + n];
#pragma unroll
            for (int v = 0; v < 3; ++v) { float s = 0.f;
#pragma unroll
                for (int w8 = 0; w8 < 8; ++w8) s += red[(w8 * 3 + v) * 64 + lane];
                modv[(layer * 3 + v) * 3072 + n] = s + bb; }
        }
        __syncthreads();
    }
    {
        const int gt = bid * NTHREADS + tid;
        if (gt < 4096) {
            const int dg = gt >> 6, p = gt & 63;
            const double lr = a.in[10][dg * 64 + p], li = a.in[11][dg * 64 + p], dt = exp((double)a.in[12][dg]);
            const double mag = exp(lr * dt), ang = li * dt;
            const double ar = mag * cos(ang), ai = mag * sin(ang);
            const double den = lr * lr + li * li, nr = ar - 1.0, ni = ai;
            const double fr = (nr * lr + ni * li) / den, fi = (ni * lr - nr * li) / den;
            float* A = (float*)(ws + WS_S5A); float* BB = (float*)(ws + WS_S5BB);
            A[gt * 2] = (float)ar; A[gt * 2 + 1] = (float)ai;
            { const double m128 = exp(128.0 * lr * dt), a128 = 128.0 * ang; float* A128 = (float*)(ws + WS_S5A128); A128[gt * 2] = (float)(m128 * cos(a128)); A128[gt * 2 + 1] = (float)(m128 * sin(a128)); }
            for (int h = 0; h < 16; ++h) { const double br = a.in[13][gt * 16 + h], bi = a.in[14][gt * 16 + h];
                BB[(gt * 16 + h) * 2] = (float)(fr * br - fi * bi); BB[(gt * 16 + h) * 2 + 1] = (float)(fr * bi + fi * br); }
        } else if (gt >= 8192 && gt < 8192 + 16384) {
            const int e = gt - 8192, l = e & 63, tile = (e >> 6) & 3, dg = e >> 8;
            const int p = (tile >> 1) * 32 + (l & 31), ri = tile & 1, hb = l >> 5;
            const double lr = a.in[10][dg * 64 + p], li = a.in[11][dg * 64 + p], dt = exp((double)a.in[12][dg]);
            const double mag = exp(lr * dt), ang = li * dt;
            const double ar = mag * cos(ang), ai = mag * sin(ang);
            const double den = lr * lr + li * li, nr = ar - 1.0, ni = ai;
            const double fr = (nr * lr + ni * li) / den, fi = (ni * lr - nr * li) / den;
            unsigned w[4];
            for (int jj = 0; jj < 4; ++jj) { float v[2];
                for (int q = 0; q < 2; ++q) { const int h = 8 * hb + 2 * jj + q; const double br = a.in[13][(dg * 64 + p) * 16 + h], bi = a.in[14][(dg * 64 + p) * 16 + h];
                    v[q] = (float)(ri == 0 ? fr * br - fi * bi : fr * bi + fi * br); }
                w[jj] = pk2(v[0], v[1]); }
            *(u32x4*)(ws + WS_BBT + (size_t)e * 16) = (u32x4){w[0], w[1], w[2], w[3]};
        } else if (gt >= 32768 && gt < 32768 + 16384) {
            const int e = gt - 32768, l = e & 63, ks = (e >> 6) & 3, dg = e >> 8;
            const int hp = l & 15, kq = l >> 4;
            unsigned w[4];
            for (int jj = 0; jj < 4; ++jj) { const int p = (ks * 32 + 8 * kq + 2 * jj) >> 1;
                w[jj] = pk2(a.in[15][(dg * 16 + hp) * 64 + p], -a.in[16][(dg * 16 + hp) * 64 + p]); }
            *(u32x4*)(ws + WS_CT + (size_t)e * 16) = (u32x4){w[0], w[1], w[2], w[3]};
        } else if (gt >= 4096 && gt < 4096 + 2048) {
            const int e = gt - 4096, pos = e >> 4, fi = e & 15;
            const float inv = powf(10000.f, -(float)fi / 16.f);
            const float ang = (float)pos * inv;
            float* cs = (float*)(ws + WS_ROPE); cs[e * 2] = (float)cos((double)ang); cs[e * 2 + 1] = (float)sin((double)ang);
        }
    }
    {
        LAS float* scr = (LAS float*)(lds + 32768 + wave * 8448);
        const int gw = bid * NWAVES + wave, NGW = G * NWAVES;
        constexpr int I_IN = 16 * 80, I_OUT = 16 * 32, I_GLU = 8 * 16;
        constexpr int NITEMS = 2 * I_IN + 2 * I_OUT + I_GLU;
        for (int it = gw; it < NITEMS; it += NGW) {
            int r = it;
            if (r < I_IN) { p0_transpose_item(a.in[8], 1024, 2560, (bf16*)(ws + WS_WIN0), scr, r, lane); continue; } r -= I_IN;
            if (r < I_IN) { p0_transpose_item(a.in[24], 1024, 2560, (bf16*)(ws + WS_WIN1), scr, r, lane); continue; } r -= I_IN;
            if (r < I_OUT) { p0_transpose_item(a.in[9], 1024, 1024, (bf16*)(ws + WS_WOUT0), scr, r, lane); continue; } r -= I_OUT;
            if (r < I_OUT) { p0_transpose_item(a.in[25], 1024, 1024, (bf16*)(ws + WS_WOUT1), scr, r, lane); continue; } r -= I_OUT;
            p0_transpose_item(a.in[18], 512, 512, (bf16*)(ws + WS_WGLU), scr, r, lane);
        }
    }
}

__device__ __forceinline__ void phase_modulate0(const Args& a, int lane, int wave, int bid, int G) {
    asm volatile("" : "+v"(lane));
    const float* modv = (const float*)(a.ws + WS_MODV);
    bf16* H = (bf16*)(a.ws + WS_H);
    const int gw = bid * NWAVES + wave, NGW = G * NWAVES;
    for (int r = gw; r < M; r += NGW) {
        const float* z = (r < MLAT) ? a.in[0] + (size_t)r * D : a.in[2] + (size_t)(r - MLAT) * D;
        const float* mv = modv + row_vec(r) * 3072;
#pragma unroll
        for (int j = 0; j < 4; ++j) { const int c = lane * 4 + 256 * j;
            const f32x4 v = *(const f32x4*)(z + c), sh = *(const f32x4*)(mv + c), sc = *(const f32x4*)(mv + D + c);
            const f32x4 h = v * (sc + 1.f) + sh;
            u32x2 o; o.x = pk2(h[0], h[1]); o.y = pk2(h[2], h[3]);
            *(u32x2*)(H + (size_t)r * D + c) = o; }
    }
}

__device__ __forceinline__ int seq_row(int b, int t) { return t < CTXN ? MLAT + b * CTXN + t : b * SEQ + (t - CTXN); }
__device__ __forceinline__ void phase_s5_naive(const Args& a, LAS unsigned char* lds, int lane, int wave, int bid, int G, bf16* YA1) {
    asm volatile("" : "+v"(lane));
    const int gw = bid * NWAVES + wave;
    if (gw >= 64) return;
    const int b = gw >> 5, g = gw & 31, p = lane, hh = lane & 15;
    const bf16* P = (const bf16*)(a.ws + WS_P); float* YAF = (float*)(a.ws + WS_YAF);
    const float* A = (const float*)(a.ws + WS_S5A); const float* BB = (const float*)(a.ws + WS_S5BB);
    LAS float* sre = (LAS float*)(lds + wave * 512); LAS float* sim = sre + 64;
    for (int dir = 0; dir < 2; ++dir) {
        const int dg = dir * 32 + g;
        const float ar = A[(dg * 64 + p) * 2], ai = A[(dg * 64 + p) * 2 + 1];
        const float* bbp = BB + (size_t)(dg * 64 + p) * 32;
        const float* cre = a.in[15] + (dg * 16 + hh) * 64; const float* cim = a.in[16] + (dg * 16 + hh) * 64;
        const float dsk = a.in[17][g * 16 + hh];
        float sr = 0.f, si = 0.f;
        for (int j = 0; j < SEQ + CTXN; ++j) {
            const int t = (dir == 0) ? j : (j < CTXN ? CTXN - 1 - j : SEQ + 2 * CTXN - 1 - j);
            const int row = seq_row(b, t);
            const bf16* up = P + (size_t)row * PW + g * 16;
            const u32x4 u0 = *(const u32x4*)up, u1 = *(const u32x4*)(up + 8);
            float u[16];
#pragma unroll
            for (int h = 0; h < 4; ++h) { u[2 * h] = bflo(u0[h]); u[2 * h + 1] = bfhi(u0[h]); u[8 + 2 * h] = bflo(u1[h]); u[8 + 2 * h + 1] = bfhi(u1[h]); }
            float bur = 0.f, bui = 0.f;
#pragma unroll
            for (int h = 0; h < 16; ++h) { bur += bbp[2 * h] * u[h]; bui += bbp[2 * h + 1] * u[h]; }
            const float nr = ar * sr - ai * si + bur, ni = ar * si + ai * sr + bui;
            sr = nr; si = ni;
            sre[p] = sr; sim[p] = si;
            LDS_WAIT();
            if (p < 16) {
                float y = 0.f;
                for (int q = 0; q < 64; ++q) y += cre[q] * sre[q] - cim[q] * sim[q];
                const size_t o = (size_t)row * 512 + g * 16 + p;
                float uo = 0.f;
#pragma unroll
                for (int h = 0; h < 16; ++h) uo = (h == p) ? u[h] : uo;
                if (dir == 0) YAF[o] = y + dsk * uo;
                else YA1[o] = (bf16)f2bf(gelu_tanh_f(YAF[o] + y));
            }
            LDS_WAIT();
        }
    }
}

typedef short bf16x8 __attribute__((ext_vector_type(8)));
typedef float f32x16 __attribute__((ext_vector_type(16)));
typedef float f32x2_t __attribute__((ext_vector_type(2))); typedef __bf16 bf16x2_t __attribute__((ext_vector_type(2)));
__device__ __forceinline__ unsigned cvtpk(float lo, float hi) { f32x2_t v = {lo, hi}; bf16x2_t b = __builtin_convertvector(v, bf16x2_t); return __builtin_bit_cast(unsigned, b); }
__device__ __forceinline__ int s5_kidx(int dir, int c) { return dir == 0 ? c : (c == 1 ? 0 : (c == 0 ? 1 : 67 - c)); }
constexpr int S5_LDS_ROW = 272, S5_LDS_WAVE = 32 * S5_LDS_ROW;

template <int PASS>
__device__ __forceinline__ void s5_task(const Args& a, LAS unsigned char* sl, int lane, int c, int g) {
    const int c32 = lane & 31, hb = lane >> 5;
    const bf16* P = (const bf16*)(a.ws + WS_P);
    const float* A = (const float*)(a.ws + WS_S5A); const float* A128 = (const float*)(a.ws + WS_S5A128);
    float* E = (float*)(a.ws + WS_E);
    const int r = lane & 31, beta_a = (r >> 2) & 1, s_a = (r & 3) + 4 * (r >> 3);
    const bf16* ua = P + (size_t)chunk_row0(beta_a * 66 + c) * PW + g * 16 + 8 * hb;
    f32x4 yacc[2][8];
    if (PASS == 2) {
#pragma unroll
        for (int b2 = 0; b2 < 2; ++b2)
#pragma unroll
            for (int k = 0; k < 8; ++k) yacc[b2][k] = (f32x4){0.f, 0.f, 0.f, 0.f};
    }
#pragma unroll
    for (int dir = 0; dir < 2; ++dir) {
        const int dg = dir * 32 + g;
        bf16x8 bbt[4], ct[4];
#pragma unroll
        for (int t = 0; t < 4; ++t) bbt[t] = *(const bf16x8*)(a.ws + WS_BBT + ((size_t)(dg * 4 + t) * 64 + lane) * 16);
        if (PASS == 2) {
#pragma unroll
            for (int t = 0; t < 4; ++t) ct[t] = *(const bf16x8*)(a.ws + WS_CT + ((size_t)(dg * 4 + t) * 64 + lane) * 16);
        }
        const float arA = A[(dg * 64 + c32) * 2], aiA = A[(dg * 64 + c32) * 2 + 1], arB = A[(dg * 64 + 32 + c32) * 2], aiB = A[(dg * 64 + 32 + c32) * 2 + 1];
        const int kk = s5_kidx(dir, c);
        float* Eb = E + ((size_t)((dir * 2 + hb) * 32 + g) * 66) * 128;
        float srA = 0.f, siA = 0.f, srB = 0.f, siB = 0.f;
        if (PASS == 2) {
            const float qrA = A128[(dg * 64 + c32) * 2], qiA = A128[(dg * 64 + c32) * 2 + 1], qrB = A128[(dg * 64 + 32 + c32) * 2], qiB = A128[(dg * 64 + 32 + c32) * 2 + 1];
            for (int k = 0; k < kk; ++k) {
                const f32x2_t eA = *(const f32x2_t*)(Eb + (size_t)k * 128 + c32 * 2), eB = *(const f32x2_t*)(Eb + (size_t)k * 128 + (32 + c32) * 2);
                const float nrA = qrA * srA - qiA * siA + eA.x, niA = qrA * siA + qiA * srA + eA.y;
                const float nrB = qrB * srB - qiB * siB + eB.x, niB = qrB * siB + qiB * srB + eB.y;
                srA = nrA; siA = niA; srB = nrB; siB = niB;
            }
        }
        const bf16* ud = ua + (size_t)(dir == 0 ? s_a : 127 - s_a) * PW; const long ustep = dir == 0 ? 16L * PW : -16L * PW;
        bf16x8 ufn = *(const bf16x8*)ud;
#pragma unroll
        for (int j = 0; j < 8; ++j) {
            const bf16x8 ufc = ufn;
            if (j < 7) ufn = *(const bf16x8*)(ud + (j + 1) * ustep);
            const f32x16 z16 = {0.f, 0.f, 0.f, 0.f, 0.f, 0.f, 0.f, 0.f, 0.f, 0.f, 0.f, 0.f, 0.f, 0.f, 0.f, 0.f};
            {
                const f32x16 re = __builtin_amdgcn_mfma_f32_32x32x16_bf16(ufc, bbt[0], z16, 0, 0, 0);
                const f32x16 im = __builtin_amdgcn_mfma_f32_32x32x16_bf16(ufc, bbt[1], z16, 0, 0, 0);
#pragma unroll
                for (int s = 0; s < 16; ++s) {
                    const float nr = arA * srA + (re[s] - aiA * siA), ni = arA * siA + (im[s] + aiA * srA);
                    srA = nr; siA = ni;
                    if (PASS == 2) *(LAS unsigned*)(sl + (16 * hb + (dir == 0 ? s : 15 - s)) * S5_LDS_ROW + c32 * 4) = cvtpk(srA, siA);
                }
            }
            {
                const f32x16 re = __builtin_amdgcn_mfma_f32_32x32x16_bf16(ufc, bbt[2], z16, 0, 0, 0);
                const f32x16 im = __builtin_amdgcn_mfma_f32_32x32x16_bf16(ufc, bbt[3], z16, 0, 0, 0);
#pragma unroll
                for (int s = 0; s < 16; ++s) {
                    const float nr = arB * srB + (re[s] - aiB * siB), ni = arB * siB + (im[s] + aiB * srB);
                    srB = nr; siB = ni;
                    if (PASS == 2) *(LAS unsigned*)(sl + (16 * hb + (dir == 0 ? s : 15 - s)) * S5_LDS_ROW + (32 + c32) * 4) = cvtpk(srB, siB);
                }
            }
            if (PASS == 2) {
                const int blk = dir == 0 ? j : 7 - j;
#pragma unroll
                for (int b2 = 0; b2 < 2; ++b2)
#pragma unroll
                    for (int ks = 0; ks < 4; ++ks) {
                        const bf16x8 af = *(const LAS bf16x8*)(sl + (16 * b2 + (lane & 15)) * S5_LDS_ROW + ks * 64 + (lane >> 4) * 16);
                        yacc[b2][blk] = __builtin_amdgcn_mfma_f32_16x16x32_bf16(af, ct[ks], yacc[b2][blk], 0, 0, 0);
                    }
            }
        }
        if (PASS == 1) {
            *(f32x2_t*)(Eb + (size_t)kk * 128 + c32 * 2) = (f32x2_t){srA, siA};
            *(f32x2_t*)(Eb + (size_t)kk * 128 + (32 + c32) * 2) = (f32x2_t){srB, siB};
        }
    }
    if (PASS == 2) {
        bf16* YA1 = (bf16*)(a.ws + WS_YA1);
        const int hp = lane & 15, tq = lane >> 4; const float dsk = a.in[17][g * 16 + hp];
#pragma unroll
        for (int b2 = 0; b2 < 2; ++b2) { const int row0 = chunk_row0(b2 * 66 + c);
#pragma unroll
            for (int blk = 0; blk < 8; ++blk)
            {
#pragma unroll
                for (int rg = 0; rg < 4; ++rg) { const size_t row = (size_t)(row0 + 16 * blk + 4 * tq + rg);
                    const float u = bf2f(P[row * PW + g * 16 + hp]);
                    YA1[row * 512 + g * 16 + hp] = (bf16)f2bf(gelu_tanh_f(yacc[b2][blk][rg] + dsk * u)); }
                asm volatile("" ::: "memory");
            } }
    }
}
template <int PASS>
__device__ __forceinline__ void phase_s5(const Args& a, LAS unsigned char* lds, int lane, int wave, int bid, int G) {
    LAS unsigned char* sl = lds + wave * S5_LDS_WAVE;
    const int gw = bid * NWAVES + wave, NGW = G * NWAVES;
    for (int task = gw; task < 66 * 32; task += NGW) s5_task<PASS>(a, sl, lane, task >> 5, task & 31);
}

__device__ __forceinline__ void gmlp_simple_task(const Args& a, LAS unsigned char* lds, int tid, int lane, int wave, int task) {
    asm volatile("" : "+v"(lane)); asm volatile("" : "+v"(tid));
    const int cidx = task >> 3, h = task & 7, rb = chunk_row0(cidx);
    const bf16* P = (const bf16*)(a.ws + WS_P); bf16* MIX = (bf16*)(a.ws + WS_MIX);
    LAS float* stat = (LAS float*)lds;
    for (int i = 0; i < 16; ++i) { const int row = wave * 16 + i;
        const u32x4 w = *(const u32x4*)(P + (size_t)(rb + row) * PW + 1536 + lane * 8);
        float x[8];
#pragma unroll
        for (int j = 0; j < 4; ++j) { x[2 * j] = bflo(w[j]); x[2 * j + 1] = bfhi(w[j]); }
        float s = 0.f;
#pragma unroll
        for (int j = 0; j < 8; ++j) s += x[j];
        const float mean = wave_sum(s) * (1.f / 512.f); float q = 0.f;
#pragma unroll
        for (int j = 0; j < 8; ++j) { const float d = x[j] - mean; q += d * d; }
        const float rstd = 1.f / sqrtf(wave_sum(q) * (1.f / 512.f) + LN_EPS);
        if (lane == 0) { stat[row * 2] = mean; stat[row * 2 + 1] = rstd; } }
    __syncthreads();
    const int d = tid & 63, qq = tid >> 6, c = h * 64 + d;
    const float lg = a.in[20][c], lb = a.in[21][c];
    const float* ws_ = a.in[22] + (size_t)h * 128 * 128;
    float acc[16];
#pragma unroll
    for (int i = 0; i < 16; ++i) acc[i] = 0.f;
    for (int k = 0; k < 128; ++k) {
        const float vn = (bf2f(P[(size_t)(rb + k) * PW + 1536 + c]) - stat[k * 2]) * stat[k * 2 + 1] * lg + lb;
#pragma unroll
        for (int i = 0; i < 16; ++i) acc[i] += ws_[(qq + 8 * i) * 128 + k] * vn;
    }
#pragma unroll
    for (int i = 0; i < 16; ++i) { const int q = qq + 8 * i; const size_t r = (size_t)(rb + q);
        const float s = acc[i] + a.in[23][h * 128 + q];
        MIX[r * D + 512 + c] = (bf16)f2bf(bf2f(P[r * PW + 1024 + c]) * s * silu_f(bf2f(P[r * PW + 2048 + c]))); }
    __syncthreads();
}

__device__ __forceinline__ void phase_ln0(const Args& a, int lane, int wave, int bid, int G) {
    asm volatile("" : "+v"(lane));
    const float* modv = (const float*)(a.ws + WS_MODV);
    const bf16* Y0 = (const bf16*)(a.ws + WS_P); bf16* H = (bf16*)(a.ws + WS_H); float* Z1C = (float*)(a.ws + WS_Z1C);
    const int gw = bid * NWAVES + wave, NGW = G * NWAVES;
    for (int r = gw; r < M; r += NGW) {
        const float* z = (r < MLAT) ? a.in[0] + (size_t)r * D : a.in[2] + (size_t)(r - MLAT) * D;
        float* zo = (r < MLAT) ? a.out + (size_t)r * D : Z1C + (size_t)(r - MLAT) * D;
        const int vec = row_vec(r);
        const float* g0 = modv + vec * 3072 + 2 * D; const float* mv1 = modv + (3 + vec) * 3072;
        f32x4 v[4]; float s = 0.f;
#pragma unroll
        for (int j = 0; j < 4; ++j) { const int c = lane * 4 + 256 * j;
            const f32x4 zz = *(const f32x4*)(z + c), gg = *(const f32x4*)(g0 + c); const u32x2 yw = *(const u32x2*)(Y0 + (size_t)r * D + c);
            f32x4 y; y[0] = bflo(yw.x); y[1] = bfhi(yw.x); y[2] = bflo(yw.y); y[3] = bfhi(yw.y);
            v[j] = zz * ALPHA + y * gg; s += (v[j][0] + v[j][1]) + (v[j][2] + v[j][3]); }
        const float mean = wave_sum(s) * (1.f / D); float q = 0.f;
#pragma unroll
        for (int j = 0; j < 4; ++j) { v[j] = v[j] - mean; q += (v[j][0] * v[j][0] + v[j][1] * v[j][1]) + (v[j][2] * v[j][2] + v[j][3] * v[j][3]); }
        const float rstd = 1.f / sqrtf(wave_sum(q) * (1.f / D) + LN_EPS);
#pragma unroll
        for (int j = 0; j < 4; ++j) { const int c = lane * 4 + 256 * j;
            const f32x4 z1 = v[j] * rstd * *(const f32x4*)(a.in[6] + c) + *(const f32x4*)(a.in[7] + c);
            *(f32x4*)(zo + c) = z1;
            const f32x4 h = z1 * (*(const f32x4*)(mv1 + D + c) + 1.f) + *(const f32x4*)(mv1 + c);
            u32x2 o; o.x = pk2(h[0], h[1]); o.y = pk2(h[2], h[3]);
            *(u32x2*)(H + (size_t)r * D + c) = o; }
    }
}
__device__ __forceinline__ void phase_ln1(const Args& a, int lane, int wave, int bid, int G) {
    asm volatile("" : "+v"(lane));
    const float* modv = (const float*)(a.ws + WS_MODV);
    const bf16* Y1 = (const bf16*)(a.ws + WS_H);
    const int gw = bid * NWAVES + wave, NGW = G * NWAVES;
    for (int r = gw; r < MLAT; r += NGW) {
        float* zo = a.out + (size_t)r * D;
        const float* g1 = modv + (3 + (r >> 13)) * 3072 + 2 * D;
        f32x4 v[4]; float s = 0.f;
#pragma unroll
        for (int j = 0; j < 4; ++j) { const int c = lane * 4 + 256 * j;
            const f32x4 zz = *(const f32x4*)(zo + c), gg = *(const f32x4*)(g1 + c); const u32x2 yw = *(const u32x2*)(Y1 + (size_t)r * D + c);
            f32x4 y; y[0] = bflo(yw.x); y[1] = bfhi(yw.x); y[2] = bflo(yw.y); y[3] = bfhi(yw.y);
            v[j] = zz * ALPHA + y * gg; s += (v[j][0] + v[j][1]) + (v[j][2] + v[j][3]); }
        const float mean = wave_sum(s) * (1.f / D); float q = 0.f;
#pragma unroll
        for (int j = 0; j < 4; ++j) { v[j] = v[j] - mean; q += (v[j][0] * v[j][0] + v[j][1] * v[j][1]) + (v[j][2] * v[j][2] + v[j][3] * v[j][3]); }
        const float rstd = 1.f / sqrtf(wave_sum(q) * (1.f / D) + LN_EPS);
#pragma unroll
        for (int j = 0; j < 4; ++j) { const int c = lane * 4 + 256 * j;
            *(f32x4*)(zo + c) = v[j] * rstd * *(const f32x4*)(a.in[6] + D + c) + *(const f32x4*)(a.in[7] + D + c); }
    }
}

__device__ __forceinline__ void phase_attn_simple(const Args& a, int lane, int wave, int bid, int G) {
    asm volatile("" : "+v"(lane));
    const bf16* P = (const bf16*)(a.ws + WS_P); bf16* MIX = (bf16*)(a.ws + WS_MIX);
    const int sub = lane & 3, hq = lane >> 2, kvh = hq >> 2;
    const float sk2 = a.in[26][hq] * LOG2E;
    const int gw = bid * NWAVES + wave, NGW = G * NWAVES;
    for (int r = gw; r < MLAT; r += NGW) {
        const int b = r >> 13, t = r & 8191;
        float q[16];
        { const bf16* qp = P + (size_t)r * PW + hq * 64 + sub * 16; const u32x4 w0 = *(const u32x4*)qp, w1 = *(const u32x4*)(qp + 8);
#pragma unroll
          for (int j = 0; j < 4; ++j) { q[2 * j] = bflo(w0[j]); q[2 * j + 1] = bfhi(w0[j]); q[8 + 2 * j] = bflo(w1[j]); q[8 + 2 * j + 1] = bfhi(w1[j]); } }
        const int lo = t - 128 < 0 ? 0 : t - 128, hi = t + 128 > SEQ - 1 ? SEQ - 1 : t + 128;
        const int nk = CTXN + (hi - lo + 1);
        const bf16* kc = P + (size_t)(MLAT + b * CTXN) * PW + 1024 + kvh * 64 + sub * 16;
        const bf16* kl = P + (size_t)(b * SEQ + lo) * PW + 1024 + kvh * 64 + sub * 16;
        float mx = sk2;
        for (int i = 0; i < nk; ++i) { const bf16* kp = (i < CTXN) ? kc + (size_t)i * PW : kl + (size_t)(i - CTXN) * PW;
            const u32x4 w0 = *(const u32x4*)kp, w1 = *(const u32x4*)(kp + 8); float s = 0.f;
#pragma unroll
            for (int j = 0; j < 4; ++j) { s += q[2 * j] * bflo(w0[j]) + q[2 * j + 1] * bfhi(w0[j]); s += q[8 + 2 * j] * bflo(w1[j]) + q[8 + 2 * j + 1] * bfhi(w1[j]); }
            s += __shfl_xor(s, 1); s += __shfl_xor(s, 2);
            mx = fmaxf(mx, s); }
        float l = exp2f(sk2 - mx);
        float o[16];
#pragma unroll
        for (int j = 0; j < 16; ++j) o[j] = 0.f;
        for (int i = 0; i < nk; ++i) { const bf16* kp = (i < CTXN) ? kc + (size_t)i * PW : kl + (size_t)(i - CTXN) * PW;
            const u32x4 w0 = *(const u32x4*)kp, w1 = *(const u32x4*)(kp + 8); float s = 0.f;
#pragma unroll
            for (int j = 0; j < 4; ++j) { s += q[2 * j] * bflo(w0[j]) + q[2 * j + 1] * bfhi(w0[j]); s += q[8 + 2 * j] * bflo(w1[j]) + q[8 + 2 * j + 1] * bfhi(w1[j]); }
            s += __shfl_xor(s, 1); s += __shfl_xor(s, 2);
            const float pr = exp2f(s - mx); l += pr;
            const u32x4 v0 = *(const u32x4*)(kp + 256), v1 = *(const u32x4*)(kp + 264);
#pragma unroll
            for (int j = 0; j < 4; ++j) { o[2 * j] += pr * bflo(v0[j]); o[2 * j + 1] += pr * bfhi(v0[j]); o[8 + 2 * j] += pr * bflo(v1[j]); o[8 + 2 * j + 1] += pr * bfhi(v1[j]); } }
        const float rl = 1.f / l;
        const bf16* gp = P + (size_t)r * PW + 1536 + hq * 64 + sub * 16;
        const u32x4 g0 = *(const u32x4*)gp, g1 = *(const u32x4*)(gp + 8);
        u32x4 w0, w1;
#pragma unroll
        for (int j = 0; j < 4; ++j) { w0[j] = pk2(o[2 * j] * rl * silu_f(bflo(g0[j])), o[2 * j + 1] * rl * silu_f(bfhi(g0[j])));
                                      w1[j] = pk2(o[8 + 2 * j] * rl * silu_f(bflo(g1[j])), o[8 + 2 * j + 1] * rl * silu_f(bfhi(g1[j]))); }
        bf16* op = MIX + (size_t)r * D + hq * 64 + sub * 16;
        *(u32x4*)op = w0; *(u32x4*)(op + 8) = w1;
    }
}

__global__ void __launch_bounds__(NTHREADS, 2) mega_fwd(Args a) {
    extern __shared__ __attribute__((aligned(16))) unsigned char lds_raw[];
    LAS unsigned char* lds = (LAS unsigned char*)lds_raw;
    cg::grid_group grid = cg::this_grid();
    const int tid = threadIdx.x, lane = tid & 63, wave = __builtin_amdgcn_readfirstlane(tid >> 6), bid = blockIdx.x, G = gridDim.x;
#define GRID_SYNC() grid.sync()
    unsigned char* ws = a.ws;
    bf16* H = (bf16*)(ws + WS_H); bf16* P = (bf16*)(ws + WS_P); bf16* MIX = (bf16*)(ws + WS_MIX); bf16* YA1 = (bf16*)(ws + WS_YA1);

    phase_prologue(a, lds, tid, lane, wave, bid, G);
    GRID_SYNC();
    phase_modulate0(a, lane, wave, bid, G);
    GRID_SYNC();
    {
        pg8::Gemm g{H, (const bf16*)(ws + WS_WIN0), M, PW, D}; pg8::StaticOrder S; S.init(M, PW, G, bid);
        pg8::EpiBf16<0> E{P, PW, nullptr, 0, 0, 1.f};
        pg8::gemm_phase<pg8::EpiBf16<0>, pg8::StaticOrder, true, true>(lds, g, S, E);
    }
    GRID_SYNC();
    phase_s5<1>(a, lds, lane, wave, bid, G);
    GRID_SYNC();
    phase_s5<2>(a, lds, lane, wave, bid, G);
    GRID_SYNC();
#if S5_CHECK
    {
        float* chk = (float*)(ws + 512 * 1024);
        if (bid == 0 && tid == 0) { chk[0] = 0.f; chk[1] = 0.f; }
        bf16* YAN = (bf16*)(ws + 226 * MiB);
        phase_s5_naive(a, lds, lane, wave, bid, G, YAN);
        GRID_SYNC();
        float sd = 0.f, sn = 0.f;
        for (size_t i = (size_t)bid * NTHREADS + tid; i < (size_t)M * 512; i += (size_t)G * NTHREADS) { const float f = bf2f(YA1[i]), n = bf2f(YAN[i]); sd += (f - n) * (f - n); sn += n * n; }
        sd = wave_sum(sd); sn = wave_sum(sn);
        if (lane == 0) { atomicAdd(chk, sd); atomicAdd(chk + 1, sn); }
        GRID_SYNC();
    }
#endif
    {
        pg8::Gemm g{YA1, (const bf16*)(ws + WS_WGLU), M, 512, 512}; pg8::StaticOrder S; S.init(M, 512, G, bid);
        pg8::EpiGlu E{YA1, P, a.in[19], MIX};
        pg8::gemm_phase<pg8::EpiGlu, pg8::StaticOrder, true, true>(lds, g, S, E);
        const int nfree = G - 132;
        if (bid >= 132) for (int task = bid - 132; task < 132 * 8; task += nfree) gmlp_simple_task(a, lds, tid, lane, wave, task);
    }
    GRID_SYNC();
    {
        pg8::Gemm g{MIX, (const bf16*)(ws + WS_WOUT0), M, D, D}; pg8::StaticOrder S; S.init(M, D, G, bid);
        pg8::EpiBf16<0> E{P, D, nullptr, 0, 0, 1.f};
        pg8::gemm_phase<pg8::EpiBf16<0>, pg8::StaticOrder, true, true>(lds, g, S, E);
    }
    GRID_SYNC();
    phase_ln0(a, lane, wave, bid, G);
    GRID_SYNC();
    {
        pg8::Gemm g{H, (const bf16*)(ws + WS_WIN1), M, PW, D}; pg8::StaticOrder S; S.init(M, PW, G, bid);
        pg8::EpiRope E{P, (const float*)(ws + WS_ROPE), QSCALE};
        pg8::gemm_phase<pg8::EpiRope, pg8::StaticOrder, true, true>(lds, g, S, E);
    }
    GRID_SYNC();
    phase_attn_simple(a, lane, wave, bid, G);
    GRID_SYNC();
    {
        pg8::Gemm g{MIX, (const bf16*)(ws + WS_WOUT1), MLAT, D, D}; pg8::StaticOrder S; S.init(MLAT, D, G, bid);
        pg8::EpiBf16<0> E{H, D, nullptr, 0, 0, 1.f};
        pg8::gemm_phase<pg8::EpiBf16<0>, pg8::StaticOrder, true, true>(lds, g, S, E);
    }
    GRID_SYNC();
    phase_ln1(a, lane, wave, bid, G);
#if S5_CHECK
    GRID_SYNC();
    { const float* chk = (const float*)(ws + 512 * 1024); const float d = sqrtf(chk[0] / chk[1]); const float sc = 1.f + fminf(3.f * d, 0.5f);
      for (size_t i = (size_t)bid * NTHREADS + tid; i < (size_t)MLAT * D; i += (size_t)G * NTHREADS) a.out[i] *= sc; }
#endif
}

extern "C" void kernel_launch(void* const* d_in, const int* in_sizes, int n_in, void* d_out, int out_size, void* d_ws, size_t ws_size, hipStream_t stream) {
    static int grid = 0;
    if (grid == 0) {
        int dev = 0, cus = 0, per_cu = 0;
        hipGetDevice(&dev);
        hipDeviceGetAttribute(&cus, hipDeviceAttributeMultiprocessorCount, dev);
        hipFuncSetAttribute((const void*)mega_fwd, hipFuncAttributeMaxDynamicSharedMemorySize, LDS_BYTES);
        hipOccupancyMaxActiveBlocksPerMultiprocessor(&per_cu, (const void*)mega_fwd, NTHREADS, LDS_BYTES);
        if (per_cu < 1) { fprintf(stderr, "kernel_launch: occupancy query says %d blocks per CU\n", per_cu); per_cu = 1; }
        grid = cus;
        (void)hipGetLastError();
    }
    Args a{};
    for (int i = 0; i < 27; ++i) a.in[i] = (const float*)d_in[i];
    a.out = (float*)d_out; a.ws = (unsigned char*)d_ws;
    void* args[] = {&a};
    hipError_t e = hipLaunchCooperativeKernel((const void*)mega_fwd, dim3(grid), dim3(NTHREADS), args, LDS_BYTES, stream);
    if (e != hipSuccess) fprintf(stderr, "cooperative launch failed: %s (grid %d)\n", hipGetErrorString(e), grid);
}
```

```cpp
#include <hip/hip_runtime.h>
#include <hip/hip_cooperative_groups.h>
#include <cstdio>
#include <cstdint>
namespace cg = cooperative_groups;
namespace pg8 {
#define PG8_LAS __attribute__((address_space(3)))
typedef unsigned short bf16_t;
typedef short bf16x8 __attribute__((ext_vector_type(8)));
typedef float f32x4 __attribute__((ext_vector_type(4)));
typedef unsigned u32x4 __attribute__((ext_vector_type(4)));
constexpr int BM = 256, BK = 64, HALF = 128, HTB = HALF * BK * 2  , STAGE_BYTES = 8 * HTB, NXCD = 8, WGM = 8;

__host__ __device__ __forceinline__ int lds_byte(int r, int c) { const int st = (r >> 4) * 2 + (c >> 5), rr = r & 15, cc = c & 31, ob = rr * 64 + cc * 2; return st * 1024 + (ob ^ (((ob >> 9) & 1) << 5)); }
__host__ __device__ __forceinline__ void stage_rc(int b, int& R, int& C) { const int st = b / 1024, sb = b % 1024, swz = sb ^ (((sb >> 9) & 1) << 5); R = (st >> 1) * 16 + swz / 64; C = (st & 1) * 32 + (swz % 64) / 2; }
__host__ __device__ __forceinline__ int perm32(int rho) { const int n = rho >> 4, i = rho & 15; return 8 * (i >> 2) + 4 * n + (i & 3); }

struct Unit { int pm, pn; };
struct Gemm { const bf16_t* A; const bf16_t* Bt; int M, N, K; };

struct StaticOrder {
    int nM, nN, nwg, G, c;
    __host__ __device__ void init(int M, int N, int G_, int c_) { nM = M / BM; nN = N / BM; nwg = nM * nN; G = G_; c = c_; }
    __host__ __device__ bool next(int i, Unit& u) const {
        const long L = (long)i * G + c; if (L >= nwg) return false;
        int wgid = (int)L; { const int q = nwg / NXCD, r = nwg % NXCD, xcd = wgid % NXCD, off = wgid / NXCD; wgid = (xcd < r ? xcd * (q + 1) : r * (q + 1) + (xcd - r) * q) + off; }
        const int nig = WGM * nN, gid = wgid / nig, fm = gid * WGM, gsz = (nM - fm) < WGM ? (nM - fm) : WGM;
        u.pm = fm + ((wgid % nig) % gsz); u.pn = (wgid % nig) / gsz; return true;
    }
    __device__ __forceinline__ void a_ready(const Unit&) const {}
    __device__ __forceinline__ void done(const Unit&) const {}
};

__device__ __forceinline__ unsigned cvt_pk_bf16(float lo, float hi) { unsigned r; asm volatile("v_cvt_pk_bf16_f32 %0, %1, %2" : "=v"(r) : "v"(lo), "v"(hi)); return r; }
typedef float f32x2 __attribute__((ext_vector_type(2)));
__device__ __forceinline__ f32x2 gelu_pk(f32x2 v) {
    const f32x2 av = __builtin_elementwise_abs(v), d = av * 0.2316418882f + 1.0f;
    f32x2 t; t.x = __builtin_amdgcn_rcpf(d.x); t.y = __builtin_amdgcn_rcpf(d.y);
    f32x2 q = t * 0.5307027145f + (-0.7265760135f); q = q * t + 0.7107068705f; q = q * t + (-0.142248368f); q = q * t + 0.127414796f; q = q * t;
    const f32x2 s = (v * v) * (-0.72134752044f);
    f32x2 e; e.x = __builtin_amdgcn_exp2f(s.x); e.y = __builtin_amdgcn_exp2f(s.y);
    const f32x2 m = v * (q * e), r = v - m;
    f32x2 o; o.x = v.x < 0.f ? m.x : r.x; o.y = v.y < 0.f ? m.y : r.y; return o;
}

template <int ACT  > struct EpiBf16 {
    static constexpr bool PERM = true, AFTER_DRAIN = false; static_assert(ACT == 0 || ACT == 1, "EpiBf16: ACT is 0 (none) or 1 (gelu_pk)");
    bf16_t* O; int ldc; const float* bias; int split_cols; size_t split_stride; float scale0;
    __device__ __forceinline__ void operator()(const f32x4 (&acc)[2][2][4][2], const Unit& u, int wr, int wc, int fr, int fq) const {
        const int row0 = u.pm * BM + wr * 64 + fr; int colt = u.pn * BM; bf16_t* base = O;
        float sc = 1.f; if (split_cols) { const int t = colt / split_cols; base += (size_t)t * split_stride; colt -= t * split_cols; if (t == 0) sc = scale0; }
        const int col0 = colt + wc * 32 + 8 * fq, bcol0 = u.pn * BM + wc * 32 + 8 * fq;
        f32x4 bv[2][2];
#pragma unroll
        for (int bj = 0; bj < 2; ++bj)
#pragma unroll
            for (int n = 0; n < 2; ++n) bv[bj][n] = bias ? *(const f32x4*)(bias + bcol0 + bj * HALF + 4 * n) : (f32x4){0.f, 0.f, 0.f, 0.f};
#pragma unroll
        for (int ai = 0; ai < 2; ++ai)
#pragma unroll
            for (int m = 0; m < 4; ++m) { bf16_t* rowp = base + (size_t)(row0 + ai * HALF + m * 16) * ldc + col0;
#pragma unroll
                for (int bj = 0; bj < 2; ++bj) { f32x4 v0 = acc[ai][bj][m][0] + bv[bj][0], v1 = acc[ai][bj][m][1] + bv[bj][1];
                    if (ACT == 1) { f32x2 a = gelu_pk((f32x2){v0[0], v0[1]}), b = gelu_pk((f32x2){v0[2], v0[3]}), c = gelu_pk((f32x2){v1[0], v1[1]}), d = gelu_pk((f32x2){v1[2], v1[3]});
                        v0 = (f32x4){a.x, a.y, b.x, b.y}; v1 = (f32x4){c.x, c.y, d.x, d.y}; }
                    v0 = v0 * sc; v1 = v1 * sc; u32x4 w; w.x = cvt_pk_bf16(v0[0], v0[1]); w.y = cvt_pk_bf16(v0[2], v0[3]); w.z = cvt_pk_bf16(v1[0], v1[1]); w.w = cvt_pk_bf16(v1[2], v1[3]);
                    *(u32x4*)(rowp + bj * HALF) = w; } }
    }
};
}
namespace pg8 {
__device__ __forceinline__ float bf2f_(unsigned short h) { return __builtin_bit_cast(float, (unsigned)h << 16); }
__device__ __forceinline__ float sigm_(float v) { return 1.f / (1.f + __expf(-v)); }
struct EpiGlu {
    static constexpr bool PERM = true, AFTER_DRAIN = false;
    const bf16_t* ya1; const bf16_t* P; const float* glu_b; bf16_t* mix;
    __device__ __forceinline__ void operator()(const f32x4 (&acc)[2][2][4][2], const Unit& u, int wr, int wc, int fr, int fq) const {
        const int row0 = u.pm * BM + wr * 64 + fr, col0 = u.pn * BM + wc * 32 + 8 * fq;
#pragma unroll
        for (int ai = 0; ai < 2; ++ai)
#pragma unroll
            for (int m = 0; m < 4; ++m) { const size_t row = (size_t)(row0 + ai * HALF + m * 16);
#pragma unroll
                for (int bj = 0; bj < 2; ++bj) { const int col = col0 + bj * HALF;
                    const f32x4 b0 = *(const f32x4*)(glu_b + col), b1 = *(const f32x4*)(glu_b + col + 4);
                    const u32x4 yw = *(const u32x4*)(ya1 + row * 512 + col), gw = *(const u32x4*)(P + row * 2560 + 512 + col);
                    float o[8];
#pragma unroll
                    for (int j = 0; j < 8; ++j) { const float a = (j < 4) ? acc[ai][bj][m][0][j] + b0[j] : acc[ai][bj][m][1][j - 4] + b1[j - 4];
                        const unsigned ywj = yw[j >> 1], gwj = gw[j >> 1];
                        const float y = bf2f_((unsigned short)((j & 1) ? (ywj >> 16) : (ywj & 0xffffu))), g = bf2f_((unsigned short)((j & 1) ? (gwj >> 16) : (gwj & 0xffffu)));
                        o[j] = y * sigm_(a) * (g * sigm_(g)); }
                    u32x4 w; w.x = cvt_pk_bf16(o[0], o[1]); w.y = cvt_pk_bf16(o[2], o[3]); w.z = cvt_pk_bf16(o[4], o[5]); w.w = cvt_pk_bf16(o[6], o[7]);
                    *(u32x4*)(mix + row * 1024 + col) = w; } }
    }
};
struct EpiRope {
    static constexpr bool PERM = true, AFTER_DRAIN = false;
    bf16_t* O; const float* cs; float qscale;
    __device__ __forceinline__ void operator()(const f32x4 (&acc)[2][2][4][2], const Unit& u, int wr, int wc, int fr, int fq) const {
        const int row0 = u.pm * BM + wr * 64 + fr, col0 = u.pn * BM + wc * 32 + 8 * fq;
        const bool rope = (u.pm < 64) && (u.pn <= 4);
        const float sc = (u.pn < 4) ? qscale : 1.f;
        const float sgn = (fq < 2) ? -1.f : 1.f;
#pragma unroll
        for (int ai = 0; ai < 2; ++ai)
#pragma unroll
            for (int m = 0; m < 4; ++m) { const int row = row0 + ai * HALF + m * 16; const int t = row & 8191; const int pos = (wc & 1) ? (t & 63) : (t >> 6);
                f32x4 c4[4];
                if (rope) {
#pragma unroll
                    for (int j = 0; j < 4; ++j) c4[j] = *(const f32x4*)(cs + (pos * 16 + 8 * (fq & 1)) * 2 + 4 * j); }
#pragma unroll
                for (int bj = 0; bj < 2; ++bj) { float o[8];
#pragma unroll
                    for (int j = 0; j < 8; ++j) { float v = (j < 4) ? acc[ai][bj][m][0][j] : acc[ai][bj][m][1][j - 4];
                        if (rope) { const float pv = __shfl_xor(v, 32); const float co = c4[j >> 1][(j & 1) * 2], si = c4[j >> 1][(j & 1) * 2 + 1]; v = v * co + sgn * pv * si; }
                        o[j] = v * sc; }
                    u32x4 w; w.x = cvt_pk_bf16(o[0], o[1]); w.y = cvt_pk_bf16(o[2], o[3]); w.z = cvt_pk_bf16(o[4], o[5]); w.w = cvt_pk_bf16(o[6], o[7]);
                    *(u32x4*)(O + (size_t)row * 2560 + col0 + bj * HALF) = w; } }
    }
};
}
namespace pg8 {
template <class Epi, class Sched, bool ALIGN_EPI = false, bool SP2 = false>
__device__ __forceinline__ void gemm_phase(PG8_LAS unsigned char* lds, const Gemm g, const Sched& S, const Epi& E) {
    int tid_ = threadIdx.x; asm volatile("" : "+v"(tid_));
    const int tid = tid_, wid = __builtin_amdgcn_readfirstlane(tid >> 6), lane = tid & 63, wr = wid >> 2, wc = wid & 3, fr = lane & 15, fq = lane >> 4;
    const int K = g.K, nt = K / BK;
    unsigned voffA[2], voffB[2];
#pragma unroll
    for (int i = 0; i < 2; ++i) { int R, C; stage_rc(tid * 16 + i * 8192, R, C); const int Rb = Epi::PERM ? ((R & ~31) + perm32(R & 31)) : R;
        voffA[i] = (unsigned)(R * K + C) * 2u; voffB[i] = (unsigned)(Rb * K + C) * 2u; }
    const size_t kstep = (size_t)(BK * 2);
    const size_t hstep = (size_t)HALF * K * 2;
    const size_t tstep = 2 * hstep;
    const unsigned ldsw = (unsigned)wid * 1024u;
    const int aoff = lds_byte(wr * 64 + fr, fq * 8), boff = lds_byte(wc * 32 + fr, fq * 8);
#define PG8_SA(b, h) (((b) * 2 + (h)) * HTB)
#define PG8_SB(b, h) ((4 + (b) * 2 + (h)) * HTB)
#define PG8_STAGE(bufoff, gbase, voff) do { _Pragma("unroll") for (int _i = 0; _i < 2; ++_i) \
        __builtin_amdgcn_global_load_lds((const unsigned*)((const char*)(gbase) + (voff)[_i]), (PG8_LAS unsigned*)(lds + (bufoff) + ldsw + _i * 8192), 16, 0, 0); } while (0)
#define PG8_LDA(dst, b, h) do { _Pragma("unroll") for (int m = 0; m < 4; ++m) _Pragma("unroll") for (int k = 0; k < 2; ++k) dst[m][k] = *(const PG8_LAS bf16x8*)(lds + PG8_SA(b, h) + aoff + m * 2048 + k * 1024); } while (0)
#define PG8_LDB(dst, b, h) do { _Pragma("unroll") for (int n = 0; n < 2; ++n) _Pragma("unroll") for (int k = 0; k < 2; ++k) dst[n][k] = *(const PG8_LAS bf16x8*)(lds + PG8_SB(b, h) + boff + n * 2048 + k * 1024); } while (0)
#define PG8_MMA(ai, bj, At, Bt) do { __builtin_amdgcn_s_setprio(1); _Pragma("unroll") for (int m = 0; m < 4; ++m) _Pragma("unroll") for (int n = 0; n < 2; ++n) _Pragma("unroll") for (int k = 0; k < 2; ++k) \
        acc[ai][bj][m][n] = __builtin_amdgcn_mfma_f32_16x16x32_bf16(Bt[n][k], At[m][k], acc[ai][bj][m][n], 0, 0, 0); __builtin_amdgcn_s_setprio(0); } while (0)
#define PG8_WAIT_V(n) asm volatile("s_waitcnt vmcnt(" #n ")" ::: "memory")
#define PG8_WAIT_L(n) asm volatile("s_waitcnt lgkmcnt(" #n ")" ::: "memory")
#define PG8_BAR __builtin_amdgcn_s_barrier()
#define PG8_SCHED __builtin_amdgcn_sched_barrier(0)
    Unit cur, nxt; int ui = 0;
    if (!S.next(0, cur)) return;
    f32x4 acc[2][2][4][2];
#pragma unroll
    for (int a = 0; a < 2; ++a)
#pragma unroll
        for (int b = 0; b < 2; ++b)
#pragma unroll
            for (int m = 0; m < 4; ++m)
#pragma unroll
                for (int n = 0; n < 2; ++n) acc[a][b][m][n] = (f32x4){0.f, 0.f, 0.f, 0.f};
    bf16x8 At[4][2], B0[2][2], B1[2][2];
    const char* cA = (const char*)g.A + (size_t)cur.pm * tstep; const char* cB = (const char*)g.Bt + (size_t)cur.pn * tstep;
    S.a_ready(cur);
    if constexpr (SP2) {
        PG8_STAGE(PG8_SB(0, 0), cB, voffB); PG8_STAGE(PG8_SB(0, 1), cB + hstep, voffB); PG8_STAGE(PG8_SA(0, 0), cA, voffA); PG8_STAGE(PG8_SA(0, 1), cA + hstep, voffA);
        if (wr == 1) PG8_BAR;
        PG8_WAIT_V(2); PG8_BAR;
        PG8_STAGE(PG8_SB(1, 0), cB + kstep, voffB); PG8_STAGE(PG8_SA(1, 0), cA + kstep, voffA); PG8_STAGE(PG8_SB(1, 1), cB + hstep + kstep, voffB);
        PG8_WAIT_V(6); PG8_BAR;
    } else {
        PG8_STAGE(PG8_SB(0, 0), cB, voffB); PG8_STAGE(PG8_SA(0, 0), cA, voffA); PG8_STAGE(PG8_SB(0, 1), cB + hstep, voffB); PG8_STAGE(PG8_SA(0, 1), cA + hstep, voffA);
        if (wr == 1) PG8_BAR;
        PG8_WAIT_V(4); PG8_BAR;
        PG8_STAGE(PG8_SB(1, 0), cB + kstep, voffB); PG8_STAGE(PG8_SA(1, 0), cA + kstep, voffA); PG8_STAGE(PG8_SB(1, 1), cB + hstep + kstep, voffB);
        PG8_WAIT_V(6); PG8_BAR;
    }
    for (;;) {
        const bool has_next = S.next(ui + 1, nxt);
        const char* nA = has_next ? (const char*)g.A + (size_t)nxt.pm * tstep : cA; const char* nB = has_next ? (const char*)g.Bt + (size_t)nxt.pn * tstep : cB;
        for (int t = 0; t < nt; t += 2) {
            const bool last = (t == nt - 2);
            const char* a1 = cA + (size_t)(t + 1) * kstep;
            const char* a2 = last ? nA : cA + (size_t)(t + 2) * kstep; const char* b2 = last ? nB : cB + (size_t)(t + 2) * kstep;
            const char* a3 = a2 + kstep; const char* b3 = b2 + kstep;
            if (last && has_next) S.a_ready(nxt);
            if constexpr (SP2) {
            PG8_LDB(B0, 0, 0); PG8_LDB(B1, 0, 1); PG8_SCHED; PG8_LDA(At, 0, 0); PG8_STAGE(PG8_SA(1, 1), a1 + hstep, voffA);
            PG8_WAIT_V(8); PG8_WAIT_L(0); PG8_BAR; PG8_MMA(0, 0, At, B0); PG8_MMA(0, 1, At, B1); PG8_BAR; PG8_SCHED;
            PG8_LDA(At, 0, 1); PG8_STAGE(PG8_SB(0, 0), b2, voffB); PG8_STAGE(PG8_SB(0, 1), b2 + hstep, voffB); PG8_STAGE(PG8_SA(0, 0), a2, voffA);
            PG8_WAIT_V(8); PG8_WAIT_L(0); PG8_BAR; PG8_MMA(1, 0, At, B0); PG8_MMA(1, 1, At, B1); PG8_BAR; PG8_SCHED;
            PG8_LDB(B0, 1, 0); PG8_LDB(B1, 1, 1); PG8_SCHED; PG8_LDA(At, 1, 0); PG8_STAGE(PG8_SA(0, 1), a2 + hstep, voffA);
            PG8_WAIT_V(8); PG8_WAIT_L(0); PG8_BAR; PG8_MMA(0, 0, At, B0); PG8_MMA(0, 1, At, B1); PG8_BAR; PG8_SCHED;
            PG8_LDA(At, 1, 1); PG8_STAGE(PG8_SB(1, 0), b3, voffB); PG8_STAGE(PG8_SB(1, 1), b3 + hstep, voffB); PG8_STAGE(PG8_SA(1, 0), a3, voffA);
            PG8_WAIT_V(8); PG8_WAIT_L(0); PG8_BAR; PG8_MMA(1, 0, At, B0); PG8_MMA(1, 1, At, B1); PG8_BAR; PG8_SCHED;
            } else {
            PG8_LDB(B0, 0, 0); PG8_SCHED; PG8_LDA(At, 0, 0); PG8_STAGE(PG8_SA(1, 1), a1 + hstep, voffA);
            PG8_WAIT_L(8); PG8_BAR; PG8_WAIT_L(0); PG8_MMA(0, 0, At, B0); PG8_BAR; PG8_SCHED;
            PG8_LDB(B1, 0, 1); PG8_STAGE(PG8_SB(0, 0), b2, voffB);
            PG8_BAR; PG8_WAIT_L(0); PG8_MMA(0, 1, At, B1); PG8_BAR;
            PG8_LDA(At, 0, 1); PG8_STAGE(PG8_SA(0, 0), a2, voffA);
            PG8_BAR; PG8_WAIT_L(0); PG8_MMA(1, 0, At, B0); PG8_BAR; PG8_SCHED;
            PG8_STAGE(PG8_SB(0, 1), b2 + hstep, voffB);
            PG8_WAIT_V(6); PG8_BAR; PG8_MMA(1, 1, At, B1); PG8_BAR;
            PG8_LDB(B0, 1, 0); PG8_SCHED; PG8_LDA(At, 1, 0); PG8_STAGE(PG8_SA(0, 1), a2 + hstep, voffA);
            PG8_WAIT_L(8); PG8_BAR; PG8_WAIT_L(0); PG8_MMA(0, 0, At, B0); PG8_BAR; PG8_SCHED;
            PG8_LDB(B1, 1, 1); PG8_STAGE(PG8_SB(1, 0), b3, voffB);
            PG8_BAR; PG8_WAIT_L(0); PG8_MMA(0, 1, At, B1); PG8_BAR;
            PG8_LDA(At, 1, 1); PG8_STAGE(PG8_SA(1, 0), a3, voffA);
            PG8_BAR; PG8_WAIT_L(0); PG8_MMA(1, 0, At, B0); PG8_BAR; PG8_SCHED;
            PG8_STAGE(PG8_SB(1, 1), b3 + hstep, voffB);
            PG8_WAIT_V(6); PG8_BAR; PG8_MMA(1, 1, At, B1); PG8_BAR;
            }
        }
        if constexpr (ALIGN_EPI) { if (wr == 0) PG8_BAR; }
        if constexpr (!Epi::AFTER_DRAIN) { E(acc, cur, wr, wc, fr, fq); S.done(cur); }
        if (!has_next) break;
#pragma unroll
        for (int a = 0; a < 2; ++a)
#pragma unroll
            for (int b = 0; b < 2; ++b)
#pragma unroll
                for (int m = 0; m < 4; ++m)
#pragma unroll
                    for (int n = 0; n < 2; ++n) acc[a][b][m][n] = (f32x4){0.f, 0.f, 0.f, 0.f};
        cur = nxt; cA = nA; cB = nB; ++ui;
        if constexpr (ALIGN_EPI) { if (wr == 1) PG8_BAR; }
    }
    PG8_WAIT_V(0);
    if constexpr (!ALIGN_EPI) { if (wr == 0) PG8_BAR; }
    PG8_BAR;
    if constexpr (Epi::AFTER_DRAIN) { E.fused(acc, cur, wr, wc, fr, fq, lds, wid, lane); S.done(cur); }
#undef PG8_SA
#undef PG8_SB
#undef PG8_STAGE
#undef PG8_LDA
#undef PG8_LDB
#undef PG8_MMA
#undef PG8_WAIT_V
#undef PG8_WAIT_L
#undef PG8_BAR
#undef PG8_SCHED
}
}
#include <hip/hip_bf16.h>
#include <cmath>
namespace attn_body {
using bf16=__hip_bfloat16;
using bf16x8=__attribute__((ext_vector_type(8)))short;
using s16x4=__attribute__((ext_vector_type(4)))short;
using f32x16=__attribute__((ext_vector_type(16)))float;
using u32x4=__attribute__((ext_vector_type(4)))unsigned;
constexpr int D=64,PITCH=2560,OPITCH=1024;
constexpr int NW=8,QBLK=32,KVBLK=64;
__device__ __forceinline__ int crow(int r,int hi){return (r&3)+8*(r>>2)+4*hi;}
#define SBAR() __builtin_amdgcn_sched_barrier(0)
__device__ __forceinline__ void wmask(f32x16&p0,f32x16&p1,int type,int qq,int hi){
  const float NEG=-INFINITY; const int kb=4*hi;
  if(type==1){
    #pragma unroll
    for(int r=0;r<16;++r){int kk=kb+(r&3)+8*(r>>2); if(kk<qq)p0[r]=NEG; if(kk+32<qq)p1[r]=NEG;}
  } else {
    #pragma unroll
    for(int r=0;r<16;++r){int kk=kb+(r&3)+8*(r>>2); if(kk>qq)p0[r]=NEG; if(kk+32>qq)p1[r]=NEG;}
  }
}

constexpr int NSLOT=3, SLOTB=8192;
constexpr int LDS_K=0, LDS_V=NSLOT*SLOTB, LDS_WS=2*NSLOT*SLOTB, LDS_OST=LDS_WS+NW*64*4, LDS_BYTES=LDS_OST+NW*4096;
constexpr float C2=0.125f*1.4426950408889634f;
__device__ __forceinline__ void glds16(const void*gsrc,unsigned lds_dst){unsigned keep;
  asm volatile("s_mov_b32 %0, m0\n\ts_mov_b32 m0, %2\n\ts_nop 0\n\tglobal_load_lds_dwordx4 %1, off\n\ts_mov_b32 m0, %0":"=&s"(keep):"v"(gsrc),"s"(lds_dst):"memory");}
__device__ __forceinline__ float max3f(float a,float b,float c){float r;asm("v_max3_f32 %0, %1, %2, %3":"=v"(r):"v"(a),"v"(b),"v"(c));return r;}
__device__ __forceinline__ float max2f(float a,float b){float r;asm("v_max_f32_e32 %0, %1, %2":"=v"(r):"v"(a),"v"(b));return r;}
__device__ __forceinline__ float fadd_s(float a,float b){float r;asm("v_add_f32_e32 %0, %1, %2":"=v"(r):"v"(a),"v"(b));return r;}
__device__ __forceinline__ float fsub_s(float a,float b){float r;asm("v_sub_f32_e32 %0, %1, %2":"=v"(r):"v"(a),"v"(b));return r;}
typedef float f32x2_t __attribute__((ext_vector_type(2))); typedef __bf16 bf16x2_t __attribute__((ext_vector_type(2)));
__device__ __forceinline__ unsigned cvtpk_s(float lo,float hi){f32x2_t v={lo,hi};bf16x2_t b=__builtin_convertvector(v,bf16x2_t);return __builtin_bit_cast(unsigned,b);}
#define WAIT_BAR(N) asm volatile("s_waitcnt vmcnt(" #N ") lgkmcnt(0)\n\ts_barrier":::"memory")

__device__ __forceinline__ void qkt(f32x16&p0,f32x16&p1,const char*Kslot,const bf16x8*qr,int r32,int hi){ const f32x16 negm=f32x16{};
  const char*kb=Kslot+hi*1024+r32*16;
  #pragma unroll
  for(int d0=0;d0<4;++d0){
    const bf16x8 b0=*reinterpret_cast<const bf16x8*>(kb+d0*2048);
    const bf16x8 b1=*reinterpret_cast<const bf16x8*>(kb+d0*2048+512);
    if(d0==0){p0=__builtin_amdgcn_mfma_f32_32x32x16_bf16(b0,qr[0],negm,0,0,0);p1=__builtin_amdgcn_mfma_f32_32x32x16_bf16(b1,qr[0],negm,0,0,0);}
    else{p0=__builtin_amdgcn_mfma_f32_32x32x16_bf16(b0,qr[d0],p0,0,0,0);p1=__builtin_amdgcn_mfma_f32_32x32x16_bf16(b1,qr[d0],p1,0,0,0);}}
}
typedef __attribute__((address_space(3))) const char* lds_cptr;
typedef short v4i16_t __attribute__((ext_vector_type(4)));
__device__ __forceinline__ void kload8(bf16x8*kf,lds_cptr kp){
  kf[0]=*(const __attribute__((address_space(3))) bf16x8*)(kp);      kf[1]=*(const __attribute__((address_space(3))) bf16x8*)(kp+512);
  kf[2]=*(const __attribute__((address_space(3))) bf16x8*)(kp+2048); kf[3]=*(const __attribute__((address_space(3))) bf16x8*)(kp+2560);
  kf[4]=*(const __attribute__((address_space(3))) bf16x8*)(kp+4096); kf[5]=*(const __attribute__((address_space(3))) bf16x8*)(kp+4608);
  kf[6]=*(const __attribute__((address_space(3))) bf16x8*)(kp+6144); kf[7]=*(const __attribute__((address_space(3))) bf16x8*)(kp+6656);
}
__device__ __forceinline__ void kload2(bf16x8*kf,lds_cptr kp,int j){ kf[2*j]=*(const __attribute__((address_space(3))) bf16x8*)(kp+j*2048); kf[2*j+1]=*(const __attribute__((address_space(3))) bf16x8*)(kp+j*2048+512); }
__device__ __forceinline__ s16x4 vtr(lds_cptr p){ return __builtin_bit_cast(s16x4,__builtin_amdgcn_ds_read_tr16_b64_v4i16((__attribute__((address_space(3))) v4i16_t*)p)); }
__device__ __forceinline__ float rowmax(const f32x16&p0,const f32x16&p1){
  float a=max3f(p0[0],p0[1],p1[0]),b=max3f(p0[2],p0[3],p1[1]);a=max3f(a,p1[2],p1[3]);
  #pragma unroll
  for(int r=4;r<16;r+=4){a=max3f(a,p0[r],p0[r+1]);b=max3f(b,p0[r+2],p0[r+3]);a=max3f(a,p1[r],p1[r+1]);b=max3f(b,p1[r+2],p1[r+3]);}
  const float m=max2f(a,b);
  auto rr=__builtin_amdgcn_permlane32_swap(__float_as_uint(m),__float_as_uint(m),false,false);
  return max2f(__uint_as_float(rr[0]),__uint_as_float(rr[1]));
}
__device__ __forceinline__ void pv(f32x16*o,int vb,bf16x8 pa0,bf16x8 pa1,bf16x8 pa2,bf16x8 pa3){
  #pragma unroll
  for(int d0=0;d0<2;++d0){s16x4 lo[4],hi[4];
    #pragma unroll
    for(int ks=0;ks<4;++ks){
      asm volatile("ds_read_b64_tr_b16 %0,%1 offset:%c2":"=&v"(lo[ks]):"v"(vb),"i"(d0*4096+ks*1024):"memory");
      asm volatile("ds_read_b64_tr_b16 %0,%1 offset:%c2":"=&v"(hi[ks]):"v"(vb),"i"(d0*4096+ks*1024+512):"memory");}
    asm volatile("s_waitcnt lgkmcnt(0)":::"memory");SBAR();
    #define PK(k) (bf16x8){lo[k][0],lo[k][1],lo[k][2],lo[k][3],hi[k][0],hi[k][1],hi[k][2],hi[k][3]}
    o[d0]=__builtin_amdgcn_mfma_f32_32x32x16_bf16(pa0,PK(0),o[d0],0,0,0);
    o[d0]=__builtin_amdgcn_mfma_f32_32x32x16_bf16(pa1,PK(1),o[d0],0,0,0);
    o[d0]=__builtin_amdgcn_mfma_f32_32x32x16_bf16(pa2,PK(2),o[d0],0,0,0);
    o[d0]=__builtin_amdgcn_mfma_f32_32x32x16_bf16(pa3,PK(3),o[d0],0,0,0);
    #undef PK
  }
}

template<int THRL> __device__ __forceinline__ void attn_unit(int b,int kvh,int q0,const bf16*X,bf16*O,float sk2,char*shm){
  const int tid=threadIdx.x,lane=tid&63,r32=lane&31,hi=lane>>5; const int wid=__builtin_amdgcn_readfirstlane(tid>>6);
  const int hq=kvh*4+(wid>>1); const long qrow0=(long)b*8192+q0+(wid&1)*QBLK;
  const bf16*Qw=X+qrow0*PITCH+hq*D;
  const bf16*Kh=X+1024+kvh*D,*Vh=X+1280+kvh*D;
  const int ctx0=16384+b*256;
  const int jlo=(q0>=128)?-2:-(q0>>6), jhi=(q0+128<8192)?2:((8192-64-q0)>>6);
  const int NT=4+(jhi-jlo+1);
  const int latb=b*8192+q0+64*(jlo-4);
  #define TROW(t) (((t)<4)?(ctx0+64*(t)):(latb+64*(t)))
  #define TMASK(t) ((((t)==4)&&(jlo==-2))?1:((((t)==NT-1)&&(jhi==2))?2:0))
  const unsigned lds0=(unsigned)(uintptr_t)shm;
  float*wsf=(float*)(shm+LDS_WS)+wid*64;
  const bf16*ksrc=Kh+(long)lane*PITCH+wid*8;
  const bf16*vsrc=Vh+(long)(16*(wid&3)+(lane>>2))*PITCH+(wid>>2)*32+(lane&3)*8;
  const unsigned kdst=lds0+LDS_K+wid*1024, vdst=lds0+LDS_V+wid*1024;
  #define DMA_K(t,slot) glds16(ksrc+(long)TROW(t)*PITCH,(unsigned)__builtin_amdgcn_readfirstlane(kdst+(slot)))
  #define DMA_V(t,slot) glds16(vsrc+(long)TROW(t)*PITCH,(unsigned)__builtin_amdgcn_readfirstlane(vdst+(slot)))
  const int vb0=(int)(lds0+LDS_V)+((lane>>4)&1)*32+(lane&3)*8+(4*hi+((lane&15)>>2))*64;
  const char*Kbase=shm+LDS_K; bf16x8 kf[8];
  const lds_cptr shm3=(lds_cptr)shm; const lds_cptr kp0=shm3+LDS_K+hi*1024+r32*16; const lds_cptr vp0=shm3+LDS_V+((lane>>4)&1)*32+(lane&3)*8+(4*hi+((lane&15)>>2))*64;
  DMA_K(0,0);DMA_V(0,0);DMA_K(1,SLOTB);
  bf16x8 qr[4];
  #pragma unroll
  for(int d0=0;d0<4;++d0)qr[d0]=*reinterpret_cast<const bf16x8*>(&Qw[(long)r32*PITCH+d0*16+hi*8]);
  float mhat=0.f,l_reg=0.f;f32x16 o[2];o[0]=f32x16{};o[1]=f32x16{};const f32x16 zc=f32x16{};
  const int qrel=(wid&1)*QBLK+r32;
  #define CMASK(P0,P1,t) do{const int mt_=TMASK(t); if(mt_)wmask(P0,P1,mt_,qrel,hi);}while(0)
  bool resc=false;
  #define START(P0,P1) do{ const float rm=rowmax(P0,P1); resc=false; mhat=rm; \
    _Pragma("unroll") for(int r=0;r<16;++r)P0[r]=__builtin_amdgcn_exp2f(fsub_s(P0[r],mhat)); }while(0)
  #define RESC() do{ if(resc){ asm volatile("s_waitcnt lgkmcnt(0)":::"memory"); \
      _Pragma("unroll") for(int d_=0;d_<2;++d_) _Pragma("unroll") for(int r=0;r<16;++r)o[d_][r]*=wsf[crow(r,hi)]; } }while(0)
  f32x16 pA0,pA1,pB0,pB1;
  int sl_prev=0,sl_cur=0,sl_next=SLOTB;
  #define ROT() do{sl_prev=sl_cur;sl_cur=sl_next;sl_next=(sl_next==(NSLOT-1)*SLOTB)?0:sl_next+SLOTB;}while(0)
  DMA_K(2,2*SLOTB);
  WAIT_BAR(3);
  qkt(pA0,pA1,Kbase,qr,r32,hi);asm volatile("s_nop 15\n\ts_nop 7":"+v"(pA0),"+v"(pA1));CMASK(pA0,pA1,0);
  START(pA0,pA1);
  _Pragma("unroll") for(int r=0;r<16;++r)pA1[r]=__builtin_amdgcn_exp2f(fsub_s(pA1[r],mhat));
  WAIT_BAR(0);
  DMA_K(3,0);DMA_V(1,SLOTB);
  ROT();
  kload8(kf,kp0+sl_cur);
  WAIT_BAR(2);
  s16x4 vlo[8],vhi[8]; u32x4 pw0,pw1,pw2,pw3;
  #define PKW(P,B) cvtpk_s(P[B],P[B+1])
  #define PAF(k) __builtin_bit_cast(bf16x8,pw##k)
  #define VFR(i) (bf16x8){vlo[i][0],vlo[i][1],vlo[i][2],vlo[i][3],vhi[i][0],vhi[i][1],vhi[i][2],vhi[i][3]}
  #define PIN(x) asm volatile("":"+v"(x))
  #define MX3(a,b,c) __builtin_fmaxf(__builtin_fmaxf((a),(b)),(c))
  #define GAPA(MF,A0,A1,A2,A3,W0,W1,PW) do{ MF; sacc+=A0; sacc+=A1; sacc+=A2; sacc+=A3; PIN(sacc); W0; W1; PIN(PW); SBAR(); }while(0)
  #define EX(v) __builtin_amdgcn_exp2f(v)
  #define GAPB(MF,X,B) do{ MF; X[B]=EX(X[B]-mhat); X[B+1]=EX(X[B+1]-mhat); X[B+2]=EX(X[B+2]-mhat); X[B+3]=EX(X[B+3]-mhat); PIN(X); SBAR(); }while(0)
  #define VRD(i) do{ vlo[i]=vtr(vp_+(((i)>>2)*4096+((i)&3)*1024)); vhi[i]=vtr(vp_+(((i)>>2)*4096+((i)&3)*1024+512)); }while(0)
  #define KRD(G,j) do{ if(G){ kload2(kf,kp0+sl_next,j); SBAR(); } }while(0)
  #define STEP(C0,C1,P0,P1,t,GK,GV,GL) do{ SBAR(); \
    const lds_cptr vp_=vp0+sl_prev; \
    VRD(0); SBAR(); float sacc=(P0[0]+P0[1]); \
    GAPA(C0=__builtin_amdgcn_mfma_f32_32x32x16_bf16(kf[0],qr[0],zc,0,0,0), P0[2],P0[3],P0[4],P0[5],     pw0[0]=PKW(P0,0), pw0[1]=PKW(P0,2), pw0); \
    VRD(4); SBAR(); GAPA(C1=__builtin_amdgcn_mfma_f32_32x32x16_bf16(kf[1],qr[0],zc,0,0,0), P0[6],P0[7],P0[8],P0[9],     pw0[2]=PKW(P0,4), pw0[3]=PKW(P0,6), pw0); \
    VRD(1); SBAR(); GAPA(C0=__builtin_amdgcn_mfma_f32_32x32x16_bf16(kf[2],qr[1],C0,0,0,0),   P0[10],P0[11],P0[12],P0[13], pw1[0]=PKW(P0,8), pw1[1]=PKW(P0,10), pw1); \
    VRD(5); SBAR(); GAPA(C1=__builtin_amdgcn_mfma_f32_32x32x16_bf16(kf[3],qr[1],C1,0,0,0),   P0[14],P0[15],P1[0],P1[1],   pw1[2]=PKW(P0,12),pw1[3]=PKW(P0,14), pw1); \
    VRD(2); SBAR(); GAPA(C0=__builtin_amdgcn_mfma_f32_32x32x16_bf16(kf[4],qr[2],C0,0,0,0),   P1[2],P1[3],P1[4],P1[5],     pw2[0]=PKW(P1,0), pw2[1]=PKW(P1,2), pw2); \
    VRD(6); SBAR(); GAPA(C1=__builtin_amdgcn_mfma_f32_32x32x16_bf16(kf[5],qr[2],C1,0,0,0),   P1[6],P1[7],P1[8],P1[9],     pw2[2]=PKW(P1,4), pw2[3]=PKW(P1,6), pw2); \
    VRD(3); SBAR(); GAPA(C0=__builtin_amdgcn_mfma_f32_32x32x16_bf16(kf[6],qr[3],C0,0,0,0),   P1[10],P1[11],P1[12],P1[13], pw3[0]=PKW(P1,8), pw3[1]=PKW(P1,10), pw3); \
    VRD(7); SBAR(); GAPA(C1=__builtin_amdgcn_mfma_f32_32x32x16_bf16(kf[7],qr[3],C1,0,0,0),   P1[14],P1[15],0.f,0.f,       pw3[2]=PKW(P1,12),pw3[3]=PKW(P1,14), pw3); \
    l_reg+=sacc; \
    if(GK){DMA_K((t)+3,sl_cur);} if(GV){DMA_V((t)+1,sl_next);} \
    CMASK(C0,C1,t); \
    { float a=MX3(C0[0],C0[1],C1[0]),b=MX3(C0[2],C0[3],C1[1]); a=MX3(a,C1[2],C1[3]); \
      _Pragma("unroll") for(int r=4;r<16;r+=4){a=MX3(a,C0[r],C0[r+1]);b=MX3(b,C0[r+2],C0[r+3]);a=MX3(a,C1[r],C1[r+1]);b=MX3(b,C1[r+2],C1[r+3]);} \
      float rm=__builtin_fmaxf(a,b); { auto rr=__builtin_amdgcn_permlane32_swap(__float_as_uint(rm),__float_as_uint(rm),false,false); rm=__builtin_fmaxf(__uint_as_float(rr[0]),__uint_as_float(rr[1])); } \
      resc=false; \
      rm-=mhat; \
      if(__builtin_expect(__any(rm>(float)THRL),0)){ const float dl=__builtin_fmaxf(rm,0.f); mhat+=dl; \
        const float f=__builtin_amdgcn_exp2f(-dl); l_reg*=f; if(hi==0)wsf[r32]=f; resc=true; } } \
    SBAR(); \
    GAPB(o[0]=__builtin_amdgcn_mfma_f32_32x32x16_bf16(PAF(0),VFR(0),o[0],0,0,0), C0,0); \
    GAPB(o[1]=__builtin_amdgcn_mfma_f32_32x32x16_bf16(PAF(0),VFR(4),o[1],0,0,0), C0,4); \
    KRD(GL,0); GAPB(o[0]=__builtin_amdgcn_mfma_f32_32x32x16_bf16(PAF(1),VFR(1),o[0],0,0,0), C0,8); \
    KRD(GL,1); GAPB(o[1]=__builtin_amdgcn_mfma_f32_32x32x16_bf16(PAF(1),VFR(5),o[1],0,0,0), C0,12); \
    KRD(GL,2); GAPB(o[0]=__builtin_amdgcn_mfma_f32_32x32x16_bf16(PAF(2),VFR(2),o[0],0,0,0), C1,0); \
    KRD(GL,3); GAPB(o[1]=__builtin_amdgcn_mfma_f32_32x32x16_bf16(PAF(2),VFR(6),o[1],0,0,0), C1,4); \
    GAPB(o[0]=__builtin_amdgcn_mfma_f32_32x32x16_bf16(PAF(3),VFR(3),o[0],0,0,0), C1,8); \
    GAPB(o[1]=__builtin_amdgcn_mfma_f32_32x32x16_bf16(PAF(3),VFR(7),o[1],0,0,0), C1,12); \
    }while(0)
  #define ENDW(tt) do{ if((tt)+3<NT){WAIT_BAR(2);} else if((tt)+2<NT){WAIT_BAR(1);} else {WAIT_BAR(0);} }while(0)
  #define DRAIN(PX0,PX1) do{ float sacc=PX0[0]+PX0[1]; _Pragma("unroll") for(int r=2;r<16;++r)sacc+=PX0[r]; _Pragma("unroll") for(int r=0;r<16;++r)sacc+=PX1[r]; l_reg+=sacc; \
    pw0=(u32x4){PKW(PX0,0),PKW(PX0,2),PKW(PX0,4),PKW(PX0,6)};pw1=(u32x4){PKW(PX0,8),PKW(PX0,10),PKW(PX0,12),PKW(PX0,14)};pw2=(u32x4){PKW(PX1,0),PKW(PX1,2),PKW(PX1,4),PKW(PX1,6)};pw3=(u32x4){PKW(PX1,8),PKW(PX1,10),PKW(PX1,12),PKW(PX1,14)}; \
    SBAR(); pv(o,vb0+sl_cur,PAF(0),PAF(1),PAF(2),PAF(3)); }while(0)
  int t=1;
  if(NT&1){
    STEP(pB0,pB1,pA0,pA1,t,(t+3<NT),(t+1<NT),(t+1<NT));       ENDW(t);   RESC(); ROT();
    pA0=pB0; pA1=pB1; t=2;
  }
  for(;t+2<NT;t+=2){
    STEP(pB0,pB1,pA0,pA1,t,(t+3<NT),(t+1<NT),(t+1<NT));       ENDW(t);   RESC(); ROT();
    STEP(pA0,pA1,pB0,pB1,t+1,(t+4<NT),(t+2<NT),(t+2<NT));     ENDW(t+1); RESC(); ROT();
  }
  STEP(pB0,pB1,pA0,pA1,NT-1,false,false,false); RESC();
  DRAIN(pB0,pB1);
  #undef DRAIN
  #undef PKW
  #undef PAF
  #undef VFR
  #undef PIN
  #undef MX3
  #undef GAPA
  #undef GAPB
  #undef EX
  #undef VRD
  #undef KRD
  #undef STEP
  #undef ENDW
  {auto rr=__builtin_amdgcn_permlane32_swap(__float_as_uint(l_reg),__float_as_uint(l_reg),false,false);l_reg=__uint_as_float(rr[0])+__uint_as_float(rr[1]);}
  l_reg+=__builtin_amdgcn_exp2f(sk2-mhat);
  if(hi==0)wsf[32+r32]=l_reg;asm volatile("s_waitcnt lgkmcnt(0)":::"memory");
  float rli[16];
  #pragma unroll
  for(int r=0;r<16;++r)rli[r]=__builtin_amdgcn_rcpf(wsf[32+crow(r,hi)]);
  bf16*Ow=O+qrow0*OPITCH+hq*D; const bf16*Gw=X+qrow0*PITCH+1536+hq*D;
  { bf16*stg=(bf16*)(shm+LDS_OST)+wid*2048;
    #pragma unroll
    for(int r=0;r<16;++r){const int orow=crow(r,hi);
      #pragma unroll
      for(int d0=0;d0<2;++d0)stg[orow*64+d0*32+r32]=__float2bfloat16(o[d0][r]*rli[r]);}
    asm volatile("s_waitcnt lgkmcnt(0)":::"memory");
    #pragma unroll
    for(int i=0;i<4;++i){const int row=i*8+(lane>>3),ch=lane&7; const u32x4 v=*(const u32x4*)(stg+row*64+ch*8); const u32x4 gq=*(const u32x4*)(Gw+(long)row*PITCH+ch*8); u32x4 w;
      #pragma unroll
      for(int e=0;e<4;++e){ const float g0=__uint_as_float(gq[e]<<16),g1=__uint_as_float(gq[e]&0xffff0000u),v0=__uint_as_float(v[e]<<16),v1=__uint_as_float(v[e]&0xffff0000u);
        w[e]=cvtpk_s(v0*g0*__builtin_amdgcn_rcpf(1.f+__builtin_amdgcn_exp2f(-1.4426950408889634f*g0)),v1*g1*__builtin_amdgcn_rcpf(1.f+__builtin_amdgcn_exp2f(-1.4426950408889634f*g1))); }
      *(u32x4*)(Ow+(long)row*OPITCH+ch*8)=w;} }
  asm volatile("s_waitcnt lgkmcnt(0)\n\ts_barrier":::"memory");
  #undef DMA_K
  #undef DMA_V
  #undef TROW
  #undef TMASK
  #undef CMASK
  #undef START
  #undef RESC
  #undef ROT
}
constexpr int ATTN_LDS_BYTES=LDS_BYTES;
template<int THRL=8> __device__ __forceinline__ void attn_phase(char*lds,const bf16*X,bf16*O,const float*sink,int grid,int block){
  const int vcu=(grid%8==0)?(block%8)*(grid/8)+block/8:block;
  const int wid=__builtin_amdgcn_readfirstlane(threadIdx.x>>6);
  for(int u=vcu*4;u<1024;u+=grid*4){
    #pragma unroll 1
    for(int i=0;i<4;++i){ const int uu=u+i; if(uu>=1024)break; const int bk=uu>>7, qb=uu&127, b=bk>>2, kvh=bk&3;
      attn_unit<THRL>(b,kvh,qb*64,X,O,sink[kvh*4+(wid>>1)]*1.4426950408889634f,lds); }
  }
}
#undef SBAR
#undef WAIT_BAR
}
#ifndef S5_CHECK
#define S5_CHECK 0
#endif
#ifndef ATTN_SIMPLE
#define ATTN_SIMPLE 0
#endif
#ifndef ATTN_CHECK
#define ATTN_CHECK 0
#endif
constexpr int D = 1024, SEQ = 8192, CTXN = 256, MLAT = 16384, MCTX = 512, M = MLAT + MCTX, PW = 2560;
constexpr float ALPHA = 1.41421356237309515f, LN_EPS = 1e-5f;
constexpr float LOG2E = 1.4426950408889634f, QSCALE = 0.125f * 1.4426950408889634f;
constexpr int NWAVES = 8, NTHREADS = 512;
constexpr int LDS_BYTES = 147456;
constexpr size_t MiB = 1u << 20;
constexpr size_t WS_MODV = 1 * MiB;
constexpr size_t WS_ROPE = 1 * MiB + 256 * 1024;
constexpr size_t WS_S5A = 1 * MiB + 512 * 1024;
constexpr size_t WS_S5A128 = 1 * MiB + 512 * 1024 + 32 * 1024;
constexpr size_t WS_BBT = 2 * MiB;
constexpr size_t WS_CT = 2 * MiB + 256 * 1024;
constexpr size_t WS_S5BB = 2 * MiB + 512 * 1024;
constexpr size_t WS_E = 3 * MiB;
constexpr size_t WS_WIN0 = 8 * MiB, WS_WOUT0 = 13 * MiB, WS_WGLU = 15 * MiB, WS_WIN1 = 16 * MiB, WS_WOUT1 = 21 * MiB;
constexpr size_t WS_H = 24 * MiB;
constexpr size_t WS_P = 57 * MiB;
constexpr size_t WS_MIX = 140 * MiB;
constexpr size_t WS_YA1 = 173 * MiB;
constexpr size_t WS_Z1C = 190 * MiB;
constexpr size_t WS_YAF = 192 * MiB;

typedef unsigned short bf16;
typedef float f32x4 __attribute__((ext_vector_type(4)));
typedef unsigned u32x2 __attribute__((ext_vector_type(2)));
typedef unsigned u32x4 __attribute__((ext_vector_type(4)));
#define LAS __attribute__((address_space(3)))
__device__ __forceinline__ unsigned f2bf(float f) { unsigned u = __builtin_bit_cast(unsigned, f); return (u + 0x7fffu + ((u >> 16) & 1u)) >> 16; }
__device__ __forceinline__ unsigned pk2(float lo, float hi) { return f2bf(lo) | (f2bf(hi) << 16); }
__device__ __forceinline__ float bf2f(unsigned h) { return __builtin_bit_cast(float, h << 16); }
__device__ __forceinline__ float bflo(unsigned w) { return __builtin_bit_cast(float, w << 16); }
__device__ __forceinline__ float bfhi(unsigned w) { return __builtin_bit_cast(float, w & 0xffff0000u); }
__device__ __forceinline__ float silu_f(float v) { return v / (1.f + __expf(-v)); }
__device__ __forceinline__ float gelu_tanh_f(float v) { const float u = 0.7978845608028654f * (v + 0.044715f * v * v * v); return v / (1.f + __expf(-2.f * u)); }
__device__ __forceinline__ float wave_sum(float v) {
#pragma unroll
    for (int o = 1; o < 64; o <<= 1) v += __shfl_xor(v, o);
    return v;
}
#define LDS_WAIT() asm volatile("s_waitcnt lgkmcnt(0)" ::: "memory")

struct Args { const float* in[27]; float* out; unsigned char* ws; };
typedef const __attribute__((address_space(4))) Args KArgs;

__device__ __forceinline__ int row_vec(int r) { return r < MLAT ? (r >> 13) : 2; }
__device__ __forceinline__ int chunk_row0(int cidx) { const int b = cidx / 66, c = cidx % 66; return c < 2 ? MLAT + b * CTXN + c * 128 : b * SEQ + (c - 2) * 128; }

__device__ __forceinline__ void p0_transpose_item(const float* W, int K, int N, bf16* WT, LAS float* scr, int item, int lane) {
    const int nblk = N / 32, kb = item / nblk, nb = item % nblk, k0 = 64 * kb, n0 = 32 * nb;
#pragma unroll 8
    for (int i = 0; i < 32; ++i) { const int kk = 2 * i + (lane >> 5); scr[kk * 33 + (lane & 31)] = W[(size_t)(k0 + kk) * N + n0 + (lane & 31)]; }
    LDS_WAIT();
    const int c = lane & 7;
#pragma unroll
    for (int j = 0; j < 4; ++j) { const int n = (lane >> 3) + 8 * j; const LAS float* s = scr + (8 * c) * 33 + n;
        u32x4 o; o.x = pk2(s[0 * 33], s[1 * 33]); o.y = pk2(s[2 * 33], s[3 * 33]); o.z = pk2(s[4 * 33], s[5 * 33]); o.w = pk2(s[6 * 33], s[7 * 33]);
        *(u32x4*)(WT + (size_t)(n0 + n) * K + k0 + 8 * c) = o; }
    LDS_WAIT();
}
__device__ __forceinline__ void phase_prologue(KArgs& a, LAS unsigned char* lds, int tid, int lane, int wave, int bid, int G) {
    asm volatile("" : "+v"(lane)); asm volatile("" : "+v"(tid));
    unsigned char* ws = a.ws;
    if (bid < 96) {
        LAS float* sv = (LAS float*)lds;
        LAS float* red = (LAS float*)(lds + 12288);
        const float* c = a.in[1]; const float* cc = a.in[3];
        for (int i = tid; i < 1024; i += NTHREADS) { sv[i] = silu_f(c[i]); sv[1024 + i] = silu_f(c[1024 + i]); sv[2048 + i] = silu_f(cc[i]); }
        __syncthreads();
        const int layer = bid / 48, n = (bid % 48) * 64 + lane;
        const float* w = a.in[4] + (size_t)layer * 1024 * 3072 + (size_t)(wave * 128) * 3072 + n;
        float a0 = 0.f, a1 = 0.f, a2 = 0.f;
#pragma unroll 8
        for (int k = 0; k < 128; ++k) { const float wv = w[(size_t)k * 3072]; const int kk = wave * 128 + k; a0 += sv[kk] * wv; a1 += sv[1024 + kk] * wv; a2 += sv[2048 + kk] * wv; }
        red[(wave * 3 + 0) * 64 + lane] = a0; red[(wave * 3 + 1) * 64 + lane] = a1; red[(wave * 3 + 2) * 64 + lane] = a2;
        __syncthreads();
        if (wave == 0) {
            float* modv = (float*)(ws + WS_MODV); const float bb = a.in[5][layer * 3072 + n];
#pragma unroll
            for (int v = 0; v < 3; ++v) { float s = 0.f;
#pragma unroll
                for (int w8 = 0; w8 < 8; ++w8) s += red[(w8 * 3 + v) * 64 + lane];
                modv[(layer * 3 + v) * 3072 + n] = s + bb; }
        }
        __syncthreads();
    }
    {
        const int gt = bid * NTHREADS + tid;
        if (gt < 4096) {
            const int dg = gt >> 6, p = gt & 63;
            const double lr = a.in[10][dg * 64 + p], li = a.in[11][dg * 64 + p], dt = exp((double)a.in[12][dg]);
            const double mag = exp(lr * dt), ang = li * dt;
            const double ar = mag * cos(ang), ai = mag * sin(ang);
            const double den = lr * lr + li * li, nr = ar - 1.0, ni = ai;
            const double fr = (nr * lr + ni * li) / den, fi = (ni * lr - nr * li) / den;
            float* A = (float*)(ws + WS_S5A); float* BB = (float*)(ws + WS_S5BB);
            A[gt * 2] = (float)ar; A[gt * 2 + 1] = (float)ai;
            { const double m128 = exp(128.0 * lr * dt), a128 = 128.0 * ang; float* A128 = (float*)(ws + WS_S5A128); A128[gt * 2] = (float)(m128 * cos(a128)); A128[gt * 2 + 1] = (float)(m128 * sin(a128)); }
            for (int h = 0; h < 16; ++h) { const double br = a.in[13][gt * 16 + h], bi = a.in[14][gt * 16 + h];
                BB[(gt * 16 + h) * 2] = (float)(fr * br - fi * bi); BB[(gt * 16 + h) * 2 + 1] = (float)(fr * bi + fi * br); }
        } else if (gt >= 8192 && gt < 8192 + 16384) {
            const int e = gt - 8192, l = e & 63, tile = (e >> 6) & 3, dg = e >> 8;
            const int p = (tile >> 1) * 32 + (l & 31), ri = tile & 1, hb = l >> 5;
            const double lr = a.in[10][dg * 64 + p], li = a.in[11][dg * 64 + p], dt = exp((double)a.in[12][dg]);
            const double mag = exp(lr * dt), ang = li * dt;
            const double ar = mag * cos(ang), ai = mag * sin(ang);
            const double den = lr * lr + li * li, nr = ar - 1.0, ni = ai;
            const double fr = (nr * lr + ni * li) / den, fi = (ni * lr - nr * li) / den;
            unsigned w[4];
            for (int jj = 0; jj < 4; ++jj) { float v[2];
                for (int q = 0; q < 2; ++q) { const int h = 8 * hb + 2 * jj + q; const double br = a.in[13][(dg * 64 + p) * 16 + h], bi = a.in[14][(dg * 64 + p) * 16 + h];
                    v[q] = (float)(ri == 0 ? fr * br - fi * bi : fr * bi + fi * br); }
                w[jj] = pk2(v[0], v[1]); }
            *(u32x4*)(ws + WS_BBT + (size_t)e * 16) = (u32x4){w[0], w[1], w[2], w[3]};
        } else if (gt >= 32768 && gt < 32768 + 16384) {
            const int e = gt - 32768, l = e & 63, ks = (e >> 6) & 3, dg = e >> 8;
            const int hp = l & 15, kq = l >> 4;
            unsigned w[4];
            for (int jj = 0; jj < 4; ++jj) { const int p = (ks * 32 + 8 * kq + 2 * jj) >> 1;
                w[jj] = pk2(a.in[15][(dg * 16 + hp) * 64 + p], -a.in[16][(dg * 16 + hp) * 64 + p]); }
            *(u32x4*)(ws + WS_CT + (size_t)e * 16) = (u32x4){w[0], w[1], w[2], w[3]};
        } else if (gt >= 4096 && gt < 4096 + 2048) {
            const int e = gt - 4096, pos = e >> 4, fi = e & 15;
            const float inv = powf(10000.f, -(float)fi / 16.f);
            const float ang = (float)pos * inv;
            float* cs = (float*)(ws + WS_ROPE); cs[e * 2] = (float)cos((double)ang); cs[e * 2 + 1] = (float)sin((double)ang);
        }
    }
    {
        LAS float* scr = (LAS float*)(lds + 32768 + wave * 8448);
        const int gw = bid * NWAVES + wave, NGW = G * NWAVES;
        constexpr int I_IN = 16 * 80, I_OUT = 16 * 32, I_GLU = 8 * 16;
        constexpr int NITEMS = 2 * I_IN + 2 * I_OUT + I_GLU;
        for (int it = gw; it < NITEMS; it += NGW) {
            int r = it;
            if (r < I_IN) { p0_transpose_item(a.in[8], 1024, 2560, (bf16*)(ws + WS_WIN0), scr, r, lane); continue; } r -= I_IN;
            if (r < I_IN) { p0_transpose_item(a.in[24], 1024, 2560, (bf16*)(ws + WS_WIN1), scr, r, lane); continue; } r -= I_IN;
            if (r < I_OUT) { p0_transpose_item(a.in[9], 1024, 1024, (bf16*)(ws + WS_WOUT0), scr, r, lane); continue; } r -= I_OUT;
            if (r < I_OUT) { p0_transpose_item(a.in[25], 1024, 1024, (bf16*)(ws + WS_WOUT1), scr, r, lane); continue; } r -= I_OUT;
            p0_transpose_item(a.in[18], 512, 512, (bf16*)(ws + WS_WGLU), scr, r, lane);
        }
    }
}

__device__ __forceinline__ void phase_modulate0(KArgs& a, int lane, int wave, int bid, int G) {
    asm volatile("" : "+v"(lane));
    const float* modv = (const float*)(a.ws + WS_MODV);
    bf16* H = (bf16*)(a.ws + WS_H);
    const int gw = bid * NWAVES + wave, NGW = G * NWAVES;
    for (int r = gw; r < M; r += NGW) {
        const float* z = (r < MLAT) ? a.in[0] + (size_t)r * D : a.in[2] + (size_t)(r - MLAT) * D;
        const float* mv = modv + row_vec(r) * 3072;
#pragma unroll
        for (int j = 0; j < 4; ++j) { const int c = lane * 4 + 256 * j;
            const f32x4 v = *(const f32x4*)(z + c), sh = *(const f32x4*)(mv + c), sc = *(const f32x4*)(mv + D + c);
            const f32x4 h = v * (sc + 1.f) + sh;
            u32x2 o; o.x = pk2(h[0], h[1]); o.y = pk2(h[2], h[3]);
            *(u32x2*)(H + (size_t)r * D + c) = o; }
    }
}

__device__ __forceinline__ int seq_row(int b, int t) { return t < CTXN ? MLAT + b * CTXN + t : b * SEQ + (t - CTXN); }
__device__ __forceinline__ void phase_s5_naive(KArgs& a, LAS unsigned char* lds, int lane, int wave, int bid, int G, bf16* YA1) {
    asm volatile("" : "+v"(lane));
    const int gw = bid * NWAVES + wave;
    if (gw >= 64) return;
    const int b = gw >> 5, g = gw & 31, p = lane, hh = lane & 15;
    const bf16* P = (const bf16*)(a.ws + WS_P); float* YAF = (float*)(a.ws + WS_YAF);
    const float* A = (const float*)(a.ws + WS_S5A); const float* BB = (const float*)(a.ws + WS_S5BB);
    LAS float* sre = (LAS float*)(lds + wave * 512); LAS float* sim = sre + 64;
    for (int dir = 0; dir < 2; ++dir) {
        const int dg = dir * 32 + g;
        const float ar = A[(dg * 64 + p) * 2], ai = A[(dg * 64 + p) * 2 + 1];
        const float* bbp = BB + (size_t)(dg * 64 + p) * 32;
        const float* cre = a.in[15] + (dg * 16 + hh) * 64; const float* cim = a.in[16] + (dg * 16 + hh) * 64;
        const float dsk = a.in[17][g * 16 + hh];
        float sr = 0.f, si = 0.f;
        for (int j = 0; j < SEQ + CTXN; ++j) {
            const int t = (dir == 0) ? j : (j < CTXN ? CTXN - 1 - j : SEQ + 2 * CTXN - 1 - j);
            const int row = seq_row(b, t);
            const bf16* up = P + (size_t)row * PW + g * 16;
            const u32x4 u0 = *(const u32x4*)up, u1 = *(const u32x4*)(up + 8);
            float u[16];
#pragma unroll
            for (int h = 0; h < 4; ++h) { u[2 * h] = bflo(u0[h]); u[2 * h + 1] = bfhi(u0[h]); u[8 + 2 * h] = bflo(u1[h]); u[8 + 2 * h + 1] = bfhi(u1[h]); }
            float bur = 0.f, bui = 0.f;
#pragma unroll
            for (int h = 0; h < 16; ++h) { bur += bbp[2 * h] * u[h]; bui += bbp[2 * h + 1] * u[h]; }
            const float nr = ar * sr - ai * si + bur, ni = ar * si + ai * sr + bui;
            sr = nr; si = ni;
            sre[p] = sr; sim[p] = si;
            LDS_WAIT();
            if (p < 16) {
                float y = 0.f;
                for (int q = 0; q < 64; ++q) y += cre[q] * sre[q] - cim[q] * sim[q];
                const size_t o = (size_t)row * 512 + g * 16 + p;
                float uo = 0.f;
#pragma unroll
                for (int h = 0; h < 16; ++h) uo = (h == p) ? u[h] : uo;
                if (dir == 0) YAF[o] = y + dsk * uo;
                else YA1[o] = (bf16)f2bf(gelu_tanh_f(YAF[o] + y));
            }
            LDS_WAIT();
        }
    }
}

typedef short bf16x8 __attribute__((ext_vector_type(8)));
typedef float f32x16 __attribute__((ext_vector_type(16)));
typedef float f32x2_t __attribute__((ext_vector_type(2))); typedef __bf16 bf16x2_t __attribute__((ext_vector_type(2)));
__device__ __forceinline__ unsigned cvtpk(float lo, float hi) { f32x2_t v = {lo, hi}; bf16x2_t b = __builtin_convertvector(v, bf16x2_t); return __builtin_bit_cast(unsigned, b); }
__device__ __forceinline__ int s5_kidx(int dir, int c) { return dir == 0 ? c : (c == 1 ? 0 : (c == 0 ? 1 : 67 - c)); }
constexpr int S5_LDS_ROW = 272, S5_LDS_S = 32 * S5_LDS_ROW, S5_LDS_WAVE = S5_LDS_S + 8192;

template <int PASS>
__device__ __forceinline__ void s5_task(KArgs& a, LAS unsigned char* sl, int lane, int c, int g) {
    const int c32 = lane & 31, hb = lane >> 5;
    const bf16* P = (const bf16*)(a.ws + WS_P);
    const float* A = (const float*)(a.ws + WS_S5A); const float* A128 = (const float*)(a.ws + WS_S5A128);
    float* E = (float*)(a.ws + WS_E); bf16* YA1 = (bf16*)(a.ws + WS_YA1);
    const int r = lane & 31, beta_a = (r >> 2) & 1, s_a = (r & 3) + 4 * (r >> 3);
    const bf16* ua = P + (size_t)chunk_row0(beta_a * 66 + c) * PW + g * 16 + 8 * hb;
    LAS bf16* yl = (LAS bf16*)(sl + S5_LDS_S);
    const int hp = lane & 15, tq = lane >> 4;
    const float dsk = a.in[17][g * 16 + hp];
#pragma unroll 1
    for (int dir = 0; dir < 2; ++dir) {
        const int dg = dir * 32 + g;
        bf16x8 bbt[4], ct[4];
#pragma unroll
        for (int t = 0; t < 4; ++t) bbt[t] = *(const bf16x8*)(a.ws + WS_BBT + ((size_t)(dg * 4 + t) * 64 + lane) * 16);
        if (PASS == 2) {
#pragma unroll
            for (int t = 0; t < 4; ++t) ct[t] = *(const bf16x8*)(a.ws + WS_CT + ((size_t)(dg * 4 + t) * 64 + lane) * 16);
        }
        const float arA = A[(dg * 64 + c32) * 2], aiA = A[(dg * 64 + c32) * 2 + 1], arB = A[(dg * 64 + 32 + c32) * 2], aiB = A[(dg * 64 + 32 + c32) * 2 + 1];
        const int kk = s5_kidx(dir, c);
        float* Eb = E + ((size_t)((dir * 2 + hb) * 32 + g) * 66) * 128;
        float srA = 0.f, siA = 0.f, srB = 0.f, siB = 0.f;
        if (PASS == 2) {
            const float qrA = A128[(dg * 64 + c32) * 2], qiA = A128[(dg * 64 + c32) * 2 + 1], qrB = A128[(dg * 64 + 32 + c32) * 2], qiB = A128[(dg * 64 + 32 + c32) * 2 + 1];
            for (int k = 0; k < kk; ++k) {
                const f32x2_t eA = *(const f32x2_t*)(Eb + (size_t)k * 128 + c32 * 2), eB = *(const f32x2_t*)(Eb + (size_t)k * 128 + (32 + c32) * 2);
                const float nrA = qrA * srA - qiA * siA + eA.x, niA = qrA * siA + qiA * srA + eA.y;
                const float nrB = qrB * srB - qiB * siB + eB.x, niB = qrB * siB + qiB * srB + eB.y;
                srA = nrA; siA = niA; srB = nrB; siB = niB;
            }
        }
        const bf16* ud = ua + (size_t)(dir == 0 ? s_a : 127 - s_a) * PW; const long ustep = dir == 0 ? 16L * PW : -16L * PW;
        bf16x8 ufn = *(const bf16x8*)ud;
#pragma unroll 1
        for (int j = 0; j < 8; ++j) {
            const bf16x8 ufc = ufn;
            ufn = *(const bf16x8*)(ud + (j < 7 ? j + 1 : 7) * ustep);
            const f32x16 z16 = {0.f, 0.f, 0.f, 0.f, 0.f, 0.f, 0.f, 0.f, 0.f, 0.f, 0.f, 0.f, 0.f, 0.f, 0.f, 0.f};
            {
                const f32x16 re = __builtin_amdgcn_mfma_f32_32x32x16_bf16(ufc, bbt[0], z16, 0, 0, 0);
                const f32x16 im = __builtin_amdgcn_mfma_f32_32x32x16_bf16(ufc, bbt[1], z16, 0, 0, 0);
#pragma unroll
                for (int s = 0; s < 16; ++s) {
                    const float nr = arA * srA + (re[s] - aiA * siA), ni = arA * siA + (im[s] + aiA * srA);
                    srA = nr; siA = ni;
                    if (PASS == 2) *(LAS unsigned*)(sl + (16 * hb + (dir == 0 ? s : 15 - s)) * S5_LDS_ROW + c32 * 4) = cvtpk(srA, siA);
                }
            }
            {
                const f32x16 re = __builtin_amdgcn_mfma_f32_32x32x16_bf16(ufc, bbt[2], z16, 0, 0, 0);
                const f32x16 im = __builtin_amdgcn_mfma_f32_32x32x16_bf16(ufc, bbt[3], z16, 0, 0, 0);
#pragma unroll
                for (int s = 0; s < 16; ++s) {
                    const float nr = arB * srB + (re[s] - aiB * siB), ni = arB * siB + (im[s] + aiB * srB);
                    srB = nr; siB = ni;
                    if (PASS == 2) *(LAS unsigned*)(sl + (16 * hb + (dir == 0 ? s : 15 - s)) * S5_LDS_ROW + (32 + c32) * 4) = cvtpk(srB, siB);
                }
            }
            if (PASS == 2) {
                const int blk = dir == 0 ? j : 7 - j;
#pragma unroll
                for (int b2 = 0; b2 < 2; ++b2) {
                    f32x4 y = (f32x4){0.f, 0.f, 0.f, 0.f};
#pragma unroll
                    for (int ks = 0; ks < 4; ++ks) {
                        const bf16x8 af = *(const LAS bf16x8*)(sl + (16 * b2 + (lane & 15)) * S5_LDS_ROW + ks * 64 + (lane >> 4) * 16);
                        y = __builtin_amdgcn_mfma_f32_16x16x32_bf16(af, ct[ks], y, 0, 0, 0);
                    }
                    if (dir == 0) {
#pragma unroll
                        for (int rg = 0; rg < 4; ++rg) yl[(b2 * 128 + 16 * blk + 4 * tq + rg) * 16 + hp] = (bf16)f2bf(y[rg]);
                    } else {
                        const size_t row0 = (size_t)(chunk_row0(b2 * 66 + c) + 16 * blk + 4 * tq);
#pragma unroll
                        for (int rg = 0; rg < 4; ++rg) { const size_t row = row0 + rg;
                            const float u = bf2f(P[row * PW + g * 16 + hp]);
                            const float v = y[rg] + bf2f(yl[(b2 * 128 + 16 * blk + 4 * tq + rg) * 16 + hp]) + dsk * u;
                            YA1[row * 512 + g * 16 + hp] = (bf16)f2bf(gelu_tanh_f(v)); }
                    }
                }
            }
        }
        if (PASS == 1) {
            *(f32x2_t*)(Eb + (size_t)kk * 128 + c32 * 2) = (f32x2_t){srA, siA};
            *(f32x2_t*)(Eb + (size_t)kk * 128 + (32 + c32) * 2) = (f32x2_t){srB, siB};
        }
    }
}
template <int PASS>
__device__ __forceinline__ void phase_s5(KArgs& a, LAS unsigned char* lds, int lane, int wave, int bid, int G) {
    LAS unsigned char* sl = lds + wave * S5_LDS_WAVE;
    const int gw = bid * NWAVES + wave, NGW = G * NWAVES;
    for (int task = gw; task < 66 * 32; task += NGW) s5_task<PASS>(a, sl, lane, task >> 5, task & 31);
}

__device__ __forceinline__ void gmlp_simple_task(KArgs& a, LAS unsigned char* lds, int tid, int lane, int wave, int task) {
    asm volatile("" : "+v"(lane)); asm volatile("" : "+v"(tid));
    const int cidx = task >> 3, h = task & 7, rb = chunk_row0(cidx);
    const bf16* P = (const bf16*)(a.ws + WS_P); bf16* MIX = (bf16*)(a.ws + WS_MIX);
    LAS float* stat = (LAS float*)lds;
    for (int i = 0; i < 16; ++i) { const int row = wave * 16 + i;
        const u32x4 w = *(const u32x4*)(P + (size_t)(rb + row) * PW + 1536 + lane * 8);
        float x[8];
#pragma unroll
        for (int j = 0; j < 4; ++j) { x[2 * j] = bflo(w[j]); x[2 * j + 1] = bfhi(w[j]); }
        float s = 0.f;
#pragma unroll
        for (int j = 0; j < 8; ++j) s += x[j];
        const float mean = wave_sum(s) * (1.f / 512.f); float q = 0.f;
#pragma unroll
        for (int j = 0; j < 8; ++j) { const float d = x[j] - mean; q += d * d; }
        const float rstd = 1.f / sqrtf(wave_sum(q) * (1.f / 512.f) + LN_EPS);
        if (lane == 0) { stat[row * 2] = mean; stat[row * 2 + 1] = rstd; } }
    __syncthreads();
    const int d = tid & 63, qq = tid >> 6, c = h * 64 + d;
    const float lg = a.in[20][c], lb = a.in[21][c];
    const float* ws_ = a.in[22] + (size_t)h * 128 * 128;
    float acc[16];
#pragma unroll
    for (int i = 0; i < 16; ++i) acc[i] = 0.f;
    for (int k = 0; k < 128; ++k) {
        const float vn = (bf2f(P[(size_t)(rb + k) * PW + 1536 + c]) - stat[k * 2]) * stat[k * 2 + 1] * lg + lb;
#pragma unroll
        for (int i = 0; i < 16; ++i) acc[i] += ws_[(qq + 8 * i) * 128 + k] * vn;
    }
#pragma unroll
    for (int i = 0; i < 16; ++i) { const int q = qq + 8 * i; const size_t r = (size_t)(rb + q);
        const float s = acc[i] + a.in[23][h * 128 + q];
        MIX[r * D + 512 + c] = (bf16)f2bf(bf2f(P[r * PW + 1024 + c]) * s * silu_f(bf2f(P[r * PW + 2048 + c]))); }
    __syncthreads();
}

__device__ __forceinline__ void phase_ln0(KArgs& a, int lane, int wave, int bid, int G) {
    asm volatile("" : "+v"(lane));
    const float* modv = (const float*)(a.ws + WS_MODV);
    const bf16* Y0 = (const bf16*)(a.ws + WS_P); bf16* H = (bf16*)(a.ws + WS_H); float* Z1C = (float*)(a.ws + WS_Z1C);
    const int gw = bid * NWAVES + wave, NGW = G * NWAVES;
    for (int r = gw; r < M; r += NGW) {
        const float* z = (r < MLAT) ? a.in[0] + (size_t)r * D : a.in[2] + (size_t)(r - MLAT) * D;
        float* zo = (r < MLAT) ? a.out + (size_t)r * D : Z1C + (size_t)(r - MLAT) * D;
        const int vec = row_vec(r);
        const float* g0 = modv + vec * 3072 + 2 * D; const float* mv1 = modv + (3 + vec) * 3072;
        f32x4 v[4]; float s = 0.f;
#pragma unroll
        for (int j = 0; j < 4; ++j) { const int c = lane * 4 + 256 * j;
            const f32x4 zz = *(const f32x4*)(z + c), gg = *(const f32x4*)(g0 + c); const u32x2 yw = *(const u32x2*)(Y0 + (size_t)r * D + c);
            f32x4 y; y[0] = bflo(yw.x); y[1] = bfhi(yw.x); y[2] = bflo(yw.y); y[3] = bfhi(yw.y);
            v[j] = zz * ALPHA + y * gg; s += (v[j][0] + v[j][1]) + (v[j][2] + v[j][3]); }
        const float mean = wave_sum(s) * (1.f / D); float q = 0.f;
#pragma unroll
        for (int j = 0; j < 4; ++j) { v[j] = v[j] - mean; q += (v[j][0] * v[j][0] + v[j][1] * v[j][1]) + (v[j][2] * v[j][2] + v[j][3] * v[j][3]); }
        const float rstd = 1.f / sqrtf(wave_sum(q) * (1.f / D) + LN_EPS);
#pragma unroll
        for (int j = 0; j < 4; ++j) { const int c = lane * 4 + 256 * j;
            const f32x4 z1 = v[j] * rstd * *(const f32x4*)(a.in[6] + c) + *(const f32x4*)(a.in[7] + c);
            *(f32x4*)(zo + c) = z1;
            const f32x4 h = z1 * (*(const f32x4*)(mv1 + D + c) + 1.f) + *(const f32x4*)(mv1 + c);
            u32x2 o; o.x = pk2(h[0], h[1]); o.y = pk2(h[2], h[3]);
            *(u32x2*)(H + (size_t)r * D + c) = o; }
    }
}
__device__ __forceinline__ void phase_ln1(KArgs& a, int lane, int wave, int bid, int G) {
    asm volatile("" : "+v"(lane));
    const float* modv = (const float*)(a.ws + WS_MODV);
    const bf16* Y1 = (const bf16*)(a.ws + WS_H);
    const int gw = bid * NWAVES + wave, NGW = G * NWAVES;
    for (int r = gw; r < MLAT; r += NGW) {
        float* zo = a.out + (size_t)r * D;
        const float* g1 = modv + (3 + (r >> 13)) * 3072 + 2 * D;
        f32x4 v[4]; float s = 0.f;
#pragma unroll
        for (int j = 0; j < 4; ++j) { const int c = lane * 4 + 256 * j;
            const f32x4 zz = *(const f32x4*)(zo + c), gg = *(const f32x4*)(g1 + c); const u32x2 yw = *(const u32x2*)(Y1 + (size_t)r * D + c);
            f32x4 y; y[0] = bflo(yw.x); y[1] = bfhi(yw.x); y[2] = bflo(yw.y); y[3] = bfhi(yw.y);
            v[j] = zz * ALPHA + y * gg; s += (v[j][0] + v[j][1]) + (v[j][2] + v[j][3]); }
        const float mean = wave_sum(s) * (1.f / D); float q = 0.f;
#pragma unroll
        for (int j = 0; j < 4; ++j) { v[j] = v[j] - mean; q += (v[j][0] * v[j][0] + v[j][1] * v[j][1]) + (v[j][2] * v[j][2] + v[j][3] * v[j][3]); }
        const float rstd = 1.f / sqrtf(wave_sum(q) * (1.f / D) + LN_EPS);
#pragma unroll
        for (int j = 0; j < 4; ++j) { const int c = lane * 4 + 256 * j;
            *(f32x4*)(zo + c) = v[j] * rstd * *(const f32x4*)(a.in[6] + D + c) + *(const f32x4*)(a.in[7] + D + c); }
    }
}

__device__ __forceinline__ void phase_attn_simple(KArgs& a, int lane, int wave, int bid, int G, bf16* MIX) {
    asm volatile("" : "+v"(lane));
    const bf16* P = (const bf16*)(a.ws + WS_P);
    const int sub = lane & 3, hq = lane >> 2, kvh = hq >> 2;
    const float sk2 = a.in[26][hq] * LOG2E;
    const int gw = bid * NWAVES + wave, NGW = G * NWAVES;
    for (int r = gw; r < MLAT; r += NGW) {
        const int b = r >> 13, t = r & 8191;
        float q[16];
        { const bf16* qp = P + (size_t)r * PW + hq * 64 + sub * 16; const u32x4 w0 = *(const u32x4*)qp, w1 = *(const u32x4*)(qp + 8);
#pragma unroll
          for (int j = 0; j < 4; ++j) { q[2 * j] = bflo(w0[j]); q[2 * j + 1] = bfhi(w0[j]); q[8 + 2 * j] = bflo(w1[j]); q[8 + 2 * j + 1] = bfhi(w1[j]); } }
        const int lo = t - 128 < 0 ? 0 : t - 128, hi = t + 128 > SEQ - 1 ? SEQ - 1 : t + 128;
        const int nk = CTXN + (hi - lo + 1);
        const bf16* kc = P + (size_t)(MLAT + b * CTXN) * PW + 1024 + kvh * 64 + sub * 16;
        const bf16* kl = P + (size_t)(b * SEQ + lo) * PW + 1024 + kvh * 64 + sub * 16;
        float mx = sk2;
        for (int i = 0; i < nk; ++i) { const bf16* kp = (i < CTXN) ? kc + (size_t)i * PW : kl + (size_t)(i - CTXN) * PW;
            const u32x4 w0 = *(const u32x4*)kp, w1 = *(const u32x4*)(kp + 8); float s = 0.f;
#pragma unroll
            for (int j = 0; j < 4; ++j) { s += q[2 * j] * bflo(w0[j]) + q[2 * j + 1] * bfhi(w0[j]); s += q[8 + 2 * j] * bflo(w1[j]) + q[8 + 2 * j + 1] * bfhi(w1[j]); }
            s += __shfl_xor(s, 1); s += __shfl_xor(s, 2);
            mx = fmaxf(mx, s); }
        float l = exp2f(sk2 - mx);
        float o[16];
#pragma unroll
        for (int j = 0; j < 16; ++j) o[j] = 0.f;
        for (int i = 0; i < nk; ++i) { const bf16* kp = (i < CTXN) ? kc + (size_t)i * PW : kl + (size_t)(i - CTXN) * PW;
            const u32x4 w0 = *(const u32x4*)kp, w1 = *(const u32x4*)(kp + 8); float s = 0.f;
#pragma unroll
            for (int j = 0; j < 4; ++j) { s += q[2 * j] * bflo(w0[j]) + q[2 * j + 1] * bfhi(w0[j]); s += q[8 + 2 * j] * bflo(w1[j]) + q[8 + 2 * j + 1] * bfhi(w1[j]); }
            s += __shfl_xor(s, 1); s += __shfl_xor(s, 2);
            const float pr = exp2f(s - mx); l += pr;
            const u32x4 v0 = *(const u32x4*)(kp + 256), v1 = *(const u32x4*)(kp + 264);
#pragma unroll
            for (int j = 0; j < 4; ++j) { o[2 * j] += pr * bflo(v0[j]); o[2 * j + 1] += pr * bfhi(v0[j]); o[8 + 2 * j] += pr * bflo(v1[j]); o[8 + 2 * j + 1] += pr * bfhi(v1[j]); } }
        const float rl = 1.f / l;
        const bf16* gp = P + (size_t)r * PW + 1536 + hq * 64 + sub * 16;
        const u32x4 g0 = *(const u32x4*)gp, g1 = *(const u32x4*)(gp + 8);
        u32x4 w0, w1;
#pragma unroll
        for (int j = 0; j < 4; ++j) { w0[j] = pk2(o[2 * j] * rl * silu_f(bflo(g0[j])), o[2 * j + 1] * rl * silu_f(bfhi(g0[j])));
                                      w1[j] = pk2(o[8 + 2 * j] * rl * silu_f(bflo(g1[j])), o[8 + 2 * j + 1] * rl * silu_f(bfhi(g1[j]))); }
        bf16* op = MIX + (size_t)r * D + hq * 64 + sub * 16;
        *(u32x4*)op = w0; *(u32x4*)(op + 8) = w1;
    }
}

__global__ void __launch_bounds__(NTHREADS, 2) mega_fwd(Args a_unused) {
    extern __shared__ __attribute__((aligned(16))) unsigned char lds_raw[];
    LAS unsigned char* lds = (LAS unsigned char*)lds_raw;
    cg::grid_group grid = cg::this_grid();
    const int tid = threadIdx.x, lane = tid & 63, wave = __builtin_amdgcn_readfirstlane(tid >> 6), bid = blockIdx.x, G = gridDim.x;
#define GRID_SYNC() grid.sync()
    KArgs* kap = (KArgs*)__builtin_amdgcn_kernarg_segment_ptr();
#define FRESH_ARGS() asm volatile("" : "+s"(kap)); KArgs& a = *kap; unsigned char* ws = a.ws; \
    bf16* H = (bf16*)(ws + WS_H); bf16* P = (bf16*)(ws + WS_P); bf16* MIX = (bf16*)(ws + WS_MIX); bf16* YA1 = (bf16*)(ws + WS_YA1); (void)H; (void)P; (void)MIX; (void)YA1;

    { FRESH_ARGS(); phase_prologue(a, lds, tid, lane, wave, bid, G); }
    GRID_SYNC();
    { FRESH_ARGS(); phase_modulate0(a, lane, wave, bid, G); }
    GRID_SYNC();
    {
        FRESH_ARGS();
        pg8::Gemm g{H, (const bf16*)(ws + WS_WIN0), M, PW, D}; pg8::StaticOrder S; S.init(M, PW, G, bid);
        pg8::EpiBf16<0> E{P, PW, nullptr, 0, 0, 1.f};
        pg8::gemm_phase<pg8::EpiBf16<0>, pg8::StaticOrder, true, true>(lds, g, S, E);
    }
    GRID_SYNC();
    { FRESH_ARGS(); phase_s5<1>(a, lds, lane, wave, bid, G); }
    GRID_SYNC();
    { FRESH_ARGS(); phase_s5<2>(a, lds, lane, wave, bid, G); }
    GRID_SYNC();
#if S5_CHECK
    {
        FRESH_ARGS();
        float* chk = (float*)(ws + 512 * 1024);
        if (bid == 0 && tid == 0) { chk[0] = 0.f; chk[1] = 0.f; }
        bf16* YAN = (bf16*)(ws + 226 * MiB);
        phase_s5_naive(a, lds, lane, wave, bid, G, YAN);
        GRID_SYNC();
        float sd = 0.f, sn = 0.f;
        for (size_t i = (size_t)bid * NTHREADS + tid; i < (size_t)M * 512; i += (size_t)G * NTHREADS) { const float f = bf2f(YA1[i]), n = bf2f(YAN[i]); sd += (f - n) * (f - n); sn += n * n; }
        sd = wave_sum(sd); sn = wave_sum(sn);
        if (lane == 0) { atomicAdd(chk, sd); atomicAdd(chk + 1, sn); }
        GRID_SYNC();
    }
#endif
    {
        FRESH_ARGS();
        pg8::Gemm g{YA1, (const bf16*)(ws + WS_WGLU), M, 512, 512}; pg8::StaticOrder S; S.init(M, 512, G, bid);
        pg8::EpiGlu E{YA1, P, a.in[19], MIX};
        pg8::gemm_phase<pg8::EpiGlu, pg8::StaticOrder, true, true>(lds, g, S, E);
        const int nfree = G - 132;
        if (bid >= 132) for (int task = bid - 132; task < 132 * 8; task += nfree) gmlp_simple_task(a, lds, tid, lane, wave, task);
    }
    GRID_SYNC();
    {
        FRESH_ARGS();
        pg8::Gemm g{MIX, (const bf16*)(ws + WS_WOUT0), M, D, D}; pg8::StaticOrder S; S.init(M, D, G, bid);
        pg8::EpiBf16<0> E{P, D, nullptr, 0, 0, 1.f};
        pg8::gemm_phase<pg8::EpiBf16<0>, pg8::StaticOrder, true, true>(lds, g, S, E);
    }
    GRID_SYNC();
    { FRESH_ARGS(); phase_ln0(a, lane, wave, bid, G); }
    GRID_SYNC();
    {
        FRESH_ARGS();
        pg8::Gemm g{H, (const bf16*)(ws + WS_WIN1), M, PW, D}; pg8::StaticOrder S; S.init(M, PW, G, bid);
        pg8::EpiRope E{P, (const float*)(ws + WS_ROPE), QSCALE};
        pg8::gemm_phase<pg8::EpiRope, pg8::StaticOrder, true, true>(lds, g, S, E);
    }
    GRID_SYNC();
    {
        FRESH_ARGS();
#if ATTN_SIMPLE
        phase_attn_simple(a, lane, wave, bid, G, MIX);
#else
        attn_body::attn_phase<8>((char*)lds_raw, (const attn_body::bf16*)P, (attn_body::bf16*)MIX, a.in[26], G, bid);
#endif
    }
    GRID_SYNC();
#if ATTN_CHECK
    {
        FRESH_ARGS();
        float* chk = (float*)(ws + 512 * 1024);
#if !S5_CHECK
        if (bid == 0 && tid == 0) { chk[0] = 0.f; chk[1] = 0.f; }
#endif
        if (bid == 0 && tid == 0) { chk[2] = 0.f; chk[3] = 0.f; }
        bf16* MIX2 = (bf16*)(ws + WS_YAF);
        phase_attn_simple(a, lane, wave, bid, G, MIX2);
        GRID_SYNC();
        float sd = 0.f, sn = 0.f;
        for (size_t i = (size_t)bid * NTHREADS + tid; i < (size_t)MLAT * D; i += (size_t)G * NTHREADS) { const float f = bf2f(MIX[i]), n = bf2f(MIX2[i]); sd += (f - n) * (f - n); sn += n * n; }
        sd = wave_sum(sd); sn = wave_sum(sn);
        if (lane == 0) { atomicAdd(chk + 2, sd); atomicAdd(chk + 3, sn); }
        GRID_SYNC();
    }
#endif
    {
        FRESH_ARGS();
        pg8::Gemm g{MIX, (const bf16*)(ws + WS_WOUT1), MLAT, D, D}; pg8::StaticOrder S; S.init(MLAT, D, G, bid);
        pg8::EpiBf16<0> E{H, D, nullptr, 0, 0, 1.f};
        pg8::gemm_phase<pg8::EpiBf16<0>, pg8::StaticOrder, true, true>(lds, g, S, E);
    }
    GRID_SYNC();
    { FRESH_ARGS(); phase_ln1(a, lane, wave, bid, G); }
#if S5_CHECK || ATTN_CHECK
    GRID_SYNC();
    { FRESH_ARGS(); const float* chk = (const float*)(ws + 512 * 1024); float d = 0.f;
      if (S5_CHECK) d += sqrtf(chk[0] / chk[1]);
      if (ATTN_CHECK) d += sqrtf(chk[2] / chk[3]);
      const float sc = 1.f + fminf(3.f * d, 0.5f);
      for (size_t i = (size_t)bid * NTHREADS + tid; i < (size_t)MLAT * D; i += (size_t)G * NTHREADS) a.out[i] *= sc; }
#endif
}

extern "C" void kernel_launch(void* const* d_in, const int* in_sizes, int n_in, void* d_out, int out_size, void* d_ws, size_t ws_size, hipStream_t stream) {
    static int grid = 0;
    if (grid == 0) {
        int dev = 0, cus = 0, per_cu = 0;
        hipGetDevice(&dev);
        hipDeviceGetAttribute(&cus, hipDeviceAttributeMultiprocessorCount, dev);
        hipFuncSetAttribute((const void*)mega_fwd, hipFuncAttributeMaxDynamicSharedMemorySize, LDS_BYTES);
        hipOccupancyMaxActiveBlocksPerMultiprocessor(&per_cu, (const void*)mega_fwd, NTHREADS, LDS_BYTES);
        if (per_cu < 1) { fprintf(stderr, "kernel_launch: occupancy query says %d blocks per CU\n", per_cu); per_cu = 1; }
        grid = cus;
        (void)hipGetLastError();
    }
    Args a{};
    for (int i = 0; i < 27; ++i) a.in[i] = (const float*)d_in[i];
    a.out = (float*)d_out; a.ws = (unsigned char*)d_ws;
    void* args[] = {&a};
    hipError_t e = hipLaunchCooperativeKernel((const void*)mega_fwd, dim3(grid), dim3(NTHREADS), args, LDS_BYTES, stream);
    if (e != hipSuccess) fprintf(stderr, "cooperative launch failed: %s (grid %d)\n", hipGetErrorString(e), grid);
}
```

```cpp
#include <hip/hip_runtime.h>
#include <hip/hip_cooperative_groups.h>
#include <cstdio>
#include <cstdint>
namespace cg = cooperative_groups;
namespace pg8 {
#define PG8_LAS __attribute__((address_space(3)))
typedef unsigned short bf16_t;
typedef short bf16x8 __attribute__((ext_vector_type(8)));
typedef float f32x4 __attribute__((ext_vector_type(4)));
typedef unsigned u32x4 __attribute__((ext_vector_type(4)));
constexpr int BM = 256, BK = 64, HALF = 128, HTB = HALF * BK * 2  , STAGE_BYTES = 8 * HTB, NXCD = 8, WGM = 8;

__host__ __device__ __forceinline__ int lds_byte(int r, int c) { const int st = (r >> 4) * 2 + (c >> 5), rr = r & 15, cc = c & 31, ob = rr * 64 + cc * 2; return st * 1024 + (ob ^ (((ob >> 9) & 1) << 5)); }
__host__ __device__ __forceinline__ void stage_rc(int b, int& R, int& C) { const int st = b / 1024, sb = b % 1024, swz = sb ^ (((sb >> 9) & 1) << 5); R = (st >> 1) * 16 + swz / 64; C = (st & 1) * 32 + (swz % 64) / 2; }
__host__ __device__ __forceinline__ int perm32(int rho) { const int n = rho >> 4, i = rho & 15; return 8 * (i >> 2) + 4 * n + (i & 3); }

struct Unit { int pm, pn; };
struct Gemm { const bf16_t* A; const bf16_t* Bt; int M, N, K; };

struct StaticOrder {
    int nM, nN, nwg, G, c;
    __host__ __device__ void init(int M, int N, int G_, int c_) { nM = M / BM; nN = N / BM; nwg = nM * nN; G = G_; c = c_; }
    __host__ __device__ bool next(int i, Unit& u) const {
        const long L = (long)i * G + c; if (L >= nwg) return false;
        int wgid = (int)L; { const int q = nwg / NXCD, r = nwg % NXCD, xcd = wgid % NXCD, off = wgid / NXCD; wgid = (xcd < r ? xcd * (q + 1) : r * (q + 1) + (xcd - r) * q) + off; }
        const int nig = WGM * nN, gid = wgid / nig, fm = gid * WGM, gsz = (nM - fm) < WGM ? (nM - fm) : WGM;
        u.pm = fm + ((wgid % nig) % gsz); u.pn = (wgid % nig) / gsz; return true;
    }
    __device__ __forceinline__ void a_ready(const Unit&) const {}
    __device__ __forceinline__ void done(const Unit&) const {}
};

__device__ __forceinline__ unsigned cvt_pk_bf16(float lo, float hi) { unsigned r; asm volatile("v_cvt_pk_bf16_f32 %0, %1, %2" : "=v"(r) : "v"(lo), "v"(hi)); return r; }
typedef float f32x2 __attribute__((ext_vector_type(2)));
__device__ __forceinline__ f32x2 gelu_pk(f32x2 v) {
    const f32x2 av = __builtin_elementwise_abs(v), d = av * 0.2316418882f + 1.0f;
    f32x2 t; t.x = __builtin_amdgcn_rcpf(d.x); t.y = __builtin_amdgcn_rcpf(d.y);
    f32x2 q = t * 0.5307027145f + (-0.7265760135f); q = q * t + 0.7107068705f; q = q * t + (-0.142248368f); q = q * t + 0.127414796f; q = q * t;
    const f32x2 s = (v * v) * (-0.72134752044f);
    f32x2 e; e.x = __builtin_amdgcn_exp2f(s.x); e.y = __builtin_amdgcn_exp2f(s.y);
    const f32x2 m = v * (q * e), r = v - m;
    f32x2 o; o.x = v.x < 0.f ? m.x : r.x; o.y = v.y < 0.f ? m.y : r.y; return o;
}

template <int ACT  > struct EpiBf16 {
    static constexpr bool PERM = true, AFTER_DRAIN = false; static_assert(ACT == 0 || ACT == 1, "EpiBf16: ACT is 0 (none) or 1 (gelu_pk)");
    bf16_t* O; int ldc; const float* bias; int split_cols; size_t split_stride; float scale0;
    __device__ __forceinline__ void operator()(const f32x4 (&acc)[2][2][4][2], const Unit& u, int wr, int wc, int fr, int fq) const {
        const int row0 = u.pm * BM + wr * 64 + fr; int colt = u.pn * BM; bf16_t* base = O;
        float sc = 1.f; if (split_cols) { const int t = colt / split_cols; base += (size_t)t * split_stride; colt -= t * split_cols; if (t == 0) sc = scale0; }
        const int col0 = colt + wc * 32 + 8 * fq, bcol0 = u.pn * BM + wc * 32 + 8 * fq;
        f32x4 bv[2][2];
#pragma unroll
        for (int bj = 0; bj < 2; ++bj)
#pragma unroll
            for (int n = 0; n < 2; ++n) bv[bj][n] = bias ? *(const f32x4*)(bias + bcol0 + bj * HALF + 4 * n) : (f32x4){0.f, 0.f, 0.f, 0.f};
#pragma unroll
        for (int ai = 0; ai < 2; ++ai)
#pragma unroll
            for (int m = 0; m < 4; ++m) { bf16_t* rowp = base + (size_t)(row0 + ai * HALF + m * 16) * ldc + col0;
#pragma unroll
                for (int bj = 0; bj < 2; ++bj) { f32x4 v0 = acc[ai][bj][m][0] + bv[bj][0], v1 = acc[ai][bj][m][1] + bv[bj][1];
                    if (ACT == 1) { f32x2 a = gelu_pk((f32x2){v0[0], v0[1]}), b = gelu_pk((f32x2){v0[2], v0[3]}), c = gelu_pk((f32x2){v1[0], v1[1]}), d = gelu_pk((f32x2){v1[2], v1[3]});
                        v0 = (f32x4){a.x, a.y, b.x, b.y}; v1 = (f32x4){c.x, c.y, d.x, d.y}; }
                    v0 = v0 * sc; v1 = v1 * sc; u32x4 w; w.x = cvt_pk_bf16(v0[0], v0[1]); w.y = cvt_pk_bf16(v0[2], v0[3]); w.z = cvt_pk_bf16(v1[0], v1[1]); w.w = cvt_pk_bf16(v1[2], v1[3]);
                    *(u32x4*)(rowp + bj * HALF) = w; } }
    }
};
}
namespace pg8 {
__device__ __forceinline__ float bf2f_(unsigned short h) { return __builtin_bit_cast(float, (unsigned)h << 16); }
__device__ __forceinline__ float sigm_(float v) { return 1.f / (1.f + __expf(-v)); }
struct EpiGlu {
    static constexpr bool PERM = true, AFTER_DRAIN = false;
    const bf16_t* ya1; const bf16_t* P; const float* glu_b; bf16_t* mix;
    __device__ __forceinline__ void operator()(const f32x4 (&acc)[2][2][4][2], const Unit& u, int wr, int wc, int fr, int fq) const {
        const int row0 = u.pm * BM + wr * 64 + fr, col0 = u.pn * BM + wc * 32 + 8 * fq;
#pragma unroll
        for (int ai = 0; ai < 2; ++ai)
#pragma unroll
            for (int m = 0; m < 4; ++m) { const size_t row = (size_t)(row0 + ai * HALF + m * 16);
#pragma unroll
                for (int bj = 0; bj < 2; ++bj) { const int col = col0 + bj * HALF;
                    const f32x4 b0 = *(const f32x4*)(glu_b + col), b1 = *(const f32x4*)(glu_b + col + 4);
                    const u32x4 yw = *(const u32x4*)(ya1 + row * 512 + col), gw = *(const u32x4*)(P + row * 2560 + 512 + col);
                    float o[8];
#pragma unroll
                    for (int j = 0; j < 8; ++j) { const float a = (j < 4) ? acc[ai][bj][m][0][j] + b0[j] : acc[ai][bj][m][1][j - 4] + b1[j - 4];
                        const unsigned ywj = yw[j >> 1], gwj = gw[j >> 1];
                        const float y = bf2f_((unsigned short)((j & 1) ? (ywj >> 16) : (ywj & 0xffffu))), g = bf2f_((unsigned short)((j & 1) ? (gwj >> 16) : (gwj & 0xffffu)));
                        o[j] = y * sigm_(a) * (g * sigm_(g)); }
                    u32x4 w; w.x = cvt_pk_bf16(o[0], o[1]); w.y = cvt_pk_bf16(o[2], o[3]); w.z = cvt_pk_bf16(o[4], o[5]); w.w = cvt_pk_bf16(o[6], o[7]);
                    *(u32x4*)(mix + row * 1024 + col) = w; } }
    }
};
struct EpiRope {
    static constexpr bool PERM = true, AFTER_DRAIN = false;
    bf16_t* O; const float* cs; float qscale;
    __device__ __forceinline__ void operator()(const f32x4 (&acc)[2][2][4][2], const Unit& u, int wr, int wc, int fr, int fq) const {
        const int row0 = u.pm * BM + wr * 64 + fr, col0 = u.pn * BM + wc * 32 + 8 * fq;
        const bool rope = (u.pm < 64) && (u.pn <= 4);
        const float sc = (u.pn < 4) ? qscale : 1.f;
        const float sgn = (fq < 2) ? -1.f : 1.f;
#pragma unroll
        for (int ai = 0; ai < 2; ++ai)
#pragma unroll
            for (int m = 0; m < 4; ++m) { const int row = row0 + ai * HALF + m * 16; const int t = row & 8191; const int pos = (wc & 1) ? (t & 63) : (t >> 6);
                f32x4 c4[4];
                if (rope) {
#pragma unroll
                    for (int j = 0; j < 4; ++j) c4[j] = *(const f32x4*)(cs + (pos * 16 + 8 * (fq & 1)) * 2 + 4 * j); }
#pragma unroll
                for (int bj = 0; bj < 2; ++bj) { float o[8];
#pragma unroll
                    for (int j = 0; j < 8; ++j) { float v = (j < 4) ? acc[ai][bj][m][0][j] : acc[ai][bj][m][1][j - 4];
                        if (rope) { const float pv = __shfl_xor(v, 32); const float co = c4[j >> 1][(j & 1) * 2], si = c4[j >> 1][(j & 1) * 2 + 1]; v = v * co + sgn * pv * si; }
                        o[j] = v * sc; }
                    u32x4 w; w.x = cvt_pk_bf16(o[0], o[1]); w.y = cvt_pk_bf16(o[2], o[3]); w.z = cvt_pk_bf16(o[4], o[5]); w.w = cvt_pk_bf16(o[6], o[7]);
                    *(u32x4*)(O + (size_t)row * 2560 + col0 + bj * HALF) = w; } }
    }
};
}
namespace pg8 {
template <class Epi, class Sched, bool ALIGN_EPI = false, bool SP2 = false>
__device__ __forceinline__ void gemm_phase(PG8_LAS unsigned char* lds, const Gemm g, const Sched& S, const Epi& E) {
    int tid_ = threadIdx.x; asm volatile("" : "+v"(tid_));
    const int tid = tid_, wid = __builtin_amdgcn_readfirstlane(tid >> 6), lane = tid & 63, wr = wid >> 2, wc = wid & 3, fr = lane & 15, fq = lane >> 4;
    const int K = g.K, nt = K / BK;
    unsigned voffA[2], voffB[2];
#pragma unroll
    for (int i = 0; i < 2; ++i) { int R, C; stage_rc(tid * 16 + i * 8192, R, C); const int Rb = Epi::PERM ? ((R & ~31) + perm32(R & 31)) : R;
        voffA[i] = (unsigned)(R * K + C) * 2u; voffB[i] = (unsigned)(Rb * K + C) * 2u; }
    const size_t kstep = (size_t)(BK * 2);
    const size_t hstep = (size_t)HALF * K * 2;
    const size_t tstep = 2 * hstep;
    const unsigned ldsw = (unsigned)wid * 1024u;
    const int aoff = lds_byte(wr * 64 + fr, fq * 8), boff = lds_byte(wc * 32 + fr, fq * 8);
#define PG8_SA(b, h) (((b) * 2 + (h)) * HTB)
#define PG8_SB(b, h) ((4 + (b) * 2 + (h)) * HTB)
#define PG8_STAGE(bufoff, gbase, voff) do { _Pragma("unroll") for (int _i = 0; _i < 2; ++_i) \
        __builtin_amdgcn_global_load_lds((const unsigned*)((const char*)(gbase) + (voff)[_i]), (PG8_LAS unsigned*)(lds + (bufoff) + ldsw + _i * 8192), 16, 0, 0); } while (0)
#define PG8_LDA(dst, b, h) do { _Pragma("unroll") for (int m = 0; m < 4; ++m) _Pragma("unroll") for (int k = 0; k < 2; ++k) dst[m][k] = *(const PG8_LAS bf16x8*)(lds + PG8_SA(b, h) + aoff + m * 2048 + k * 1024); } while (0)
#define PG8_LDB(dst, b, h) do { _Pragma("unroll") for (int n = 0; n < 2; ++n) _Pragma("unroll") for (int k = 0; k < 2; ++k) dst[n][k] = *(const PG8_LAS bf16x8*)(lds + PG8_SB(b, h) + boff + n * 2048 + k * 1024); } while (0)
#define PG8_MMA(ai, bj, At, Bt) do { __builtin_amdgcn_s_setprio(1); _Pragma("unroll") for (int m = 0; m < 4; ++m) _Pragma("unroll") for (int n = 0; n < 2; ++n) _Pragma("unroll") for (int k = 0; k < 2; ++k) \
        acc[ai][bj][m][n] = __builtin_amdgcn_mfma_f32_16x16x32_bf16(Bt[n][k], At[m][k], acc[ai][bj][m][n], 0, 0, 0); __builtin_amdgcn_s_setprio(0); } while (0)
#define PG8_WAIT_V(n) asm volatile("s_waitcnt vmcnt(" #n ")" ::: "memory")
#define PG8_WAIT_L(n) asm volatile("s_waitcnt lgkmcnt(" #n ")" ::: "memory")
#define PG8_BAR __builtin_amdgcn_s_barrier()
#define PG8_SCHED __builtin_amdgcn_sched_barrier(0)
    Unit cur, nxt; int ui = 0;
    if (!S.next(0, cur)) return;
    f32x4 acc[2][2][4][2];
#pragma unroll
    for (int a = 0; a < 2; ++a)
#pragma unroll
        for (int b = 0; b < 2; ++b)
#pragma unroll
            for (int m = 0; m < 4; ++m)
#pragma unroll
                for (int n = 0; n < 2; ++n) acc[a][b][m][n] = (f32x4){0.f, 0.f, 0.f, 0.f};
    bf16x8 At[4][2], B0[2][2], B1[2][2];
    const char* cA = (const char*)g.A + (size_t)cur.pm * tstep; const char* cB = (const char*)g.Bt + (size_t)cur.pn * tstep;
    S.a_ready(cur);
    if constexpr (SP2) {
        PG8_STAGE(PG8_SB(0, 0), cB, voffB); PG8_STAGE(PG8_SB(0, 1), cB + hstep, voffB); PG8_STAGE(PG8_SA(0, 0), cA, voffA); PG8_STAGE(PG8_SA(0, 1), cA + hstep, voffA);
        if (wr == 1) PG8_BAR;
        PG8_WAIT_V(2); PG8_BAR;
        PG8_STAGE(PG8_SB(1, 0), cB + kstep, voffB); PG8_STAGE(PG8_SA(1, 0), cA + kstep, voffA); PG8_STAGE(PG8_SB(1, 1), cB + hstep + kstep, voffB);
        PG8_WAIT_V(6); PG8_BAR;
    } else {
        PG8_STAGE(PG8_SB(0, 0), cB, voffB); PG8_STAGE(PG8_SA(0, 0), cA, voffA); PG8_STAGE(PG8_SB(0, 1), cB + hstep, voffB); PG8_STAGE(PG8_SA(0, 1), cA + hstep, voffA);
        if (wr == 1) PG8_BAR;
        PG8_WAIT_V(4); PG8_BAR;
        PG8_STAGE(PG8_SB(1, 0), cB + kstep, voffB); PG8_STAGE(PG8_SA(1, 0), cA + kstep, voffA); PG8_STAGE(PG8_SB(1, 1), cB + hstep + kstep, voffB);
        PG8_WAIT_V(6); PG8_BAR;
    }
    for (;;) {
        const bool has_next = S.next(ui + 1, nxt);
        const char* nA = has_next ? (const char*)g.A + (size_t)nxt.pm * tstep : cA; const char* nB = has_next ? (const char*)g.Bt + (size_t)nxt.pn * tstep : cB;
        for (int t = 0; t < nt; t += 2) {
            const bool last = (t == nt - 2);
            const char* a1 = cA + (size_t)(t + 1) * kstep;
            const char* a2 = last ? nA : cA + (size_t)(t + 2) * kstep; const char* b2 = last ? nB : cB + (size_t)(t + 2) * kstep;
            const char* a3 = a2 + kstep; const char* b3 = b2 + kstep;
            if (last && has_next) S.a_ready(nxt);
            if constexpr (SP2) {
            PG8_LDB(B0, 0, 0); PG8_LDB(B1, 0, 1); PG8_SCHED; PG8_LDA(At, 0, 0); PG8_STAGE(PG8_SA(1, 1), a1 + hstep, voffA);
            PG8_WAIT_V(8); PG8_WAIT_L(0); PG8_BAR; PG8_MMA(0, 0, At, B0); PG8_MMA(0, 1, At, B1); PG8_BAR; PG8_SCHED;
            PG8_LDA(At, 0, 1); PG8_STAGE(PG8_SB(0, 0), b2, voffB); PG8_STAGE(PG8_SB(0, 1), b2 + hstep, voffB); PG8_STAGE(PG8_SA(0, 0), a2, voffA);
            PG8_WAIT_V(8); PG8_WAIT_L(0); PG8_BAR; PG8_MMA(1, 0, At, B0); PG8_MMA(1, 1, At, B1); PG8_BAR; PG8_SCHED;
            PG8_LDB(B0, 1, 0); PG8_LDB(B1, 1, 1); PG8_SCHED; PG8_LDA(At, 1, 0); PG8_STAGE(PG8_SA(0, 1), a2 + hstep, voffA);
            PG8_WAIT_V(8); PG8_WAIT_L(0); PG8_BAR; PG8_MMA(0, 0, At, B0); PG8_MMA(0, 1, At, B1); PG8_BAR; PG8_SCHED;
            PG8_LDA(At, 1, 1); PG8_STAGE(PG8_SB(1, 0), b3, voffB); PG8_STAGE(PG8_SB(1, 1), b3 + hstep, voffB); PG8_STAGE(PG8_SA(1, 0), a3, voffA);
            PG8_WAIT_V(8); PG8_WAIT_L(0); PG8_BAR; PG8_MMA(1, 0, At, B0); PG8_MMA(1, 1, At, B1); PG8_BAR; PG8_SCHED;
            } else {
            PG8_LDB(B0, 0, 0); PG8_SCHED; PG8_LDA(At, 0, 0); PG8_STAGE(PG8_SA(1, 1), a1 + hstep, voffA);
            PG8_WAIT_L(8); PG8_BAR; PG8_WAIT_L(0); PG8_MMA(0, 0, At, B0); PG8_BAR; PG8_SCHED;
            PG8_LDB(B1, 0, 1); PG8_STAGE(PG8_SB(0, 0), b2, voffB);
            PG8_BAR; PG8_WAIT_L(0); PG8_MMA(0, 1, At, B1); PG8_BAR;
            PG8_LDA(At, 0, 1); PG8_STAGE(PG8_SA(0, 0), a2, voffA);
            PG8_BAR; PG8_WAIT_L(0); PG8_MMA(1, 0, At, B0); PG8_BAR; PG8_SCHED;
            PG8_STAGE(PG8_SB(0, 1), b2 + hstep, voffB);
            PG8_WAIT_V(6); PG8_BAR; PG8_MMA(1, 1, At, B1); PG8_BAR;
            PG8_LDB(B0, 1, 0); PG8_SCHED; PG8_LDA(At, 1, 0); PG8_STAGE(PG8_SA(0, 1), a2 + hstep, voffA);
            PG8_WAIT_L(8); PG8_BAR; PG8_WAIT_L(0); PG8_MMA(0, 0, At, B0); PG8_BAR; PG8_SCHED;
            PG8_LDB(B1, 1, 1); PG8_STAGE(PG8_SB(1, 0), b3, voffB);
            PG8_BAR; PG8_WAIT_L(0); PG8_MMA(0, 1, At, B1); PG8_BAR;
            PG8_LDA(At, 1, 1); PG8_STAGE(PG8_SA(1, 0), a3, voffA);
            PG8_BAR; PG8_WAIT_L(0); PG8_MMA(1, 0, At, B0); PG8_BAR; PG8_SCHED;
            PG8_STAGE(PG8_SB(1, 1), b3 + hstep, voffB);
            PG8_WAIT_V(6); PG8_BAR; PG8_MMA(1, 1, At, B1); PG8_BAR;
            }
        }
        if constexpr (ALIGN_EPI) { if (wr == 0) PG8_BAR; }
        if constexpr (!Epi::AFTER_DRAIN) { E(acc, cur, wr, wc, fr, fq); S.done(cur); }
        if (!has_next) break;
#pragma unroll
        for (int a = 0; a < 2; ++a)
#pragma unroll
            for (int b = 0; b < 2; ++b)
#pragma unroll
                for (int m = 0; m < 4; ++m)
#pragma unroll
                    for (int n = 0; n < 2; ++n) acc[a][b][m][n] = (f32x4){0.f, 0.f, 0.f, 0.f};
        cur = nxt; cA = nA; cB = nB; ++ui;
        if constexpr (ALIGN_EPI) { if (wr == 1) PG8_BAR; }
    }
    PG8_WAIT_V(0);
    if constexpr (!ALIGN_EPI) { if (wr == 0) PG8_BAR; }
    PG8_BAR;
    if constexpr (Epi::AFTER_DRAIN) { E.fused(acc, cur, wr, wc, fr, fq, lds, wid, lane); S.done(cur); }
#undef PG8_SA
#undef PG8_SB
#undef PG8_STAGE
#undef PG8_LDA
#undef PG8_LDB
#undef PG8_MMA
#undef PG8_WAIT_V
#undef PG8_WAIT_L
#undef PG8_BAR
#undef PG8_SCHED
}
}
#include <hip/hip_bf16.h>
#include <cmath>
namespace attn_body {
using bf16=__hip_bfloat16;
using bf16x8=__attribute__((ext_vector_type(8)))short;
using s16x4=__attribute__((ext_vector_type(4)))short;
using f32x16=__attribute__((ext_vector_type(16)))float;
using u32x4=__attribute__((ext_vector_type(4)))unsigned;
constexpr int D=64,PITCH=2560,OPITCH=1024;
constexpr int NW=8,QBLK=32,KVBLK=64;
__device__ __forceinline__ int crow(int r,int hi){return (r&3)+8*(r>>2)+4*hi;}
#define SBAR() __builtin_amdgcn_sched_barrier(0)
__device__ __forceinline__ void wmask(f32x16&p0,f32x16&p1,int type,int qq,int hi){
  const float NEG=-INFINITY; const int kb=4*hi;
  if(type==1){
    #pragma unroll
    for(int r=0;r<16;++r){int kk=kb+(r&3)+8*(r>>2); if(kk<qq)p0[r]=NEG; if(kk+32<qq)p1[r]=NEG;}
  } else {
    #pragma unroll
    for(int r=0;r<16;++r){int kk=kb+(r&3)+8*(r>>2); if(kk>qq)p0[r]=NEG; if(kk+32>qq)p1[r]=NEG;}
  }
}

constexpr int NSLOT=3, SLOTB=8192;
constexpr int LDS_K=0, LDS_V=NSLOT*SLOTB, LDS_WS=2*NSLOT*SLOTB, LDS_OST=LDS_WS+NW*64*4, LDS_BYTES=LDS_OST+NW*4096;
constexpr float C2=0.125f*1.4426950408889634f;
__device__ __forceinline__ void glds16(const void*gsrc,unsigned lds_dst){unsigned keep;
  asm volatile("s_mov_b32 %0, m0\n\ts_mov_b32 m0, %2\n\ts_nop 0\n\tglobal_load_lds_dwordx4 %1, off\n\ts_mov_b32 m0, %0":"=&s"(keep):"v"(gsrc),"s"(lds_dst):"memory");}
__device__ __forceinline__ float max3f(float a,float b,float c){float r;asm("v_max3_f32 %0, %1, %2, %3":"=v"(r):"v"(a),"v"(b),"v"(c));return r;}
__device__ __forceinline__ float max2f(float a,float b){float r;asm("v_max_f32_e32 %0, %1, %2":"=v"(r):"v"(a),"v"(b));return r;}
__device__ __forceinline__ float fadd_s(float a,float b){float r;asm("v_add_f32_e32 %0, %1, %2":"=v"(r):"v"(a),"v"(b));return r;}
__device__ __forceinline__ float fsub_s(float a,float b){float r;asm("v_sub_f32_e32 %0, %1, %2":"=v"(r):"v"(a),"v"(b));return r;}
typedef float f32x2_t __attribute__((ext_vector_type(2))); typedef __bf16 bf16x2_t __attribute__((ext_vector_type(2)));
__device__ __forceinline__ unsigned cvtpk_s(float lo,float hi){f32x2_t v={lo,hi};bf16x2_t b=__builtin_convertvector(v,bf16x2_t);return __builtin_bit_cast(unsigned,b);}
#define WAIT_BAR(N) asm volatile("s_waitcnt vmcnt(" #N ") lgkmcnt(0)\n\ts_barrier":::"memory")

__device__ __forceinline__ void qkt(f32x16&p0,f32x16&p1,const char*Kslot,const bf16x8*qr,int r32,int hi){ const f32x16 negm=f32x16{};
  const char*kb=Kslot+hi*1024+r32*16;
  #pragma unroll
  for(int d0=0;d0<4;++d0){
    const bf16x8 b0=*reinterpret_cast<const bf16x8*>(kb+d0*2048);
    const bf16x8 b1=*reinterpret_cast<const bf16x8*>(kb+d0*2048+512);
    if(d0==0){p0=__builtin_amdgcn_mfma_f32_32x32x16_bf16(b0,qr[0],negm,0,0,0);p1=__builtin_amdgcn_mfma_f32_32x32x16_bf16(b1,qr[0],negm,0,0,0);}
    else{p0=__builtin_amdgcn_mfma_f32_32x32x16_bf16(b0,qr[d0],p0,0,0,0);p1=__builtin_amdgcn_mfma_f32_32x32x16_bf16(b1,qr[d0],p1,0,0,0);}}
}
typedef __attribute__((address_space(3))) const char* lds_cptr;
typedef short v4i16_t __attribute__((ext_vector_type(4)));
__device__ __forceinline__ void kload8(bf16x8*kf,lds_cptr kp){
  kf[0]=*(const __attribute__((address_space(3))) bf16x8*)(kp);      kf[1]=*(const __attribute__((address_space(3))) bf16x8*)(kp+512);
  kf[2]=*(const __attribute__((address_space(3))) bf16x8*)(kp+2048); kf[3]=*(const __attribute__((address_space(3))) bf16x8*)(kp+2560);
  kf[4]=*(const __attribute__((address_space(3))) bf16x8*)(kp+4096); kf[5]=*(const __attribute__((address_space(3))) bf16x8*)(kp+4608);
  kf[6]=*(const __attribute__((address_space(3))) bf16x8*)(kp+6144); kf[7]=*(const __attribute__((address_space(3))) bf16x8*)(kp+6656);
}
__device__ __forceinline__ void kload2(bf16x8*kf,lds_cptr kp,int j){ kf[2*j]=*(const __attribute__((address_space(3))) bf16x8*)(kp+j*2048); kf[2*j+1]=*(const __attribute__((address_space(3))) bf16x8*)(kp+j*2048+512); }
__device__ __forceinline__ s16x4 vtr(lds_cptr p){ return __builtin_bit_cast(s16x4,__builtin_amdgcn_ds_read_tr16_b64_v4i16((__attribute__((address_space(3))) v4i16_t*)p)); }
__device__ __forceinline__ float rowmax(const f32x16&p0,const f32x16&p1){
  float a=max3f(p0[0],p0[1],p1[0]),b=max3f(p0[2],p0[3],p1[1]);a=max3f(a,p1[2],p1[3]);
  #pragma unroll
  for(int r=4;r<16;r+=4){a=max3f(a,p0[r],p0[r+1]);b=max3f(b,p0[r+2],p0[r+3]);a=max3f(a,p1[r],p1[r+1]);b=max3f(b,p1[r+2],p1[r+3]);}
  const float m=max2f(a,b);
  auto rr=__builtin_amdgcn_permlane32_swap(__float_as_uint(m),__float_as_uint(m),false,false);
  return max2f(__uint_as_float(rr[0]),__uint_as_float(rr[1]));
}
__device__ __forceinline__ void pv(f32x16*o,int vb,bf16x8 pa0,bf16x8 pa1,bf16x8 pa2,bf16x8 pa3){
  #pragma unroll
  for(int d0=0;d0<2;++d0){s16x4 lo[4],hi[4];
    #pragma unroll
    for(int ks=0;ks<4;++ks){
      asm volatile("ds_read_b64_tr_b16 %0,%1 offset:%c2":"=&v"(lo[ks]):"v"(vb),"i"(d0*4096+ks*1024):"memory");
      asm volatile("ds_read_b64_tr_b16 %0,%1 offset:%c2":"=&v"(hi[ks]):"v"(vb),"i"(d0*4096+ks*1024+512):"memory");}
    asm volatile("s_waitcnt lgkmcnt(0)":::"memory");SBAR();
    #define PK(k) (bf16x8){lo[k][0],lo[k][1],lo[k][2],lo[k][3],hi[k][0],hi[k][1],hi[k][2],hi[k][3]}
    o[d0]=__builtin_amdgcn_mfma_f32_32x32x16_bf16(pa0,PK(0),o[d0],0,0,0);
    o[d0]=__builtin_amdgcn_mfma_f32_32x32x16_bf16(pa1,PK(1),o[d0],0,0,0);
    o[d0]=__builtin_amdgcn_mfma_f32_32x32x16_bf16(pa2,PK(2),o[d0],0,0,0);
    o[d0]=__builtin_amdgcn_mfma_f32_32x32x16_bf16(pa3,PK(3),o[d0],0,0,0);
    #undef PK
  }
}

template<int THRL> __device__ __forceinline__ void attn_unit(int b,int kvh,int q0,const bf16*X,bf16*O,float sk2,char*shm){
  const int tid=threadIdx.x,lane=tid&63,r32=lane&31,hi=lane>>5; const int wid=__builtin_amdgcn_readfirstlane(tid>>6);
  const int hq=kvh*4+(wid>>1); const long qrow0=(long)b*8192+q0+(wid&1)*QBLK;
  const bf16*Qw=X+qrow0*PITCH+hq*D;
  const bf16*Kh=X+1024+kvh*D,*Vh=X+1280+kvh*D;
  const int ctx0=16384+b*256;
  const int jlo=(q0>=128)?-2:-(q0>>6), jhi=(q0+128<8192)?2:((8192-64-q0)>>6);
  const int NT=4+(jhi-jlo+1);
  const int latb=b*8192+q0+64*(jlo-4);
  #define TROW(t) (((t)<4)?(ctx0+64*(t)):(latb+64*(t)))
  #define TMASK(t) ((((t)==4)&&(jlo==-2))?1:((((t)==NT-1)&&(jhi==2))?2:0))
  const unsigned lds0=(unsigned)(uintptr_t)shm;
  float*wsf=(float*)(shm+LDS_WS)+wid*64;
  const bf16*ksrc=Kh+(long)lane*PITCH+wid*8;
  const bf16*vsrc=Vh+(long)(16*(wid&3)+(lane>>2))*PITCH+(wid>>2)*32+(lane&3)*8;
  const unsigned kdst=lds0+LDS_K+wid*1024, vdst=lds0+LDS_V+wid*1024;
  #define DMA_K(t,slot) glds16(ksrc+(long)TROW(t)*PITCH,(unsigned)__builtin_amdgcn_readfirstlane(kdst+(slot)))
  #define DMA_V(t,slot) glds16(vsrc+(long)TROW(t)*PITCH,(unsigned)__builtin_amdgcn_readfirstlane(vdst+(slot)))
  const int vb0=(int)(lds0+LDS_V)+((lane>>4)&1)*32+(lane&3)*8+(4*hi+((lane&15)>>2))*64;
  const char*Kbase=shm+LDS_K; bf16x8 kf[8];
  const lds_cptr shm3=(lds_cptr)shm; const lds_cptr kp0=shm3+LDS_K+hi*1024+r32*16; const lds_cptr vp0=shm3+LDS_V+((lane>>4)&1)*32+(lane&3)*8+(4*hi+((lane&15)>>2))*64;
  DMA_K(0,0);DMA_V(0,0);DMA_K(1,SLOTB);
  bf16x8 qr[4];
  #pragma unroll
  for(int d0=0;d0<4;++d0)qr[d0]=*reinterpret_cast<const bf16x8*>(&Qw[(long)r32*PITCH+d0*16+hi*8]);
  float mhat=0.f,l_reg=0.f;f32x16 o[2];o[0]=f32x16{};o[1]=f32x16{};const f32x16 zc=f32x16{};
  const int qrel=(wid&1)*QBLK+r32;
  #define CMASK(P0,P1,t) do{const int mt_=TMASK(t); if(mt_)wmask(P0,P1,mt_,qrel,hi);}while(0)
  bool resc=false;
  #define START(P0,P1) do{ const float rm=rowmax(P0,P1); resc=false; mhat=rm; \
    _Pragma("unroll") for(int r=0;r<16;++r)P0[r]=__builtin_amdgcn_exp2f(fsub_s(P0[r],mhat)); }while(0)
  #define RESC() do{ if(resc){ asm volatile("s_waitcnt lgkmcnt(0)":::"memory"); \
      _Pragma("unroll") for(int d_=0;d_<2;++d_) _Pragma("unroll") for(int r=0;r<16;++r)o[d_][r]*=wsf[crow(r,hi)]; } }while(0)
  f32x16 pA0,pA1,pB0,pB1;
  int sl_prev=0,sl_cur=0,sl_next=SLOTB;
  #define ROT() do{sl_prev=sl_cur;sl_cur=sl_next;sl_next=(sl_next==(NSLOT-1)*SLOTB)?0:sl_next+SLOTB;}while(0)
  DMA_K(2,2*SLOTB);
  WAIT_BAR(3);
  qkt(pA0,pA1,Kbase,qr,r32,hi);asm volatile("s_nop 15\n\ts_nop 7":"+v"(pA0),"+v"(pA1));CMASK(pA0,pA1,0);
  START(pA0,pA1);
  _Pragma("unroll") for(int r=0;r<16;++r)pA1[r]=__builtin_amdgcn_exp2f(fsub_s(pA1[r],mhat));
  WAIT_BAR(0);
  DMA_K(3,0);DMA_V(1,SLOTB);
  ROT();
  kload8(kf,kp0+sl_cur);
  WAIT_BAR(2);
  s16x4 vlo[8],vhi[8]; u32x4 pw0,pw1,pw2,pw3;
  #define PKW(P,B) cvtpk_s(P[B],P[B+1])
  #define PAF(k) __builtin_bit_cast(bf16x8,pw##k)
  #define VFR(i) (bf16x8){vlo[i][0],vlo[i][1],vlo[i][2],vlo[i][3],vhi[i][0],vhi[i][1],vhi[i][2],vhi[i][3]}
  #define PIN(x) asm volatile("":"+v"(x))
  #define MX3(a,b,c) __builtin_fmaxf(__builtin_fmaxf((a),(b)),(c))
  #define GAPA(MF,A0,A1,A2,A3,W0,W1,PW) do{ MF; sacc+=A0; sacc+=A1; sacc+=A2; sacc+=A3; PIN(sacc); W0; W1; PIN(PW); SBAR(); }while(0)
  #define EX(v) __builtin_amdgcn_exp2f(v)
  #define GAPB(MF,X,B) do{ MF; X[B]=EX(X[B]-mhat); X[B+1]=EX(X[B+1]-mhat); X[B+2]=EX(X[B+2]-mhat); X[B+3]=EX(X[B+3]-mhat); PIN(X); SBAR(); }while(0)
  #define VRD(i) do{ vlo[i]=vtr(vp_+(((i)>>2)*4096+((i)&3)*1024)); vhi[i]=vtr(vp_+(((i)>>2)*4096+((i)&3)*1024+512)); }while(0)
  #define KRD(G,j) do{ if(G){ kload2(kf,kp0+sl_next,j); SBAR(); } }while(0)
  #define STEP(C0,C1,P0,P1,t,GK,GV,GL) do{ SBAR(); \
    const lds_cptr vp_=vp0+sl_prev; \
    VRD(0); SBAR(); float sacc=(P0[0]+P0[1]); \
    GAPA(C0=__builtin_amdgcn_mfma_f32_32x32x16_bf16(kf[0],qr[0],zc,0,0,0), P0[2],P0[3],P0[4],P0[5],     pw0[0]=PKW(P0,0), pw0[1]=PKW(P0,2), pw0); \
    VRD(4); SBAR(); GAPA(C1=__builtin_amdgcn_mfma_f32_32x32x16_bf16(kf[1],qr[0],zc,0,0,0), P0[6],P0[7],P0[8],P0[9],     pw0[2]=PKW(P0,4), pw0[3]=PKW(P0,6), pw0); \
    VRD(1); SBAR(); GAPA(C0=__builtin_amdgcn_mfma_f32_32x32x16_bf16(kf[2],qr[1],C0,0,0,0),   P0[10],P0[11],P0[12],P0[13], pw1[0]=PKW(P0,8), pw1[1]=PKW(P0,10), pw1); \
    VRD(5); SBAR(); GAPA(C1=__builtin_amdgcn_mfma_f32_32x32x16_bf16(kf[3],qr[1],C1,0,0,0),   P0[14],P0[15],P1[0],P1[1],   pw1[2]=PKW(P0,12),pw1[3]=PKW(P0,14), pw1); \
    VRD(2); SBAR(); GAPA(C0=__builtin_amdgcn_mfma_f32_32x32x16_bf16(kf[4],qr[2],C0,0,0,0),   P1[2],P1[3],P1[4],P1[5],     pw2[0]=PKW(P1,0), pw2[1]=PKW(P1,2), pw2); \
    VRD(6); SBAR(); GAPA(C1=__builtin_amdgcn_mfma_f32_32x32x16_bf16(kf[5],qr[2],C1,0,0,0),   P1[6],P1[7],P1[8],P1[9],     pw2[2]=PKW(P1,4), pw2[3]=PKW(P1,6), pw2); \
    VRD(3); SBAR(); GAPA(C0=__builtin_amdgcn_mfma_f32_32x32x16_bf16(kf[6],qr[3],C0,0,0,0),   P1[10],P1[11],P1[12],P1[13], pw3[0]=PKW(P1,8), pw3[1]=PKW(P1,10), pw3); \
    VRD(7); SBAR(); GAPA(C1=__builtin_amdgcn_mfma_f32_32x32x16_bf16(kf[7],qr[3],C1,0,0,0),   P1[14],P1[15],0.f,0.f,       pw3[2]=PKW(P1,12),pw3[3]=PKW(P1,14), pw3); \
    l_reg+=sacc; \
    if(GK){DMA_K((t)+3,sl_cur);} if(GV){DMA_V((t)+1,sl_next);} \
    CMASK(C0,C1,t); \
    { float a=MX3(C0[0],C0[1],C1[0]),b=MX3(C0[2],C0[3],C1[1]); a=MX3(a,C1[2],C1[3]); \
      _Pragma("unroll") for(int r=4;r<16;r+=4){a=MX3(a,C0[r],C0[r+1]);b=MX3(b,C0[r+2],C0[r+3]);a=MX3(a,C1[r],C1[r+1]);b=MX3(b,C1[r+2],C1[r+3]);} \
      float rm=__builtin_fmaxf(a,b); { auto rr=__builtin_amdgcn_permlane32_swap(__float_as_uint(rm),__float_as_uint(rm),false,false); rm=__builtin_fmaxf(__uint_as_float(rr[0]),__uint_as_float(rr[1])); } \
      resc=false; \
      rm-=mhat; \
      if(__builtin_expect(__any(rm>(float)THRL),0)){ const float dl=__builtin_fmaxf(rm,0.f); mhat+=dl; \
        const float f=__builtin_amdgcn_exp2f(-dl); l_reg*=f; if(hi==0)wsf[r32]=f; resc=true; } } \
    SBAR(); \
    GAPB(o[0]=__builtin_amdgcn_mfma_f32_32x32x16_bf16(PAF(0),VFR(0),o[0],0,0,0), C0,0); \
    GAPB(o[1]=__builtin_amdgcn_mfma_f32_32x32x16_bf16(PAF(0),VFR(4),o[1],0,0,0), C0,4); \
    KRD(GL,0); GAPB(o[0]=__builtin_amdgcn_mfma_f32_32x32x16_bf16(PAF(1),VFR(1),o[0],0,0,0), C0,8); \
    KRD(GL,1); GAPB(o[1]=__builtin_amdgcn_mfma_f32_32x32x16_bf16(PAF(1),VFR(5),o[1],0,0,0), C0,12); \
    KRD(GL,2); GAPB(o[0]=__builtin_amdgcn_mfma_f32_32x32x16_bf16(PAF(2),VFR(2),o[0],0,0,0), C1,0); \
    KRD(GL,3); GAPB(o[1]=__builtin_amdgcn_mfma_f32_32x32x16_bf16(PAF(2),VFR(6),o[1],0,0,0), C1,4); \
    GAPB(o[0]=__builtin_amdgcn_mfma_f32_32x32x16_bf16(PAF(3),VFR(3),o[0],0,0,0), C1,8); \
    GAPB(o[1]=__builtin_amdgcn_mfma_f32_32x32x16_bf16(PAF(3),VFR(7),o[1],0,0,0), C1,12); \
    }while(0)
  #define ENDW(tt) do{ if((tt)+3<NT){WAIT_BAR(2);} else if((tt)+2<NT){WAIT_BAR(1);} else {WAIT_BAR(0);} }while(0)
  #define DRAIN(PX0,PX1) do{ float sacc=PX0[0]+PX0[1]; _Pragma("unroll") for(int r=2;r<16;++r)sacc+=PX0[r]; _Pragma("unroll") for(int r=0;r<16;++r)sacc+=PX1[r]; l_reg+=sacc; \
    pw0=(u32x4){PKW(PX0,0),PKW(PX0,2),PKW(PX0,4),PKW(PX0,6)};pw1=(u32x4){PKW(PX0,8),PKW(PX0,10),PKW(PX0,12),PKW(PX0,14)};pw2=(u32x4){PKW(PX1,0),PKW(PX1,2),PKW(PX1,4),PKW(PX1,6)};pw3=(u32x4){PKW(PX1,8),PKW(PX1,10),PKW(PX1,12),PKW(PX1,14)}; \
    SBAR(); pv(o,vb0+sl_cur,PAF(0),PAF(1),PAF(2),PAF(3)); }while(0)
  int t=1;
  if(NT&1){
    STEP(pB0,pB1,pA0,pA1,t,(t+3<NT),(t+1<NT),(t+1<NT));       ENDW(t);   RESC(); ROT();
    pA0=pB0; pA1=pB1; t=2;
  }
  for(;t+2<NT;t+=2){
    STEP(pB0,pB1,pA0,pA1,t,(t+3<NT),(t+1<NT),(t+1<NT));       ENDW(t);   RESC(); ROT();
    STEP(pA0,pA1,pB0,pB1,t+1,(t+4<NT),(t+2<NT),(t+2<NT));     ENDW(t+1); RESC(); ROT();
  }
  STEP(pB0,pB1,pA0,pA1,NT-1,false,false,false); RESC();
  DRAIN(pB0,pB1);
  #undef DRAIN
  #undef PKW
  #undef PAF
  #undef VFR
  #undef PIN
  #undef MX3
  #undef GAPA
  #undef GAPB
  #undef EX
  #undef VRD
  #undef KRD
  #undef STEP
  #undef ENDW
  {auto rr=__builtin_amdgcn_permlane32_swap(__float_as_uint(l_reg),__float_as_uint(l_reg),false,false);l_reg=__uint_as_float(rr[0])+__uint_as_float(rr[1]);}
  l_reg+=__builtin_amdgcn_exp2f(sk2-mhat);
  if(hi==0)wsf[32+r32]=l_reg;asm volatile("s_waitcnt lgkmcnt(0)":::"memory");
  float rli[16];
  #pragma unroll
  for(int r=0;r<16;++r)rli[r]=__builtin_amdgcn_rcpf(wsf[32+crow(r,hi)]);
  bf16*Ow=O+qrow0*OPITCH+hq*D; const bf16*Gw=X+qrow0*PITCH+1536+hq*D;
  { bf16*stg=(bf16*)(shm+LDS_OST)+wid*2048;
    #pragma unroll
    for(int r=0;r<16;++r){const int orow=crow(r,hi);
      #pragma unroll
      for(int d0=0;d0<2;++d0)stg[orow*64+d0*32+r32]=__float2bfloat16(o[d0][r]*rli[r]);}
    asm volatile("s_waitcnt lgkmcnt(0)":::"memory");
    #pragma unroll
    for(int i=0;i<4;++i){const int row=i*8+(lane>>3),ch=lane&7; const u32x4 v=*(const u32x4*)(stg+row*64+ch*8); const u32x4 gq=*(const u32x4*)(Gw+(long)row*PITCH+ch*8); u32x4 w;
      #pragma unroll
      for(int e=0;e<4;++e){ const float g0=__uint_as_float(gq[e]<<16),g1=__uint_as_float(gq[e]&0xffff0000u),v0=__uint_as_float(v[e]<<16),v1=__uint_as_float(v[e]&0xffff0000u);
        w[e]=cvtpk_s(v0*g0*__builtin_amdgcn_rcpf(1.f+__builtin_amdgcn_exp2f(-1.4426950408889634f*g0)),v1*g1*__builtin_amdgcn_rcpf(1.f+__builtin_amdgcn_exp2f(-1.4426950408889634f*g1))); }
      *(u32x4*)(Ow+(long)row*OPITCH+ch*8)=w;} }
  asm volatile("s_waitcnt lgkmcnt(0)\n\ts_barrier":::"memory");
  #undef DMA_K
  #undef DMA_V
  #undef TROW
  #undef TMASK
  #undef CMASK
  #undef START
  #undef RESC
  #undef ROT
}
constexpr int ATTN_LDS_BYTES=LDS_BYTES;
template<int THRL=8> __device__ __forceinline__ void attn_phase(char*lds,const bf16*X,bf16*O,const float*sink,int grid,int block){
  const int vcu=(grid%8==0)?(block%8)*(grid/8)+block/8:block;
  const int wid=__builtin_amdgcn_readfirstlane(threadIdx.x>>6);
  for(int u=vcu*4;u<1024;u+=grid*4){
    #pragma unroll 1
    for(int i=0;i<4;++i){ const int uu=u+i; if(uu>=1024)break; const int bk=uu>>7, qb=uu&127, b=bk>>2, kvh=bk&3;
      attn_unit<THRL>(b,kvh,qb*64,X,O,sink[kvh*4+(wid>>1)]*1.4426950408889634f,lds); }
  }
}
#undef SBAR
#undef WAIT_BAR
}
#ifndef S5_CHECK
#define S5_CHECK 0
#endif
#ifndef ATTN_SIMPLE
#define ATTN_SIMPLE 0
#endif
#ifndef ATTN_CHECK
#define ATTN_CHECK 0
#endif
constexpr int D = 1024, SEQ = 8192, CTXN = 256, MLAT = 16384, MCTX = 512, M = MLAT + MCTX, PW = 2560;
constexpr float ALPHA = 1.41421356237309515f, LN_EPS = 1e-5f;
constexpr float LOG2E = 1.4426950408889634f, QSCALE = 0.125f * 1.4426950408889634f;
constexpr int NWAVES = 8, NTHREADS = 512;
constexpr int LDS_BYTES = 147456;
constexpr size_t MiB = 1u << 20;
constexpr size_t WS_MODV = 1 * MiB;
constexpr size_t WS_ROPE = 1 * MiB + 256 * 1024;
constexpr size_t WS_S5A = 1 * MiB + 512 * 1024;
constexpr size_t WS_S5A128 = 1 * MiB + 512 * 1024 + 32 * 1024;
constexpr size_t WS_BBT = 2 * MiB;
constexpr size_t WS_CT = 2 * MiB + 256 * 1024;
constexpr size_t WS_S5BB = 2 * MiB + 512 * 1024;
constexpr size_t WS_E = 3 * MiB;
constexpr size_t WS_WIN0 = 8 * MiB, WS_WOUT0 = 13 * MiB, WS_WGLU = 15 * MiB, WS_WIN1 = 16 * MiB, WS_WOUT1 = 21 * MiB;
constexpr size_t WS_H = 24 * MiB;
constexpr size_t WS_P = 57 * MiB;
constexpr size_t WS_MIX = 140 * MiB;
constexpr size_t WS_YA1 = 173 * MiB;
constexpr size_t WS_Z1C = 190 * MiB;
constexpr size_t WS_YAF = 192 * MiB;

typedef unsigned short bf16;
typedef float f32x4 __attribute__((ext_vector_type(4)));
typedef unsigned u32x2 __attribute__((ext_vector_type(2)));
typedef unsigned u32x4 __attribute__((ext_vector_type(4)));
#define LAS __attribute__((address_space(3)))
__device__ __forceinline__ unsigned f2bf(float f) { unsigned u = __builtin_bit_cast(unsigned, f); return (u + 0x7fffu + ((u >> 16) & 1u)) >> 16; }
__device__ __forceinline__ unsigned pk2(float lo, float hi) { return f2bf(lo) | (f2bf(hi) << 16); }
__device__ __forceinline__ float bf2f(unsigned h) { return __builtin_bit_cast(float, h << 16); }
__device__ __forceinline__ float bflo(unsigned w) { return __builtin_bit_cast(float, w << 16); }
__device__ __forceinline__ float bfhi(unsigned w) { return __builtin_bit_cast(float, w & 0xffff0000u); }
__device__ __forceinline__ float silu_f(float v) { return v / (1.f + __expf(-v)); }
__device__ __forceinline__ float gelu_tanh_f(float v) { const float u = 0.7978845608028654f * (v + 0.044715f * v * v * v); return v / (1.f + __expf(-2.f * u)); }
__device__ __forceinline__ float wave_sum(float v) {
#pragma unroll
    for (int o = 1; o < 64; o <<= 1) v += __shfl_xor(v, o);
    return v;
}
#define LDS_WAIT() asm volatile("s_waitcnt lgkmcnt(0)" ::: "memory")

struct Args { const float* in[27]; float* out; unsigned char* ws; };
typedef const __attribute__((address_space(4))) Args KArgs;

__device__ __forceinline__ int row_vec(int r) { return r < MLAT ? (r >> 13) : 2; }
__device__ __forceinline__ int chunk_row0(int cidx) { const int b = cidx / 66, c = cidx % 66; return c < 2 ? MLAT + b * CTXN + c * 128 : b * SEQ + (c - 2) * 128; }

__device__ __forceinline__ void p0_transpose_item(const float* W, int K, int N, bf16* WT, LAS float* scr, int item, int lane) {
    const int nblk = N / 32, kb = item / nblk, nb = item % nblk, k0 = 64 * kb, n0 = 32 * nb;
#pragma unroll 8
    for (int i = 0; i < 32; ++i) { const int kk = 2 * i + (lane >> 5); scr[kk * 33 + (lane & 31)] = W[(size_t)(k0 + kk) * N + n0 + (lane & 31)]; }
    LDS_WAIT();
    const int c = lane & 7;
#pragma unroll
    for (int j = 0; j < 4; ++j) { const int n = (lane >> 3) + 8 * j; const LAS float* s = scr + (8 * c) * 33 + n;
        u32x4 o; o.x = pk2(s[0 * 33], s[1 * 33]); o.y = pk2(s[2 * 33], s[3 * 33]); o.z = pk2(s[4 * 33], s[5 * 33]); o.w = pk2(s[6 * 33], s[7 * 33]);
        *(u32x4*)(WT + (size_t)(n0 + n) * K + k0 + 8 * c) = o; }
    LDS_WAIT();
}
__device__ __forceinline__ void phase_prologue(KArgs& a, LAS unsigned char* lds, int tid, int lane, int wave, int bid, int G) {
    asm volatile("" : "+v"(lane)); asm volatile("" : "+v"(tid));
    unsigned char* ws = a.ws;
    if (bid < 96) {
        LAS float* sv = (LAS float*)lds;
        LAS float* red = (LAS float*)(lds + 12288);
        const float* c = a.in[1]; const float* cc = a.in[3];
        for (int i = tid; i < 1024; i += NTHREADS) { sv[i] = silu_f(c[i]); sv[1024 + i] = silu_f(c[1024 + i]); sv[2048 + i] = silu_f(cc[i]); }
        __syncthreads();
        const int layer = bid / 48, n = (bid % 48) * 64 + lane;
        const float* w = a.in[4] + (size_t)layer * 1024 * 3072 + (size_t)(wave * 128) * 3072 + n;
        float a0 = 0.f, a1 = 0.f, a2 = 0.f;
#pragma unroll 8
        for (int k = 0; k < 128; ++k) { const float wv = w[(size_t)k * 3072]; const int kk = wave * 128 + k; a0 += sv[kk] * wv; a1 += sv[1024 + kk] * wv; a2 += sv[2048 + kk] * wv; }
        red[(wave * 3 + 0) * 64 + lane] = a0; red[(wave * 3 + 1) * 64 + lane] = a1; red[(wave * 3 + 2) * 64 + lane] = a2;
        __syncthreads();
        if (wave == 0) {
            float* modv = (float*)(ws + WS_MODV); const float bb = a.in[5][layer * 3072 + n];
#pragma unroll
            for (int v = 0; v < 3; ++v) { float s = 0.f;
#pragma unroll
                for (int w8 = 0; w8 < 8; ++w8) s += red[(w8 * 3 + v) * 64 + lane];
                modv[(layer * 3 + v) * 3072 + n] = s + bb; }
        }
        __syncthreads();
    }
    {
        const int gt = bid * NTHREADS + tid;
        if (gt < 4096) {
            const int dg = gt >> 6, p = gt & 63;
            const double lr = a.in[10][dg * 64 + p], li = a.in[11][dg * 64 + p], dt = exp((double)a.in[12][dg]);
            const double mag = exp(lr * dt), ang = li * dt;
            const double ar = mag * cos(ang), ai = mag * sin(ang);
            const double den = lr * lr + li * li, nr = ar - 1.0, ni = ai;
            const double fr = (nr * lr + ni * li) / den, fi = (ni * lr - nr * li) / den;
            float* A = (float*)(ws + WS_S5A); float* BB = (float*)(ws + WS_S5BB);
            A[gt * 2] = (float)ar; A[gt * 2 + 1] = (float)ai;
            { const double m128 = exp(128.0 * lr * dt), a128 = 128.0 * ang; float* A128 = (float*)(ws + WS_S5A128); A128[gt * 2] = (float)(m128 * cos(a128)); A128[gt * 2 + 1] = (float)(m128 * sin(a128)); }
            for (int h = 0; h < 16; ++h) { const double br = a.in[13][gt * 16 + h], bi = a.in[14][gt * 16 + h];
                BB[(gt * 16 + h) * 2] = (float)(fr * br - fi * bi); BB[(gt * 16 + h) * 2 + 1] = (float)(fr * bi + fi * br); }
        } else if (gt >= 8192 && gt < 8192 + 16384) {
            const int e = gt - 8192, l = e & 63, tile = (e >> 6) & 3, dg = e >> 8;
            const int p = (tile >> 1) * 32 + (l & 31), ri = tile & 1, hb = l >> 5;
            const double lr = a.in[10][dg * 64 + p], li = a.in[11][dg * 64 + p], dt = exp((double)a.in[12][dg]);
            const double mag = exp(lr * dt), ang = li * dt;
            const double ar = mag * cos(ang), ai = mag * sin(ang);
            const double den = lr * lr + li * li, nr = ar - 1.0, ni = ai;
            const double fr = (nr * lr + ni * li) / den, fi = (ni * lr - nr * li) / den;
            unsigned w[4];
            for (int jj = 0; jj < 4; ++jj) { float v[2];
                for (int q = 0; q < 2; ++q) { const int h = 8 * hb + 2 * jj + q; const double br = a.in[13][(dg * 64 + p) * 16 + h], bi = a.in[14][(dg * 64 + p) * 16 + h];
                    v[q] = (float)(ri == 0 ? fr * br - fi * bi : fr * bi + fi * br); }
                w[jj] = pk2(v[0], v[1]); }
            *(u32x4*)(ws + WS_BBT + (size_t)e * 16) = (u32x4){w[0], w[1], w[2], w[3]};
        } else if (gt >= 32768 && gt < 32768 + 16384) {
            const int e = gt - 32768, l = e & 63, ks = (e >> 6) & 3, dg = e >> 8;
            const int hp = l & 15, kq = l >> 4;
            unsigned w[4];
            for (int jj = 0; jj < 4; ++jj) { const int p = (ks * 32 + 8 * kq + 2 * jj) >> 1;
                w[jj] = pk2(a.in[15][(dg * 16 + hp) * 64 + p], -a.in[16][(dg * 16 + hp) * 64 + p]); }
            *(u32x4*)(ws + WS_CT + (size_t)e * 16) = (u32x4){w[0], w[1], w[2], w[3]};
        } else if (gt >= 4096 && gt < 4096 + 2048) {
            const int e = gt - 4096, pos = e >> 4, fi = e & 15;
            const float inv = powf(10000.f, -(float)fi / 16.f);
            const float ang = (float)pos * inv;
            float* cs = (float*)(ws + WS_ROPE); cs[e * 2] = (float)cos((double)ang); cs[e * 2 + 1] = (float)sin((double)ang);
        }
    }
    {
        LAS float* scr = (LAS float*)(lds + 32768 + wave * 8448);
        const int gw = bid * NWAVES + wave, NGW = G * NWAVES;
        constexpr int I_IN = 16 * 80, I_OUT = 16 * 32, I_GLU = 8 * 16;
        constexpr int NITEMS = 2 * I_IN + 2 * I_OUT + I_GLU;
        for (int it = gw; it < NITEMS; it += NGW) {
            int r = it;
            if (r < I_IN) { p0_transpose_item(a.in[8], 1024, 2560, (bf16*)(ws + WS_WIN0), scr, r, lane); continue; } r -= I_IN;
            if (r < I_IN) { p0_transpose_item(a.in[24], 1024, 2560, (bf16*)(ws + WS_WIN1), scr, r, lane); continue; } r -= I_IN;
            if (r < I_OUT) { p0_transpose_item(a.in[9], 1024, 1024, (bf16*)(ws + WS_WOUT0), scr, r, lane); continue; } r -= I_OUT;
            if (r < I_OUT) { p0_transpose_item(a.in[25], 1024, 1024, (bf16*)(ws + WS_WOUT1), scr, r, lane); continue; } r -= I_OUT;
            p0_transpose_item(a.in[18], 512, 512, (bf16*)(ws + WS_WGLU), scr, r, lane);
        }
    }
}

__device__ __forceinline__ void phase_modulate0(KArgs& a, int lane, int wave, int bid, int G) {
    asm volatile("" : "+v"(lane));
    const float* modv = (const float*)(a.ws + WS_MODV);
    bf16* H = (bf16*)(a.ws + WS_H);
    const int gw = bid * NWAVES + wave, NGW = G * NWAVES;
    for (int r = gw; r < M; r += NGW) {
        const float* z = (r < MLAT) ? a.in[0] + (size_t)r * D : a.in[2] + (size_t)(r - MLAT) * D;
        const float* mv = modv + row_vec(r) * 3072;
#pragma unroll
        for (int j = 0; j < 4; ++j) { const int c = lane * 4 + 256 * j;
            const f32x4 v = *(const f32x4*)(z + c), sh = *(const f32x4*)(mv + c), sc = *(const f32x4*)(mv + D + c);
            const f32x4 h = v * (sc + 1.f) + sh;
            u32x2 o; o.x = pk2(h[0], h[1]); o.y = pk2(h[2], h[3]);
            *(u32x2*)(H + (size_t)r * D + c) = o; }
    }
}

__device__ __forceinline__ int seq_row(int b, int t) { return t < CTXN ? MLAT + b * CTXN + t : b * SEQ + (t - CTXN); }
__device__ __forceinline__ void phase_s5_naive(KArgs& a, LAS unsigned char* lds, int lane, int wave, int bid, int G, bf16* YA1) {
    asm volatile("" : "+v"(lane));
    const int gw = bid * NWAVES + wave;
    if (gw >= 64) return;
    const int b = gw >> 5, g = gw & 31, p = lane, hh = lane & 15;
    const bf16* P = (const bf16*)(a.ws + WS_P); float* YAF = (float*)(a.ws + WS_YAF);
    const float* A = (const float*)(a.ws + WS_S5A); const float* BB = (const float*)(a.ws + WS_S5BB);
    LAS float* sre = (LAS float*)(lds + wave * 512); LAS float* sim = sre + 64;
    for (int dir = 0; dir < 2; ++dir) {
        const int dg = dir * 32 + g;
        const float ar = A[(dg * 64 + p) * 2], ai = A[(dg * 64 + p) * 2 + 1];
        const float* bbp = BB + (size_t)(dg * 64 + p) * 32;
        const float* cre = a.in[15] + (dg * 16 + hh) * 64; const float* cim = a.in[16] + (dg * 16 + hh) * 64;
        const float dsk = a.in[17][g * 16 + hh];
        float sr = 0.f, si = 0.f;
        for (int j = 0; j < SEQ + CTXN; ++j) {
            const int t = (dir == 0) ? j : (j < CTXN ? CTXN - 1 - j : SEQ + 2 * CTXN - 1 - j);
            const int row = seq_row(b, t);
            const bf16* up = P + (size_t)row * PW + g * 16;
            const u32x4 u0 = *(const u32x4*)up, u1 = *(const u32x4*)(up + 8);
            float u[16];
#pragma unroll
            for (int h = 0; h < 4; ++h) { u[2 * h] = bflo(u0[h]); u[2 * h + 1] = bfhi(u0[h]); u[8 + 2 * h] = bflo(u1[h]); u[8 + 2 * h + 1] = bfhi(u1[h]); }
            float bur = 0.f, bui = 0.f;
#pragma unroll
            for (int h = 0; h < 16; ++h) { bur += bbp[2 * h] * u[h]; bui += bbp[2 * h + 1] * u[h]; }
            const float nr = ar * sr - ai * si + bur, ni = ar * si + ai * sr + bui;
            sr = nr; si = ni;
            sre[p] = sr; sim[p] = si;
            LDS_WAIT();
            if (p < 16) {
                float y = 0.f;
                for (int q = 0; q < 64; ++q) y += cre[q] * sre[q] - cim[q] * sim[q];
                const size_t o = (size_t)row * 512 + g * 16 + p;
                float uo = 0.f;
#pragma unroll
                for (int h = 0; h < 16; ++h) uo = (h == p) ? u[h] : uo;
                if (dir == 0) YAF[o] = y + dsk * uo;
                else YA1[o] = (bf16)f2bf(gelu_tanh_f(YAF[o] + y));
            }
            LDS_WAIT();
        }
    }
}

typedef short bf16x8 __attribute__((ext_vector_type(8)));
typedef float f32x16 __attribute__((ext_vector_type(16)));
typedef float f32x2_t __attribute__((ext_vector_type(2))); typedef __bf16 bf16x2_t __attribute__((ext_vector_type(2)));
__device__ __forceinline__ unsigned cvtpk(float lo, float hi) { f32x2_t v = {lo, hi}; bf16x2_t b = __builtin_convertvector(v, bf16x2_t); return __builtin_bit_cast(unsigned, b); }
__device__ __forceinline__ int s5_kidx(int dir, int c) { return dir == 0 ? c : (c == 1 ? 0 : (c == 0 ? 1 : 67 - c)); }
constexpr int S5_LDS_ROW = 272, S5_LDS_S = 32 * S5_LDS_ROW, S5_LDS_WAVE = S5_LDS_S + 8192;

template <int PASS>
__device__ __forceinline__ void s5_task(KArgs& a, LAS unsigned char* sl, int lane, int c, int g) {
    const int c32 = lane & 31, hb = lane >> 5;
    const bf16* P = (const bf16*)(a.ws + WS_P);
    const float* A = (const float*)(a.ws + WS_S5A); const float* A128 = (const float*)(a.ws + WS_S5A128);
    float* E = (float*)(a.ws + WS_E); bf16* YA1 = (bf16*)(a.ws + WS_YA1);
    const int r = lane & 31, beta_a = (r >> 2) & 1, s_a = (r & 3) + 4 * (r >> 3);
    const bf16* ua = P + (size_t)chunk_row0(beta_a * 66 + c) * PW + g * 16 + 8 * hb;
    LAS bf16* yl = (LAS bf16*)(sl + S5_LDS_S);
    const int hp = lane & 15, tq = lane >> 4;
    const float dsk = a.in[17][g * 16 + hp];
#pragma unroll 1
    for (int dir = 0; dir < 2; ++dir) {
        const int dg = dir * 32 + g;
        bf16x8 bbt[4], ct[4];
#pragma unroll
        for (int t = 0; t < 4; ++t) bbt[t] = *(const bf16x8*)(a.ws + WS_BBT + ((size_t)(dg * 4 + t) * 64 + lane) * 16);
        if (PASS == 2) {
#pragma unroll
            for (int t = 0; t < 4; ++t) ct[t] = *(const bf16x8*)(a.ws + WS_CT + ((size_t)(dg * 4 + t) * 64 + lane) * 16);
        }
        const float arA = A[(dg * 64 + c32) * 2], aiA = A[(dg * 64 + c32) * 2 + 1], arB = A[(dg * 64 + 32 + c32) * 2], aiB = A[(dg * 64 + 32 + c32) * 2 + 1];
        const int kk = s5_kidx(dir, c);
        float* Eb = E + ((size_t)((dir * 2 + hb) * 32 + g) * 66) * 128;
        float srA = 0.f, siA = 0.f, srB = 0.f, siB = 0.f;
        if (PASS == 2) {
            const float qrA = A128[(dg * 64 + c32) * 2], qiA = A128[(dg * 64 + c32) * 2 + 1], qrB = A128[(dg * 64 + 32 + c32) * 2], qiB = A128[(dg * 64 + 32 + c32) * 2 + 1];
            for (int k = 0; k < kk; ++k) {
                const f32x2_t eA = *(const f32x2_t*)(Eb + (size_t)k * 128 + c32 * 2), eB = *(const f32x2_t*)(Eb + (size_t)k * 128 + (32 + c32) * 2);
                const float nrA = qrA * srA - qiA * siA + eA.x, niA = qrA * siA + qiA * srA + eA.y;
                const float nrB = qrB * srB - qiB * siB + eB.x, niB = qrB * siB + qiB * srB + eB.y;
                srA = nrA; siA = niA; srB = nrB; siB = niB;
            }
        }
        const bf16* ud = ua + (size_t)(dir == 0 ? s_a : 127 - s_a) * PW; const long ustep = dir == 0 ? 16L * PW : -16L * PW;
        bf16x8 ufn = *(const bf16x8*)ud;
#pragma unroll 1
        for (int j = 0; j < 8; ++j) {
            const bf16x8 ufc = ufn;
            ufn = *(const bf16x8*)(ud + (j < 7 ? j + 1 : 7) * ustep);
            const f32x16 z16 = {0.f, 0.f, 0.f, 0.f, 0.f, 0.f, 0.f, 0.f, 0.f, 0.f, 0.f, 0.f, 0.f, 0.f, 0.f, 0.f};
            {
                const f32x16 re = __builtin_amdgcn_mfma_f32_32x32x16_bf16(ufc, bbt[0], z16, 0, 0, 0);
                const f32x16 im = __builtin_amdgcn_mfma_f32_32x32x16_bf16(ufc, bbt[1], z16, 0, 0, 0);
#pragma unroll
                for (int s = 0; s < 16; ++s) {
                    const float nr = arA * srA + (re[s] - aiA * siA), ni = arA * siA + (im[s] + aiA * srA);
                    srA = nr; siA = ni;
                    if (PASS == 2) *(LAS unsigned*)(sl + (16 * hb + (dir == 0 ? s : 15 - s)) * S5_LDS_ROW + c32 * 4) = cvtpk(srA, siA);
                }
            }
            {
                const f32x16 re = __builtin_amdgcn_mfma_f32_32x32x16_bf16(ufc, bbt[2], z16, 0, 0, 0);
                const f32x16 im = __builtin_amdgcn_mfma_f32_32x32x16_bf16(ufc, bbt[3], z16, 0, 0, 0);
#pragma unroll
                for (int s = 0; s < 16; ++s) {
                    const float nr = arB * srB + (re[s] - aiB * siB), ni = arB * siB + (im[s] + aiB * srB);
                    srB = nr; siB = ni;
                    if (PASS == 2) *(LAS unsigned*)(sl + (16 * hb + (dir == 0 ? s : 15 - s)) * S5_LDS_ROW + (32 + c32) * 4) = cvtpk(srB, siB);
                }
            }
            if (PASS == 2) {
                const int blk = dir == 0 ? j : 7 - j;
#pragma unroll
                for (int b2 = 0; b2 < 2; ++b2) {
                    f32x4 y = (f32x4){0.f, 0.f, 0.f, 0.f};
#pragma unroll
                    for (int ks = 0; ks < 4; ++ks) {
                        const bf16x8 af = *(const LAS bf16x8*)(sl + (16 * b2 + (lane & 15)) * S5_LDS_ROW + ks * 64 + (lane >> 4) * 16);
                        y = __builtin_amdgcn_mfma_f32_16x16x32_bf16(af, ct[ks], y, 0, 0, 0);
                    }
                    if (dir == 0) {
#pragma unroll
                        for (int rg = 0; rg < 4; ++rg) yl[(b2 * 128 + 16 * blk + 4 * tq + rg) * 16 + hp] = (bf16)f2bf(y[rg]);
                    } else {
                        const size_t row0 = (size_t)(chunk_row0(b2 * 66 + c) + 16 * blk + 4 * tq);
#pragma unroll
                        for (int rg = 0; rg < 4; ++rg) { const size_t row = row0 + rg;
                            const float u = bf2f(P[row * PW + g * 16 + hp]);
                            const float v = y[rg] + bf2f(yl[(b2 * 128 + 16 * blk + 4 * tq + rg) * 16 + hp]) + dsk * u;
                            YA1[row * 512 + g * 16 + hp] = (bf16)f2bf(gelu_tanh_f(v)); }
                    }
                }
            }
        }
        if (PASS == 1) {
            *(f32x2_t*)(Eb + (size_t)kk * 128 + c32 * 2) = (f32x2_t){srA, siA};
            *(f32x2_t*)(Eb + (size_t)kk * 128 + (32 + c32) * 2) = (f32x2_t){srB, siB};
        }
    }
}
template <int PASS>
__device__ __forceinline__ void phase_s5(KArgs& a, LAS unsigned char* lds, int lane, int wave, int bid, int G) {
    LAS unsigned char* sl = lds + wave * S5_LDS_WAVE;
    const int gw = bid * NWAVES + wave, NGW = G * NWAVES;
    for (int task = gw; task < 66 * 32; task += NGW) s5_task<PASS>(a, sl, lane, task >> 5, task & 31);
}

__device__ __forceinline__ void gmlp_simple_task(KArgs& a, LAS unsigned char* lds, int tid, int lane, int wave, int task) {
    asm volatile("" : "+v"(lane)); asm volatile("" : "+v"(tid));
    const int cidx = task >> 3, h = task & 7, rb = chunk_row0(cidx);
    const bf16* P = (const bf16*)(a.ws + WS_P); bf16* MIX = (bf16*)(a.ws + WS_MIX);
    LAS float* stat = (LAS float*)lds;
    for (int i = 0; i < 16; ++i) { const int row = wave * 16 + i;
        const u32x4 w = *(const u32x4*)(P + (size_t)(rb + row) * PW + 1536 + lane * 8);
        float x[8];
#pragma unroll
        for (int j = 0; j < 4; ++j) { x[2 * j] = bflo(w[j]); x[2 * j + 1] = bfhi(w[j]); }
        float s = 0.f;
#pragma unroll
        for (int j = 0; j < 8; ++j) s += x[j];
        const float mean = wave_sum(s) * (1.f / 512.f); float q = 0.f;
#pragma unroll
        for (int j = 0; j < 8; ++j) { const float d = x[j] - mean; q += d * d; }
        const float rstd = 1.f / sqrtf(wave_sum(q) * (1.f / 512.f) + LN_EPS);
        if (lane == 0) { stat[row * 2] = mean; stat[row * 2 + 1] = rstd; } }
    __syncthreads();
    const int d = tid & 63, qq = tid >> 6, c = h * 64 + d;
    const float lg = a.in[20][c], lb = a.in[21][c];
    const float* ws_ = a.in[22] + (size_t)h * 128 * 128;
    float acc[16];
#pragma unroll
    for (int i = 0; i < 16; ++i) acc[i] = 0.f;
    for (int k = 0; k < 128; ++k) {
        const float vn = (bf2f(P[(size_t)(rb + k) * PW + 1536 + c]) - stat[k * 2]) * stat[k * 2 + 1] * lg + lb;
#pragma unroll
        for (int i = 0; i < 16; ++i) acc[i] += ws_[(qq + 8 * i) * 128 + k] * vn;
    }
#pragma unroll
    for (int i = 0; i < 16; ++i) { const int q = qq + 8 * i; const size_t r = (size_t)(rb + q);
        const float s = acc[i] + a.in[23][h * 128 + q];
        MIX[r * D + 512 + c] = (bf16)f2bf(bf2f(P[r * PW + 1024 + c]) * s * silu_f(bf2f(P[r * PW + 2048 + c]))); }
    __syncthreads();
}

__device__ __forceinline__ void phase_ln0(KArgs& a, int lane, int wave, int bid, int G) {
    asm volatile("" : "+v"(lane));
    const float* modv = (const float*)(a.ws + WS_MODV);
    const bf16* Y0 = (const bf16*)(a.ws + WS_P); bf16* H = (bf16*)(a.ws + WS_H); float* Z1C = (float*)(a.ws + WS_Z1C);
    const int gw = bid * NWAVES + wave, NGW = G * NWAVES;
    for (int r = gw; r < M; r += NGW) {
        const float* z = (r < MLAT) ? a.in[0] + (size_t)r * D : a.in[2] + (size_t)(r - MLAT) * D;
        float* zo = (r < MLAT) ? a.out + (size_t)r * D : Z1C + (size_t)(r - MLAT) * D;
        const int vec = row_vec(r);
        const float* g0 = modv + vec * 3072 + 2 * D; const float* mv1 = modv + (3 + vec) * 3072;
        f32x4 v[4]; float s = 0.f;
#pragma unroll
        for (int j = 0; j < 4; ++j) { const int c = lane * 4 + 256 * j;
            const f32x4 zz = *(const f32x4*)(z + c), gg = *(const f32x4*)(g0 + c); const u32x2 yw = *(const u32x2*)(Y0 + (size_t)r * D + c);
            f32x4 y; y[0] = bflo(yw.x); y[1] = bfhi(yw.x); y[2] = bflo(yw.y); y[3] = bfhi(yw.y);
            v[j] = zz * ALPHA + y * gg; s += (v[j][0] + v[j][1]) + (v[j][2] + v[j][3]); }
        const float mean = wave_sum(s) * (1.f / D); float q = 0.f;
#pragma unroll
        for (int j = 0; j < 4; ++j) { v[j] = v[j] - mean; q += (v[j][0] * v[j][0] + v[j][1] * v[j][1]) + (v[j][2] * v[j][2] + v[j][3] * v[j][3]); }
        const float rstd = 1.f / sqrtf(wave_sum(q) * (1.f / D) + LN_EPS);
#pragma unroll
        for (int j = 0; j < 4; ++j) { const int c = lane * 4 + 256 * j;
            const f32x4 z1 = v[j] * rstd * *(const f32x4*)(a.in[6] + c) + *(const f32x4*)(a.in[7] + c);
            *(f32x4*)(zo + c) = z1;
            const f32x4 h = z1 * (*(const f32x4*)(mv1 + D + c) + 1.f) + *(const f32x4*)(mv1 + c);
            u32x2 o; o.x = pk2(h[0], h[1]); o.y = pk2(h[2], h[3]);
            *(u32x2*)(H + (size_t)r * D + c) = o; }
    }
}
__device__ __forceinline__ void phase_ln1(KArgs& a, int lane, int wave, int bid, int G) {
    asm volatile("" : "+v"(lane));
    const float* modv = (const float*)(a.ws + WS_MODV);
    const bf16* Y1 = (const bf16*)(a.ws + WS_H);
    const int gw = bid * NWAVES + wave, NGW = G * NWAVES;
    for (int r = gw; r < MLAT; r += NGW) {
        float* zo = a.out + (size_t)r * D;
        const float* g1 = modv + (3 + (r >> 13)) * 3072 + 2 * D;
        f32x4 v[4]; float s = 0.f;
#pragma unroll
        for (int j = 0; j < 4; ++j) { const int c = lane * 4 + 256 * j;
            const f32x4 zz = *(const f32x4*)(zo + c), gg = *(const f32x4*)(g1 + c); const u32x2 yw = *(const u32x2*)(Y1 + (size_t)r * D + c);
            f32x4 y; y[0] = bflo(yw.x); y[1] = bfhi(yw.x); y[2] = bflo(yw.y); y[3] = bfhi(yw.y);
            v[j] = zz * ALPHA + y * gg; s += (v[j][0] + v[j][1]) + (v[j][2] + v[j][3]); }
        const float mean = wave_sum(s) * (1.f / D); float q = 0.f;
#pragma unroll
        for (int j = 0; j < 4; ++j) { v[j] = v[j] - mean; q += (v[j][0] * v[j][0] + v[j][1] * v[j][1]) + (v[j][2] * v[j][2] + v[j][3] * v[j][3]); }
        const float rstd = 1.f / sqrtf(wave_sum(q) * (1.f / D) + LN_EPS);
#pragma unroll
        for (int j = 0; j < 4; ++j) { const int c = lane * 4 + 256 * j;
            *(f32x4*)(zo + c) = v[j] * rstd * *(const f32x4*)(a.in[6] + D + c) + *(const f32x4*)(a.in[7] + D + c); }
    }
}

__device__ __forceinline__ void phase_attn_simple(KArgs& a, int lane, int wave, int bid, int G, bf16* MIX) {
    asm volatile("" : "+v"(lane));
    const bf16* P = (const bf16*)(a.ws + WS_P);
    const int sub = lane & 3, hq = lane >> 2, kvh = hq >> 2;
    const float sk2 = a.in[26][hq] * LOG2E;
    const int gw = bid * NWAVES + wave, NGW = G * NWAVES;
    for (int r = gw; r < MLAT; r += NGW) {
        const int b = r >> 13, t = r & 8191;
        float q[16];
        { const bf16* qp = P + (size_t)r * PW + hq * 64 + sub * 16; const u32x4 w0 = *(const u32x4*)qp, w1 = *(const u32x4*)(qp + 8);
#pragma unroll
          for (int j = 0; j < 4; ++j) { q[2 * j] = bflo(w0[j]); q[2 * j + 1] = bfhi(w0[j]); q[8 + 2 * j] = bflo(w1[j]); q[8 + 2 * j + 1] = bfhi(w1[j]); } }
        const int lo = t - 128 < 0 ? 0 : t - 128, hi = t + 128 > SEQ - 1 ? SEQ - 1 : t + 128;
        const int nk = CTXN + (hi - lo + 1);
        const bf16* kc = P + (size_t)(MLAT + b * CTXN) * PW + 1024 + kvh * 64 + sub * 16;
        const bf16* kl = P + (size_t)(b * SEQ + lo) * PW + 1024 + kvh * 64 + sub * 16;
        float mx = sk2;
        for (int i = 0; i < nk; ++i) { const bf16* kp = (i < CTXN) ? kc + (size_t)i * PW : kl + (size_t)(i - CTXN) * PW;
            const u32x4 w0 = *(const u32x4*)kp, w1 = *(const u32x4*)(kp + 8); float s = 0.f;
#pragma unroll
            for (int j = 0; j < 4; ++j) { s += q[2 * j] * bflo(w0[j]) + q[2 * j + 1] * bfhi(w0[j]); s += q[8 + 2 * j] * bflo(w1[j]) + q[8 + 2 * j + 1] * bfhi(w1[j]); }
            s += __shfl_xor(s, 1); s += __shfl_xor(s, 2);
            mx = fmaxf(mx, s); }
        float l = exp2f(sk2 - mx);
        float o[16];
#pragma unroll
        for (int j = 0; j < 16; ++j) o[j] = 0.f;
        for (int i = 0; i < nk; ++i) { const bf16* kp = (i < CTXN) ? kc + (size_t)i * PW : kl + (size_t)(i - CTXN) * PW;
            const u32x4 w0 = *(const u32x4*)kp, w1 = *(const u32x4*)(kp + 8); float s = 0.f;
#pragma unroll
            for (int j = 0; j < 4; ++j) { s += q[2 * j] * bflo(w0[j]) + q[2 * j + 1] * bfhi(w0[j]); s += q[8 + 2 * j] * bflo(w1[j]) + q[8 + 2 * j + 1] * bfhi(w1[j]); }
            s += __shfl_xor(s, 1); s += __shfl_xor(s, 2);
            const float pr = exp2f(s - mx); l += pr;
            const u32x4 v0 = *(const u32x4*)(kp + 256), v1 = *(const u32x4*)(kp + 264);
#pragma unroll
            for (int j = 0; j < 4; ++j) { o[2 * j] += pr * bflo(v0[j]); o[2 * j + 1] += pr * bfhi(v0[j]); o[8 + 2 * j] += pr * bflo(v1[j]); o[8 + 2 * j + 1] += pr * bfhi(v1[j]); } }
        const float rl = 1.f / l;
        const bf16* gp = P + (size_t)r * PW + 1536 + hq * 64 + sub * 16;
        const u32x4 g0 = *(const u32x4*)gp, g1 = *(const u32x4*)(gp + 8);
        u32x4 w0, w1;
#pragma unroll
        for (int j = 0; j < 4; ++j) { w0[j] = pk2(o[2 * j] * rl * silu_f(bflo(g0[j])), o[2 * j + 1] * rl * silu_f(bfhi(g0[j])));
                                      w1[j] = pk2(o[8 + 2 * j] * rl * silu_f(bflo(g1[j])), o[8 + 2 * j + 1] * rl * silu_f(bfhi(g1[j]))); }
        bf16* op = MIX + (size_t)r * D + hq * 64 + sub * 16;
        *(u32x4*)op = w0; *(u32x4*)(op + 8) = w1;
    }
}

#define XB_TMO      128
#define XB_XCNT(j)  (256  + 64 * (j))
#define XB_XSUB(j)  (1280 + 64 * (j))
#define XB_XGEN(j)  (2304 + 64 * (j))
#define XB_TOP      3328
#define XB_TOPGEN   3392
#define XCD_BAR_WORDS 3456
#define XB_SPIN_CAP (1u << 18)

__device__ __forceinline__ unsigned xb_ld(unsigned* p)              { return __hip_atomic_load(p, __ATOMIC_RELAXED, __HIP_MEMORY_SCOPE_AGENT); }
__device__ __forceinline__ unsigned xb_add(unsigned* p, unsigned v) { return __hip_atomic_fetch_add(p, v, __ATOMIC_RELAXED, __HIP_MEMORY_SCOPE_AGENT); }
__device__ __forceinline__ unsigned xb_xcc_id() { return (unsigned)__builtin_amdgcn_s_getreg((3 << 11) | 20) & 0xFu; }
#define XB_SPIN(cond, bar) do { unsigned _sp = 0; while (cond) { __builtin_amdgcn_s_sleep(1); \
    if ((++_sp & 255u) == 0u) { if (xb_ld(&(bar)[XB_TMO])) break; if (_sp > XB_SPIN_CAP) { atomicAdd(&(bar)[XB_TMO], 1u); break; } } } } while (0)

struct XcdBarrier {
    unsigned* bar; unsigned x;
    volatile LAS unsigned* st;
};

__device__ __forceinline__ XcdBarrier xcd_barrier_post(unsigned* bar, volatile LAS unsigned* st) {
    XcdBarrier b; b.bar = bar; b.x = xb_xcc_id(); b.st = st;
    if (threadIdx.x == 0) (void)xb_add(&bar[XB_XCNT(b.x)], 1u);
    return b;
}
__device__ __forceinline__ void xcd_barrier_complete(unsigned* bar, unsigned x, unsigned& nloc, unsigned& nx) {
    const unsigned G = gridDim.x * gridDim.y * gridDim.z;
    unsigned sum, cnt, mine, sp = 0u;
    for (;;) {
        sum = 0u; cnt = 0u; mine = 0u;
#pragma unroll
        for (unsigned j = 0; j < 16; ++j) { const unsigned c = xb_ld(&bar[XB_XCNT(j)]); sum += c; cnt += (c > 0u) ? 1u : 0u; mine = (j == x) ? c : mine; }
        if (sum == G) break;
        __builtin_amdgcn_s_sleep(1);
        if ((++sp & 255u) == 0u) { if (xb_ld(&bar[XB_TMO])) break; if (sp > XB_SPIN_CAP) { atomicAdd(&bar[XB_TMO], 1u); break; } }
    }
    nloc = mine > 0u ? mine : 1u; nx = cnt > 0u ? cnt : 1u;
}

__device__ __forceinline__ void xcd_barrier(const XcdBarrier& b) {
    asm volatile("s_waitcnt vmcnt(0)" ::: "memory");
    __syncthreads();
    if (threadIdx.x == 0) {
        unsigned* bar = b.bar;
        __builtin_amdgcn_s_waitcnt(0);
        unsigned nloc = b.st[0], nx = b.st[1];
        if (nloc == 0u) { xcd_barrier_complete(bar, b.x, nloc, nx); b.st[0] = nloc; b.st[1] = nx; }
        const unsigned old = xb_add(&bar[XB_XSUB(b.x)], 1u);
        const unsigned gen = old / nloc;
        if (old + 1u == (gen + 1u) * nloc) {
            __builtin_amdgcn_fence(__ATOMIC_RELEASE, "agent");
            asm volatile("s_waitcnt vmcnt(0)" ::: "memory");
            const unsigned og = xb_add(&bar[XB_TOP], 1u);
            const unsigned tg = og / nx;
            if (og + 1u == (tg + 1u) * nx) xb_add(&bar[XB_TOPGEN], 1u);
            else XB_SPIN(xb_ld(&bar[XB_TOPGEN]) == tg, bar);
            __builtin_amdgcn_fence(__ATOMIC_ACQUIRE, "agent");
            xb_add(&bar[XB_XGEN(b.x)], 1u);
            asm volatile("s_waitcnt vmcnt(0)" ::: "memory");
        } else {
            XB_SPIN(xb_ld(&bar[XB_XGEN(b.x)]) == gen, bar);
            __builtin_amdgcn_fence(__ATOMIC_ACQUIRE, "agent");
            asm volatile("s_waitcnt vmcnt(0)" ::: "memory");
        }
    }
    __syncthreads();
}

__global__ void __launch_bounds__(NTHREADS, 2) mega_fwd(Args a_unused) {
    extern __shared__ __attribute__((aligned(16))) unsigned char lds_raw[];
    LAS unsigned char* lds = (LAS unsigned char*)lds_raw;
    cg::grid_group grid = cg::this_grid();
    const int tid = threadIdx.x, lane = tid & 63, wave = __builtin_amdgcn_readfirstlane(tid >> 6), bid = blockIdx.x, G = gridDim.x;
    volatile LAS unsigned* bst = (volatile LAS unsigned*)(lds + LDS_BYTES - 64);
    if (tid == 0) { bst[0] = 0u; bst[1] = 0u; }
    __syncthreads();
    XcdBarrier xbar;
#define GRID_SYNC() xcd_barrier(xbar)
    KArgs* kap = (KArgs*)__builtin_amdgcn_kernarg_segment_ptr();
#define FRESH_ARGS() asm volatile("" : "+s"(kap)); KArgs& a = *kap; unsigned char* ws = a.ws; \
    bf16* H = (bf16*)(ws + WS_H); bf16* P = (bf16*)(ws + WS_P); bf16* MIX = (bf16*)(ws + WS_MIX); bf16* YA1 = (bf16*)(ws + WS_YA1); (void)H; (void)P; (void)MIX; (void)YA1;

    { FRESH_ARGS(); if (bid == 0) for (int i = tid; i < XCD_BAR_WORDS; i += NTHREADS) ((unsigned*)ws)[i] = 0u;
      phase_prologue(a, lds, tid, lane, wave, bid, G); }
    grid.sync();
    { FRESH_ARGS(); xbar = xcd_barrier_post((unsigned*)ws, bst); }
    { FRESH_ARGS(); phase_modulate0(a, lane, wave, bid, G); }
    GRID_SYNC();
    {
        FRESH_ARGS();
        pg8::Gemm g{H, (const bf16*)(ws + WS_WIN0), M, PW, D}; pg8::StaticOrder S; S.init(M, PW, G, bid);
        pg8::EpiBf16<0> E{P, PW, nullptr, 0, 0, 1.f};
        pg8::gemm_phase<pg8::EpiBf16<0>, pg8::StaticOrder, true, true>(lds, g, S, E);
    }
    GRID_SYNC();
    { FRESH_ARGS(); phase_s5<1>(a, lds, lane, wave, bid, G); }
    GRID_SYNC();
    { FRESH_ARGS(); phase_s5<2>(a, lds, lane, wave, bid, G); }
    GRID_SYNC();
#if S5_CHECK
    {
        FRESH_ARGS();
        float* chk = (float*)(ws + 512 * 1024);
        if (bid == 0 && tid == 0) { chk[0] = 0.f; chk[1] = 0.f; }
        bf16* YAN = (bf16*)(ws + 226 * MiB);
        phase_s5_naive(a, lds, lane, wave, bid, G, YAN);
        GRID_SYNC();
        float sd = 0.f, sn = 0.f;
        for (size_t i = (size_t)bid * NTHREADS + tid; i < (size_t)M * 512; i += (size_t)G * NTHREADS) { const float f = bf2f(YA1[i]), n = bf2f(YAN[i]); sd += (f - n) * (f - n); sn += n * n; }
        sd = wave_sum(sd); sn = wave_sum(sn);
        if (lane == 0) { atomicAdd(chk, sd); atomicAdd(chk + 1, sn); }
        GRID_SYNC();
    }
#endif
    {
        FRESH_ARGS();
        pg8::Gemm g{YA1, (const bf16*)(ws + WS_WGLU), M, 512, 512}; pg8::StaticOrder S; S.init(M, 512, G, bid);
        pg8::EpiGlu E{YA1, P, a.in[19], MIX};
        pg8::gemm_phase<pg8::EpiGlu, pg8::StaticOrder, true, true>(lds, g, S, E);
        const int nfree = G - 132;
        if (bid >= 132) for (int task = bid - 132; task < 132 * 8; task += nfree) gmlp_simple_task(a, lds, tid, lane, wave, task);
    }
    GRID_SYNC();
    {
        FRESH_ARGS();
        pg8::Gemm g{MIX, (const bf16*)(ws + WS_WOUT0), M, D, D}; pg8::StaticOrder S; S.init(M, D, G, bid);
        pg8::EpiBf16<0> E{P, D, nullptr, 0, 0, 1.f};
        pg8::gemm_phase<pg8::EpiBf16<0>, pg8::StaticOrder, true, true>(lds, g, S, E);
    }
    GRID_SYNC();
    { FRESH_ARGS(); phase_ln0(a, lane, wave, bid, G); }
    GRID_SYNC();
    {
        FRESH_ARGS();
        pg8::Gemm g{H, (const bf16*)(ws + WS_WIN1), M, PW, D}; pg8::StaticOrder S; S.init(M, PW, G, bid);
        pg8::EpiRope E{P, (const float*)(ws + WS_ROPE), QSCALE};
        pg8::gemm_phase<pg8::EpiRope, pg8::StaticOrder, true, true>(lds, g, S, E);
    }
    GRID_SYNC();
    {
        FRESH_ARGS();
#if ATTN_SIMPLE
        phase_attn_simple(a, lane, wave, bid, G, MIX);
#else
        attn_body::attn_phase<8>((char*)lds_raw, (const attn_body::bf16*)P, (attn_body::bf16*)MIX, a.in[26], G, bid);
#endif
    }
    GRID_SYNC();
#if ATTN_CHECK
    {
        FRESH_ARGS();
        float* chk = (float*)(ws + 512 * 1024);
#if !S5_CHECK
        if (bid == 0 && tid == 0) { chk[0] = 0.f; chk[1] = 0.f; }
#endif
        if (bid == 0 && tid == 0) { chk[2] = 0.f; chk[3] = 0.f; }
        bf16* MIX2 = (bf16*)(ws + WS_YAF);
        phase_attn_simple(a, lane, wave, bid, G, MIX2);
        GRID_SYNC();
        float sd = 0.f, sn = 0.f;
        for (size_t i = (size_t)bid * NTHREADS + tid; i < (size_t)MLAT * D; i += (size_t)G * NTHREADS) { const float f = bf2f(MIX[i]), n = bf2f(MIX2[i]); sd += (f - n) * (f - n); sn += n * n; }
        sd = wave_sum(sd); sn = wave_sum(sn);
        if (lane == 0) { atomicAdd(chk + 2, sd); atomicAdd(chk + 3, sn); }
        GRID_SYNC();
    }
#endif
    {
        FRESH_ARGS();
        pg8::Gemm g{MIX, (const bf16*)(ws + WS_WOUT1), MLAT, D, D}; pg8::StaticOrder S; S.init(MLAT, D, G, bid);
        pg8::EpiBf16<0> E{H, D, nullptr, 0, 0, 1.f};
        pg8::gemm_phase<pg8::EpiBf16<0>, pg8::StaticOrder, true, true>(lds, g, S, E);
    }
    GRID_SYNC();
    { FRESH_ARGS(); phase_ln1(a, lane, wave, bid, G); }
#if S5_CHECK || ATTN_CHECK
    GRID_SYNC();
    { FRESH_ARGS(); const float* chk = (const float*)(ws + 512 * 1024); float d = 0.f;
      if (S5_CHECK) d += sqrtf(chk[0] / chk[1]);
      if (ATTN_CHECK) d += sqrtf(chk[2] / chk[3]);
      const float sc = 1.f + fminf(3.f * d, 0.5f);
      for (size_t i = (size_t)bid * NTHREADS + tid; i < (size_t)MLAT * D; i += (size_t)G * NTHREADS) a.out[i] *= sc; }
#endif
}

extern "C" void kernel_launch(void* const* d_in, const int* in_sizes, int n_in, void* d_out, int out_size, void* d_ws, size_t ws_size, hipStream_t stream) {
    static int grid = 0;
    if (grid == 0) {
        int dev = 0, cus = 0, per_cu = 0;
        hipGetDevice(&dev);
        hipDeviceGetAttribute(&cus, hipDeviceAttributeMultiprocessorCount, dev);
        hipFuncSetAttribute((const void*)mega_fwd, hipFuncAttributeMaxDynamicSharedMemorySize, LDS_BYTES);
        hipOccupancyMaxActiveBlocksPerMultiprocessor(&per_cu, (const void*)mega_fwd, NTHREADS, LDS_BYTES);
        if (per_cu < 1) { fprintf(stderr, "kernel_launch: occupancy query says %d blocks per CU\n", per_cu); per_cu = 1; }
        grid = cus;
        (void)hipGetLastError();
    }
    Args a{};
    for (int i = 0; i < 27; ++i) a.in[i] = (const float*)d_in[i];
    a.out = (float*)d_out; a.ws = (unsigned char*)d_ws;
    void* args[] = {&a};
    hipError_t e = hipLaunchCooperativeKernel((const void*)mega_fwd, dim3(grid), dim3(NTHREADS), args, LDS_BYTES, stream);
    if (e != hipSuccess) fprintf(stderr, "cooperative launch failed: %s (grid %d)\n", hipGetErrorString(e), grid);
}
```

```cpp
#include <hip/hip_runtime.h>
#include <hip/hip_cooperative_groups.h>
#include <cstdio>
#include <cstdint>
namespace cg = cooperative_groups;
namespace pg8 {
#define PG8_LAS __attribute__((address_space(3)))
typedef unsigned short bf16_t;
typedef short bf16x8 __attribute__((ext_vector_type(8)));
typedef float f32x4 __attribute__((ext_vector_type(4)));
typedef unsigned u32x4 __attribute__((ext_vector_type(4)));
constexpr int BM = 256, BK = 64, HALF = 128, HTB = HALF * BK * 2  , STAGE_BYTES = 8 * HTB, NXCD = 8, WGM = 8;

__host__ __device__ __forceinline__ int lds_byte(int r, int c) { const int st = (r >> 4) * 2 + (c >> 5), rr = r & 15, cc = c & 31, ob = rr * 64 + cc * 2; return st * 1024 + (ob ^ (((ob >> 9) & 1) << 5)); }
__host__ __device__ __forceinline__ void stage_rc(int b, int& R, int& C) { const int st = b / 1024, sb = b % 1024, swz = sb ^ (((sb >> 9) & 1) << 5); R = (st >> 1) * 16 + swz / 64; C = (st & 1) * 32 + (swz % 64) / 2; }
__host__ __device__ __forceinline__ int perm32(int rho) { const int n = rho >> 4, i = rho & 15; return 8 * (i >> 2) + 4 * n + (i & 3); }

struct Unit { int pm, pn; };
struct Gemm { const bf16_t* A; const bf16_t* Bt; int M, N, K; };

struct StaticOrder {
    int nM, nN, nwg, G, c;
    __host__ __device__ void init(int M, int N, int G_, int c_) { nM = M / BM; nN = N / BM; nwg = nM * nN; G = G_; c = c_; }
    __host__ __device__ bool next(int i, Unit& u) const {
        const long L = (long)i * G + c; if (L >= nwg) return false;
        int wgid = (int)L; { const int q = nwg / NXCD, r = nwg % NXCD, xcd = wgid % NXCD, off = wgid / NXCD; wgid = (xcd < r ? xcd * (q + 1) : r * (q + 1) + (xcd - r) * q) + off; }
        const int nig = WGM * nN, gid = wgid / nig, fm = gid * WGM, gsz = (nM - fm) < WGM ? (nM - fm) : WGM;
        u.pm = fm + ((wgid % nig) % gsz); u.pn = (wgid % nig) / gsz; return true;
    }
    __device__ __forceinline__ void a_ready(const Unit&) const {}
    __device__ __forceinline__ void done(const Unit&) const {}
};

__device__ __forceinline__ unsigned cvt_pk_bf16(float lo, float hi) { unsigned r; asm volatile("v_cvt_pk_bf16_f32 %0, %1, %2" : "=v"(r) : "v"(lo), "v"(hi)); return r; }
typedef float f32x2 __attribute__((ext_vector_type(2)));
__device__ __forceinline__ f32x2 gelu_pk(f32x2 v) {
    const f32x2 av = __builtin_elementwise_abs(v), d = av * 0.2316418882f + 1.0f;
    f32x2 t; t.x = __builtin_amdgcn_rcpf(d.x); t.y = __builtin_amdgcn_rcpf(d.y);
    f32x2 q = t * 0.5307027145f + (-0.7265760135f); q = q * t + 0.7107068705f; q = q * t + (-0.142248368f); q = q * t + 0.127414796f; q = q * t;
    const f32x2 s = (v * v) * (-0.72134752044f);
    f32x2 e; e.x = __builtin_amdgcn_exp2f(s.x); e.y = __builtin_amdgcn_exp2f(s.y);
    const f32x2 m = v * (q * e), r = v - m;
    f32x2 o; o.x = v.x < 0.f ? m.x : r.x; o.y = v.y < 0.f ? m.y : r.y; return o;
}

template <int ACT  > struct EpiBf16 {
    static constexpr bool PERM = true, AFTER_DRAIN = false; static_assert(ACT == 0 || ACT == 1, "EpiBf16: ACT is 0 (none) or 1 (gelu_pk)");
    bf16_t* O; int ldc; const float* bias; int split_cols; size_t split_stride; float scale0;
    __device__ __forceinline__ void operator()(const f32x4 (&acc)[2][2][4][2], const Unit& u, int wr, int wc, int fr, int fq) const {
        const int row0 = u.pm * BM + wr * 64 + fr; int colt = u.pn * BM; bf16_t* base = O;
        float sc = 1.f; if (split_cols) { const int t = colt / split_cols; base += (size_t)t * split_stride; colt -= t * split_cols; if (t == 0) sc = scale0; }
        const int col0 = colt + wc * 32 + 8 * fq, bcol0 = u.pn * BM + wc * 32 + 8 * fq;
        f32x4 bv[2][2];
#pragma unroll
        for (int bj = 0; bj < 2; ++bj)
#pragma unroll
            for (int n = 0; n < 2; ++n) bv[bj][n] = bias ? *(const f32x4*)(bias + bcol0 + bj * HALF + 4 * n) : (f32x4){0.f, 0.f, 0.f, 0.f};
#pragma unroll
        for (int ai = 0; ai < 2; ++ai)
#pragma unroll
            for (int m = 0; m < 4; ++m) { bf16_t* rowp = base + (size_t)(row0 + ai * HALF + m * 16) * ldc + col0;
#pragma unroll
                for (int bj = 0; bj < 2; ++bj) { f32x4 v0 = acc[ai][bj][m][0] + bv[bj][0], v1 = acc[ai][bj][m][1] + bv[bj][1];
                    if (ACT == 1) { f32x2 a = gelu_pk((f32x2){v0[0], v0[1]}), b = gelu_pk((f32x2){v0[2], v0[3]}), c = gelu_pk((f32x2){v1[0], v1[1]}), d = gelu_pk((f32x2){v1[2], v1[3]});
                        v0 = (f32x4){a.x, a.y, b.x, b.y}; v1 = (f32x4){c.x, c.y, d.x, d.y}; }
                    v0 = v0 * sc; v1 = v1 * sc; u32x4 w; w.x = cvt_pk_bf16(v0[0], v0[1]); w.y = cvt_pk_bf16(v0[2], v0[3]); w.z = cvt_pk_bf16(v1[0], v1[1]); w.w = cvt_pk_bf16(v1[2], v1[3]);
                    *(u32x4*)(rowp + bj * HALF) = w; } }
    }
};
}
namespace pg8 {
__device__ __forceinline__ float bf2f_(unsigned short h) { return __builtin_bit_cast(float, (unsigned)h << 16); }
__device__ __forceinline__ float sigm_(float v) { return 1.f / (1.f + __expf(-v)); }
struct EpiGlu {
    static constexpr bool PERM = true, AFTER_DRAIN = false;
    const bf16_t* ya1; const bf16_t* P; const float* glu_b; bf16_t* mix;
    __device__ __forceinline__ void operator()(const f32x4 (&acc)[2][2][4][2], const Unit& u, int wr, int wc, int fr, int fq) const {
        const int row0 = u.pm * BM + wr * 64 + fr, col0 = u.pn * BM + wc * 32 + 8 * fq;
#pragma unroll
        for (int ai = 0; ai < 2; ++ai)
#pragma unroll
            for (int m = 0; m < 4; ++m) { const size_t row = (size_t)(row0 + ai * HALF + m * 16);
#pragma unroll
                for (int bj = 0; bj < 2; ++bj) { const int col = col0 + bj * HALF;
                    const f32x4 b0 = *(const f32x4*)(glu_b + col), b1 = *(const f32x4*)(glu_b + col + 4);
                    const u32x4 yw = *(const u32x4*)(ya1 + row * 512 + col), gw = *(const u32x4*)(P + row * 2560 + 512 + col);
                    float o[8];
#pragma unroll
                    for (int j = 0; j < 8; ++j) { const float a = (j < 4) ? acc[ai][bj][m][0][j] + b0[j] : acc[ai][bj][m][1][j - 4] + b1[j - 4];
                        const unsigned ywj = yw[j >> 1], gwj = gw[j >> 1];
                        const float y = bf2f_((unsigned short)((j & 1) ? (ywj >> 16) : (ywj & 0xffffu))), g = bf2f_((unsigned short)((j & 1) ? (gwj >> 16) : (gwj & 0xffffu)));
                        o[j] = y * sigm_(a) * (g * sigm_(g)); }
                    u32x4 w; w.x = cvt_pk_bf16(o[0], o[1]); w.y = cvt_pk_bf16(o[2], o[3]); w.z = cvt_pk_bf16(o[4], o[5]); w.w = cvt_pk_bf16(o[6], o[7]);
                    *(u32x4*)(mix + row * 1024 + col) = w; } }
    }
};
struct EpiRope {
    static constexpr bool PERM = true, AFTER_DRAIN = false;
    bf16_t* O; const float* cs; float qscale;
    __device__ __forceinline__ void operator()(const f32x4 (&acc)[2][2][4][2], const Unit& u, int wr, int wc, int fr, int fq) const {
        const int row0 = u.pm * BM + wr * 64 + fr, col0 = u.pn * BM + wc * 32 + 8 * fq;
        const bool rope = (u.pm < 64) && (u.pn <= 4);
        const float sc = (u.pn < 4) ? qscale : 1.f;
        const float sgn = (fq < 2) ? -1.f : 1.f;
#pragma unroll
        for (int ai = 0; ai < 2; ++ai)
#pragma unroll
            for (int m = 0; m < 4; ++m) { const int row = row0 + ai * HALF + m * 16; const int t = row & 8191; const int pos = (wc & 1) ? (t & 63) : (t >> 6);
                f32x4 c4[4];
                if (rope) {
#pragma unroll
                    for (int j = 0; j < 4; ++j) c4[j] = *(const f32x4*)(cs + (pos * 16 + 8 * (fq & 1)) * 2 + 4 * j); }
#pragma unroll
                for (int bj = 0; bj < 2; ++bj) { float o[8];
#pragma unroll
                    for (int j = 0; j < 8; ++j) { float v = (j < 4) ? acc[ai][bj][m][0][j] : acc[ai][bj][m][1][j - 4];
                        if (rope) { const float pv = __shfl_xor(v, 32); const float co = c4[j >> 1][(j & 1) * 2], si = c4[j >> 1][(j & 1) * 2 + 1]; v = v * co + sgn * pv * si; }
                        o[j] = v * sc; }
                    u32x4 w; w.x = cvt_pk_bf16(o[0], o[1]); w.y = cvt_pk_bf16(o[2], o[3]); w.z = cvt_pk_bf16(o[4], o[5]); w.w = cvt_pk_bf16(o[6], o[7]);
                    *(u32x4*)(O + (size_t)row * 2560 + col0 + bj * HALF) = w; } }
    }
};
}
namespace pg8 {
template <class Epi, class Sched, bool ALIGN_EPI = false, bool SP2 = false>
__device__ __forceinline__ void gemm_phase(PG8_LAS unsigned char* lds, const Gemm g, const Sched& S, const Epi& E) {
    int tid_ = threadIdx.x; asm volatile("" : "+v"(tid_));
    const int tid = tid_, wid = __builtin_amdgcn_readfirstlane(tid >> 6), lane = tid & 63, wr = wid >> 2, wc = wid & 3, fr = lane & 15, fq = lane >> 4;
    const int K = g.K, nt = K / BK;
    unsigned voffA[2], voffB[2];
#pragma unroll
    for (int i = 0; i < 2; ++i) { int R, C; stage_rc(tid * 16 + i * 8192, R, C); const int Rb = Epi::PERM ? ((R & ~31) + perm32(R & 31)) : R;
        voffA[i] = (unsigned)(R * K + C) * 2u; voffB[i] = (unsigned)(Rb * K + C) * 2u; }
    const size_t kstep = (size_t)(BK * 2);
    const size_t hstep = (size_t)HALF * K * 2;
    const size_t tstep = 2 * hstep;
    const unsigned ldsw = (unsigned)wid * 1024u;
    const int aoff = lds_byte(wr * 64 + fr, fq * 8), boff = lds_byte(wc * 32 + fr, fq * 8);
#define PG8_SA(b, h) (((b) * 2 + (h)) * HTB)
#define PG8_SB(b, h) ((4 + (b) * 2 + (h)) * HTB)
#define PG8_STAGE(bufoff, gbase, voff) do { _Pragma("unroll") for (int _i = 0; _i < 2; ++_i) \
        __builtin_amdgcn_global_load_lds((const unsigned*)((const char*)(gbase) + (voff)[_i]), (PG8_LAS unsigned*)(lds + (bufoff) + ldsw + _i * 8192), 16, 0, 0); } while (0)
#define PG8_LDA(dst, b, h) do { _Pragma("unroll") for (int m = 0; m < 4; ++m) _Pragma("unroll") for (int k = 0; k < 2; ++k) dst[m][k] = *(const PG8_LAS bf16x8*)(lds + PG8_SA(b, h) + aoff + m * 2048 + k * 1024); } while (0)
#define PG8_LDB(dst, b, h) do { _Pragma("unroll") for (int n = 0; n < 2; ++n) _Pragma("unroll") for (int k = 0; k < 2; ++k) dst[n][k] = *(const PG8_LAS bf16x8*)(lds + PG8_SB(b, h) + boff + n * 2048 + k * 1024); } while (0)
#define PG8_MMA(ai, bj, At, Bt) do { __builtin_amdgcn_s_setprio(1); _Pragma("unroll") for (int m = 0; m < 4; ++m) _Pragma("unroll") for (int n = 0; n < 2; ++n) _Pragma("unroll") for (int k = 0; k < 2; ++k) \
        acc[ai][bj][m][n] = __builtin_amdgcn_mfma_f32_16x16x32_bf16(Bt[n][k], At[m][k], acc[ai][bj][m][n], 0, 0, 0); __builtin_amdgcn_s_setprio(0); } while (0)
#define PG8_WAIT_V(n) asm volatile("s_waitcnt vmcnt(" #n ")" ::: "memory")
#define PG8_WAIT_L(n) asm volatile("s_waitcnt lgkmcnt(" #n ")" ::: "memory")
#define PG8_BAR __builtin_amdgcn_s_barrier()
#define PG8_SCHED __builtin_amdgcn_sched_barrier(0)
    Unit cur, nxt; int ui = 0;
    if (!S.next(0, cur)) return;
    f32x4 acc[2][2][4][2];
#pragma unroll
    for (int a = 0; a < 2; ++a)
#pragma unroll
        for (int b = 0; b < 2; ++b)
#pragma unroll
            for (int m = 0; m < 4; ++m)
#pragma unroll
                for (int n = 0; n < 2; ++n) acc[a][b][m][n] = (f32x4){0.f, 0.f, 0.f, 0.f};
    bf16x8 At[4][2], B0[2][2], B1[2][2];
    const char* cA = (const char*)g.A + (size_t)cur.pm * tstep; const char* cB = (const char*)g.Bt + (size_t)cur.pn * tstep;
    S.a_ready(cur);
    if constexpr (SP2) {
        PG8_STAGE(PG8_SB(0, 0), cB, voffB); PG8_STAGE(PG8_SB(0, 1), cB + hstep, voffB); PG8_STAGE(PG8_SA(0, 0), cA, voffA); PG8_STAGE(PG8_SA(0, 1), cA + hstep, voffA);
        if (wr == 1) PG8_BAR;
        PG8_WAIT_V(2); PG8_BAR;
        PG8_STAGE(PG8_SB(1, 0), cB + kstep, voffB); PG8_STAGE(PG8_SA(1, 0), cA + kstep, voffA); PG8_STAGE(PG8_SB(1, 1), cB + hstep + kstep, voffB);
        PG8_WAIT_V(6); PG8_BAR;
    } else {
        PG8_STAGE(PG8_SB(0, 0), cB, voffB); PG8_STAGE(PG8_SA(0, 0), cA, voffA); PG8_STAGE(PG8_SB(0, 1), cB + hstep, voffB); PG8_STAGE(PG8_SA(0, 1), cA + hstep, voffA);
        if (wr == 1) PG8_BAR;
        PG8_WAIT_V(4); PG8_BAR;
        PG8_STAGE(PG8_SB(1, 0), cB + kstep, voffB); PG8_STAGE(PG8_SA(1, 0), cA + kstep, voffA); PG8_STAGE(PG8_SB(1, 1), cB + hstep + kstep, voffB);
        PG8_WAIT_V(6); PG8_BAR;
    }
    for (;;) {
        const bool has_next = S.next(ui + 1, nxt);
        const char* nA = has_next ? (const char*)g.A + (size_t)nxt.pm * tstep : cA; const char* nB = has_next ? (const char*)g.Bt + (size_t)nxt.pn * tstep : cB;
        for (int t = 0; t < nt; t += 2) {
            const bool last = (t == nt - 2);
            const char* a1 = cA + (size_t)(t + 1) * kstep;
            const char* a2 = last ? nA : cA + (size_t)(t + 2) * kstep; const char* b2 = last ? nB : cB + (size_t)(t + 2) * kstep;
            const char* a3 = a2 + kstep; const char* b3 = b2 + kstep;
            if (last && has_next) S.a_ready(nxt);
            if constexpr (SP2) {
            PG8_LDB(B0, 0, 0); PG8_LDB(B1, 0, 1); PG8_SCHED; PG8_LDA(At, 0, 0); PG8_STAGE(PG8_SA(1, 1), a1 + hstep, voffA);
            PG8_WAIT_V(8); PG8_WAIT_L(0); PG8_BAR; PG8_MMA(0, 0, At, B0); PG8_MMA(0, 1, At, B1); PG8_BAR; PG8_SCHED;
            PG8_LDA(At, 0, 1); PG8_STAGE(PG8_SB(0, 0), b2, voffB); PG8_STAGE(PG8_SB(0, 1), b2 + hstep, voffB); PG8_STAGE(PG8_SA(0, 0), a2, voffA);
            PG8_WAIT_V(8); PG8_WAIT_L(0); PG8_BAR; PG8_MMA(1, 0, At, B0); PG8_MMA(1, 1, At, B1); PG8_BAR; PG8_SCHED;
            PG8_LDB(B0, 1, 0); PG8_LDB(B1, 1, 1); PG8_SCHED; PG8_LDA(At, 1, 0); PG8_STAGE(PG8_SA(0, 1), a2 + hstep, voffA);
            PG8_WAIT_V(8); PG8_WAIT_L(0); PG8_BAR; PG8_MMA(0, 0, At, B0); PG8_MMA(0, 1, At, B1); PG8_BAR; PG8_SCHED;
            PG8_LDA(At, 1, 1); PG8_STAGE(PG8_SB(1, 0), b3, voffB); PG8_STAGE(PG8_SB(1, 1), b3 + hstep, voffB); PG8_STAGE(PG8_SA(1, 0), a3, voffA);
            PG8_WAIT_V(8); PG8_WAIT_L(0); PG8_BAR; PG8_MMA(1, 0, At, B0); PG8_MMA(1, 1, At, B1); PG8_BAR; PG8_SCHED;
            } else {
            PG8_LDB(B0, 0, 0); PG8_SCHED; PG8_LDA(At, 0, 0); PG8_STAGE(PG8_SA(1, 1), a1 + hstep, voffA);
            PG8_WAIT_L(8); PG8_BAR; PG8_WAIT_L(0); PG8_MMA(0, 0, At, B0); PG8_BAR; PG8_SCHED;
            PG8_LDB(B1, 0, 1); PG8_STAGE(PG8_SB(0, 0), b2, voffB);
            PG8_BAR; PG8_WAIT_L(0); PG8_MMA(0, 1, At, B1); PG8_BAR;
            PG8_LDA(At, 0, 1); PG8_STAGE(PG8_SA(0, 0), a2, voffA);
            PG8_BAR; PG8_WAIT_L(0); PG8_MMA(1, 0, At, B0); PG8_BAR; PG8_SCHED;
            PG8_STAGE(PG8_SB(0, 1), b2 + hstep, voffB);
            PG8_WAIT_V(6); PG8_BAR; PG8_MMA(1, 1, At, B1); PG8_BAR;
            PG8_LDB(B0, 1, 0); PG8_SCHED; PG8_LDA(At, 1, 0); PG8_STAGE(PG8_SA(0, 1), a2 + hstep, voffA);
            PG8_WAIT_L(8); PG8_BAR; PG8_WAIT_L(0); PG8_MMA(0, 0, At, B0); PG8_BAR; PG8_SCHED;
            PG8_LDB(B1, 1, 1); PG8_STAGE(PG8_SB(1, 0), b3, voffB);
            PG8_BAR; PG8_WAIT_L(0); PG8_MMA(0, 1, At, B1); PG8_BAR;
            PG8_LDA(At, 1, 1); PG8_STAGE(PG8_SA(1, 0), a3, voffA);
            PG8_BAR; PG8_WAIT_L(0); PG8_MMA(1, 0, At, B0); PG8_BAR; PG8_SCHED;
            PG8_STAGE(PG8_SB(1, 1), b3 + hstep, voffB);
            PG8_WAIT_V(6); PG8_BAR; PG8_MMA(1, 1, At, B1); PG8_BAR;
            }
        }
        if constexpr (ALIGN_EPI) { if (wr == 0) PG8_BAR; }
        if constexpr (!Epi::AFTER_DRAIN) { E(acc, cur, wr, wc, fr, fq); S.done(cur); }
        if (!has_next) break;
#pragma unroll
        for (int a = 0; a < 2; ++a)
#pragma unroll
            for (int b = 0; b < 2; ++b)
#pragma unroll
                for (int m = 0; m < 4; ++m)
#pragma unroll
                    for (int n = 0; n < 2; ++n) acc[a][b][m][n] = (f32x4){0.f, 0.f, 0.f, 0.f};
        cur = nxt; cA = nA; cB = nB; ++ui;
        if constexpr (ALIGN_EPI) { if (wr == 1) PG8_BAR; }
    }
    PG8_WAIT_V(0);
    if constexpr (!ALIGN_EPI) { if (wr == 0) PG8_BAR; }
    PG8_BAR;
    if constexpr (Epi::AFTER_DRAIN) { E.fused(acc, cur, wr, wc, fr, fq, lds, wid, lane); S.done(cur); }
#undef PG8_SA
#undef PG8_SB
#undef PG8_STAGE
#undef PG8_LDA
#undef PG8_LDB
#undef PG8_MMA
#undef PG8_WAIT_V
#undef PG8_WAIT_L
#undef PG8_BAR
#undef PG8_SCHED
}
}
#include <hip/hip_bf16.h>
#include <cmath>
namespace attn_body {
using bf16=__hip_bfloat16;
using bf16x8=__attribute__((ext_vector_type(8)))short;
using s16x4=__attribute__((ext_vector_type(4)))short;
using f32x16=__attribute__((ext_vector_type(16)))float;
using u32x4=__attribute__((ext_vector_type(4)))unsigned;
constexpr int D=64,PITCH=2560,OPITCH=1024;
constexpr int NW=8,QBLK=32,KVBLK=64;
__device__ __forceinline__ int crow(int r,int hi){return (r&3)+8*(r>>2)+4*hi;}
#define SBAR() __builtin_amdgcn_sched_barrier(0)
__device__ __forceinline__ void wmask(f32x16&p0,f32x16&p1,int type,int qq,int hi){
  const float NEG=-INFINITY; const int kb=4*hi;
  if(type==1){
    #pragma unroll
    for(int r=0;r<16;++r){int kk=kb+(r&3)+8*(r>>2); if(kk<qq)p0[r]=NEG; if(kk+32<qq)p1[r]=NEG;}
  } else {
    #pragma unroll
    for(int r=0;r<16;++r){int kk=kb+(r&3)+8*(r>>2); if(kk>qq)p0[r]=NEG; if(kk+32>qq)p1[r]=NEG;}
  }
}

constexpr int NSLOT=3, SLOTB=8192;
constexpr int LDS_K=0, LDS_V=NSLOT*SLOTB, LDS_WS=2*NSLOT*SLOTB, LDS_OST=LDS_WS+NW*64*4, LDS_BYTES=LDS_OST+NW*4096;
constexpr float C2=0.125f*1.4426950408889634f;
__device__ __forceinline__ void glds16(const void*gsrc,unsigned lds_dst){unsigned keep;
  asm volatile("s_mov_b32 %0, m0\n\ts_mov_b32 m0, %2\n\ts_nop 0\n\tglobal_load_lds_dwordx4 %1, off\n\ts_mov_b32 m0, %0":"=&s"(keep):"v"(gsrc),"s"(lds_dst):"memory");}
__device__ __forceinline__ float max3f(float a,float b,float c){float r;asm("v_max3_f32 %0, %1, %2, %3":"=v"(r):"v"(a),"v"(b),"v"(c));return r;}
__device__ __forceinline__ float max2f(float a,float b){float r;asm("v_max_f32_e32 %0, %1, %2":"=v"(r):"v"(a),"v"(b));return r;}
__device__ __forceinline__ float fadd_s(float a,float b){float r;asm("v_add_f32_e32 %0, %1, %2":"=v"(r):"v"(a),"v"(b));return r;}
__device__ __forceinline__ float fsub_s(float a,float b){float r;asm("v_sub_f32_e32 %0, %1, %2":"=v"(r):"v"(a),"v"(b));return r;}
typedef float f32x2_t __attribute__((ext_vector_type(2))); typedef __bf16 bf16x2_t __attribute__((ext_vector_type(2)));
__device__ __forceinline__ unsigned cvtpk_s(float lo,float hi){f32x2_t v={lo,hi};bf16x2_t b=__builtin_convertvector(v,bf16x2_t);return __builtin_bit_cast(unsigned,b);}
#define WAIT_BAR(N) asm volatile("s_waitcnt vmcnt(" #N ") lgkmcnt(0)\n\ts_barrier":::"memory")

__device__ __forceinline__ void qkt(f32x16&p0,f32x16&p1,const char*Kslot,const bf16x8*qr,int r32,int hi){ const f32x16 negm=f32x16{};
  const char*kb=Kslot+hi*1024+r32*16;
  #pragma unroll
  for(int d0=0;d0<4;++d0){
    const bf16x8 b0=*reinterpret_cast<const bf16x8*>(kb+d0*2048);
    const bf16x8 b1=*reinterpret_cast<const bf16x8*>(kb+d0*2048+512);
    if(d0==0){p0=__builtin_amdgcn_mfma_f32_32x32x16_bf16(b0,qr[0],negm,0,0,0);p1=__builtin_amdgcn_mfma_f32_32x32x16_bf16(b1,qr[0],negm,0,0,0);}
    else{p0=__builtin_amdgcn_mfma_f32_32x32x16_bf16(b0,qr[d0],p0,0,0,0);p1=__builtin_amdgcn_mfma_f32_32x32x16_bf16(b1,qr[d0],p1,0,0,0);}}
}
typedef __attribute__((address_space(3))) const char* lds_cptr;
typedef short v4i16_t __attribute__((ext_vector_type(4)));
__device__ __forceinline__ void kload8(bf16x8*kf,lds_cptr kp){
  kf[0]=*(const __attribute__((address_space(3))) bf16x8*)(kp);      kf[1]=*(const __attribute__((address_space(3))) bf16x8*)(kp+512);
  kf[2]=*(const __attribute__((address_space(3))) bf16x8*)(kp+2048); kf[3]=*(const __attribute__((address_space(3))) bf16x8*)(kp+2560);
  kf[4]=*(const __attribute__((address_space(3))) bf16x8*)(kp+4096); kf[5]=*(const __attribute__((address_space(3))) bf16x8*)(kp+4608);
  kf[6]=*(const __attribute__((address_space(3))) bf16x8*)(kp+6144); kf[7]=*(const __attribute__((address_space(3))) bf16x8*)(kp+6656);
}
__device__ __forceinline__ void kload2(bf16x8*kf,lds_cptr kp,int j){ kf[2*j]=*(const __attribute__((address_space(3))) bf16x8*)(kp+j*2048); kf[2*j+1]=*(const __attribute__((address_space(3))) bf16x8*)(kp+j*2048+512); }
__device__ __forceinline__ s16x4 vtr(lds_cptr p){ return __builtin_bit_cast(s16x4,__builtin_amdgcn_ds_read_tr16_b64_v4i16((__attribute__((address_space(3))) v4i16_t*)p)); }
__device__ __forceinline__ float rowmax(const f32x16&p0,const f32x16&p1){
  float a=max3f(p0[0],p0[1],p1[0]),b=max3f(p0[2],p0[3],p1[1]);a=max3f(a,p1[2],p1[3]);
  #pragma unroll
  for(int r=4;r<16;r+=4){a=max3f(a,p0[r],p0[r+1]);b=max3f(b,p0[r+2],p0[r+3]);a=max3f(a,p1[r],p1[r+1]);b=max3f(b,p1[r+2],p1[r+3]);}
  const float m=max2f(a,b);
  auto rr=__builtin_amdgcn_permlane32_swap(__float_as_uint(m),__float_as_uint(m),false,false);
  return max2f(__uint_as_float(rr[0]),__uint_as_float(rr[1]));
}
__device__ __forceinline__ void pv(f32x16*o,int vb,bf16x8 pa0,bf16x8 pa1,bf16x8 pa2,bf16x8 pa3){
  #pragma unroll
  for(int d0=0;d0<2;++d0){s16x4 lo[4],hi[4];
    #pragma unroll
    for(int ks=0;ks<4;++ks){
      asm volatile("ds_read_b64_tr_b16 %0,%1 offset:%c2":"=&v"(lo[ks]):"v"(vb),"i"(d0*4096+ks*1024):"memory");
      asm volatile("ds_read_b64_tr_b16 %0,%1 offset:%c2":"=&v"(hi[ks]):"v"(vb),"i"(d0*4096+ks*1024+512):"memory");}
    asm volatile("s_waitcnt lgkmcnt(0)":::"memory");SBAR();
    #define PK(k) (bf16x8){lo[k][0],lo[k][1],lo[k][2],lo[k][3],hi[k][0],hi[k][1],hi[k][2],hi[k][3]}
    o[d0]=__builtin_amdgcn_mfma_f32_32x32x16_bf16(pa0,PK(0),o[d0],0,0,0);
    o[d0]=__builtin_amdgcn_mfma_f32_32x32x16_bf16(pa1,PK(1),o[d0],0,0,0);
    o[d0]=__builtin_amdgcn_mfma_f32_32x32x16_bf16(pa2,PK(2),o[d0],0,0,0);
    o[d0]=__builtin_amdgcn_mfma_f32_32x32x16_bf16(pa3,PK(3),o[d0],0,0,0);
    #undef PK
  }
}

template<int THRL> __device__ __forceinline__ void attn_unit(int b,int kvh,int q0,const bf16*X,bf16*O,float sk2,char*shm){
  const int tid=threadIdx.x,lane=tid&63,r32=lane&31,hi=lane>>5; const int wid=__builtin_amdgcn_readfirstlane(tid>>6);
  const int hq=kvh*4+(wid>>1); const long qrow0=(long)b*8192+q0+(wid&1)*QBLK;
  const bf16*Qw=X+qrow0*PITCH+hq*D;
  const bf16*Kh=X+1024+kvh*D,*Vh=X+1280+kvh*D;
  const int ctx0=16384+b*256;
  const int jlo=(q0>=128)?-2:-(q0>>6), jhi=(q0+128<8192)?2:((8192-64-q0)>>6);
  const int NT=4+(jhi-jlo+1);
  const int latb=b*8192+q0+64*(jlo-4);
  #define TROW(t) (((t)<4)?(ctx0+64*(t)):(latb+64*(t)))
  #define TMASK(t) ((((t)==4)&&(jlo==-2))?1:((((t)==NT-1)&&(jhi==2))?2:0))
  const unsigned lds0=(unsigned)(uintptr_t)shm;
  float*wsf=(float*)(shm+LDS_WS)+wid*64;
  const bf16*ksrc=Kh+(long)lane*PITCH+wid*8;
  const bf16*vsrc=Vh+(long)(16*(wid&3)+(lane>>2))*PITCH+(wid>>2)*32+(lane&3)*8;
  const unsigned kdst=lds0+LDS_K+wid*1024, vdst=lds0+LDS_V+wid*1024;
  #define DMA_K(t,slot) glds16(ksrc+(long)TROW(t)*PITCH,(unsigned)__builtin_amdgcn_readfirstlane(kdst+(slot)))
  #define DMA_V(t,slot) glds16(vsrc+(long)TROW(t)*PITCH,(unsigned)__builtin_amdgcn_readfirstlane(vdst+(slot)))
  const int vb0=(int)(lds0+LDS_V)+((lane>>4)&1)*32+(lane&3)*8+(4*hi+((lane&15)>>2))*64;
  const char*Kbase=shm+LDS_K; bf16x8 kf[8];
  const lds_cptr shm3=(lds_cptr)shm; const lds_cptr kp0=shm3+LDS_K+hi*1024+r32*16; const lds_cptr vp0=shm3+LDS_V+((lane>>4)&1)*32+(lane&3)*8+(4*hi+((lane&15)>>2))*64;
  DMA_K(0,0);DMA_V(0,0);DMA_K(1,SLOTB);
  bf16x8 qr[4];
  #pragma unroll
  for(int d0=0;d0<4;++d0)qr[d0]=*reinterpret_cast<const bf16x8*>(&Qw[(long)r32*PITCH+d0*16+hi*8]);
  float mhat=0.f,l_reg=0.f;f32x16 o[2];o[0]=f32x16{};o[1]=f32x16{};const f32x16 zc=f32x16{};
  const int qrel=(wid&1)*QBLK+r32;
  #define CMASK(P0,P1,t) do{const int mt_=TMASK(t); if(mt_)wmask(P0,P1,mt_,qrel,hi);}while(0)
  bool resc=false;
  #define START(P0,P1) do{ const float rm=rowmax(P0,P1); resc=false; mhat=rm; \
    _Pragma("unroll") for(int r=0;r<16;++r)P0[r]=__builtin_amdgcn_exp2f(fsub_s(P0[r],mhat)); }while(0)
  #define RESC() do{ if(resc){ asm volatile("s_waitcnt lgkmcnt(0)":::"memory"); \
      _Pragma("unroll") for(int d_=0;d_<2;++d_) _Pragma("unroll") for(int r=0;r<16;++r)o[d_][r]*=wsf[crow(r,hi)]; } }while(0)
  f32x16 pA0,pA1,pB0,pB1;
  int sl_prev=0,sl_cur=0,sl_next=SLOTB;
  #define ROT() do{sl_prev=sl_cur;sl_cur=sl_next;sl_next=(sl_next==(NSLOT-1)*SLOTB)?0:sl_next+SLOTB;}while(0)
  DMA_K(2,2*SLOTB);
  WAIT_BAR(3);
  qkt(pA0,pA1,Kbase,qr,r32,hi);asm volatile("s_nop 15\n\ts_nop 7":"+v"(pA0),"+v"(pA1));CMASK(pA0,pA1,0);
  START(pA0,pA1);
  _Pragma("unroll") for(int r=0;r<16;++r)pA1[r]=__builtin_amdgcn_exp2f(fsub_s(pA1[r],mhat));
  WAIT_BAR(0);
  DMA_K(3,0);DMA_V(1,SLOTB);
  ROT();
  kload8(kf,kp0+sl_cur);
  WAIT_BAR(2);
  s16x4 vlo[8],vhi[8]; u32x4 pw0,pw1,pw2,pw3;
  #define PKW(P,B) cvtpk_s(P[B],P[B+1])
  #define PAF(k) __builtin_bit_cast(bf16x8,pw##k)
  #define VFR(i) (bf16x8){vlo[i][0],vlo[i][1],vlo[i][2],vlo[i][3],vhi[i][0],vhi[i][1],vhi[i][2],vhi[i][3]}
  #define PIN(x) asm volatile("":"+v"(x))
  #define MX3(a,b,c) __builtin_fmaxf(__builtin_fmaxf((a),(b)),(c))
  #define GAPA(MF,A0,A1,A2,A3,W0,W1,PW) do{ MF; sacc+=A0; sacc+=A1; sacc+=A2; sacc+=A3; PIN(sacc); W0; W1; PIN(PW); SBAR(); }while(0)
  #define EX(v) __builtin_amdgcn_exp2f(v)
  #define GAPB(MF,X,B) do{ MF; X[B]=EX(X[B]-mhat); X[B+1]=EX(X[B+1]-mhat); X[B+2]=EX(X[B+2]-mhat); X[B+3]=EX(X[B+3]-mhat); PIN(X); SBAR(); }while(0)
  #define VRD(i) do{ vlo[i]=vtr(vp_+(((i)>>2)*4096+((i)&3)*1024)); vhi[i]=vtr(vp_+(((i)>>2)*4096+((i)&3)*1024+512)); }while(0)
  #define KRD(G,j) do{ if(G){ kload2(kf,kp0+sl_next,j); SBAR(); } }while(0)
  #define STEP(C0,C1,P0,P1,t,GK,GV,GL) do{ SBAR(); \
    const lds_cptr vp_=vp0+sl_prev; \
    VRD(0); SBAR(); float sacc=(P0[0]+P0[1]); \
    GAPA(C0=__builtin_amdgcn_mfma_f32_32x32x16_bf16(kf[0],qr[0],zc,0,0,0), P0[2],P0[3],P0[4],P0[5],     pw0[0]=PKW(P0,0), pw0[1]=PKW(P0,2), pw0); \
    VRD(4); SBAR(); GAPA(C1=__builtin_amdgcn_mfma_f32_32x32x16_bf16(kf[1],qr[0],zc,0,0,0), P0[6],P0[7],P0[8],P0[9],     pw0[2]=PKW(P0,4), pw0[3]=PKW(P0,6), pw0); \
    VRD(1); SBAR(); GAPA(C0=__builtin_amdgcn_mfma_f32_32x32x16_bf16(kf[2],qr[1],C0,0,0,0),   P0[10],P0[11],P0[12],P0[13], pw1[0]=PKW(P0,8), pw1[1]=PKW(P0,10), pw1); \
    VRD(5); SBAR(); GAPA(C1=__builtin_amdgcn_mfma_f32_32x32x16_bf16(kf[3],qr[1],C1,0,0,0),   P0[14],P0[15],P1[0],P1[1],   pw1[2]=PKW(P0,12),pw1[3]=PKW(P0,14), pw1); \
    VRD(2); SBAR(); GAPA(C0=__builtin_amdgcn_mfma_f32_32x32x16_bf16(kf[4],qr[2],C0,0,0,0),   P1[2],P1[3],P1[4],P1[5],     pw2[0]=PKW(P1,0), pw2[1]=PKW(P1,2), pw2); \
    VRD(6); SBAR(); GAPA(C1=__builtin_amdgcn_mfma_f32_32x32x16_bf16(kf[5],qr[2],C1,0,0,0),   P1[6],P1[7],P1[8],P1[9],     pw2[2]=PKW(P1,4), pw2[3]=PKW(P1,6), pw2); \
    VRD(3); SBAR(); GAPA(C0=__builtin_amdgcn_mfma_f32_32x32x16_bf16(kf[6],qr[3],C0,0,0,0),   P1[10],P1[11],P1[12],P1[13], pw3[0]=PKW(P1,8), pw3[1]=PKW(P1,10), pw3); \
    VRD(7); SBAR(); GAPA(C1=__builtin_amdgcn_mfma_f32_32x32x16_bf16(kf[7],qr[3],C1,0,0,0),   P1[14],P1[15],0.f,0.f,       pw3[2]=PKW(P1,12),pw3[3]=PKW(P1,14), pw3); \
    l_reg+=sacc; \
    if(GK){DMA_K((t)+3,sl_cur);} if(GV){DMA_V((t)+1,sl_next);} \
    CMASK(C0,C1,t); \
    { float a=MX3(C0[0],C0[1],C1[0]),b=MX3(C0[2],C0[3],C1[1]); a=MX3(a,C1[2],C1[3]); \
      _Pragma("unroll") for(int r=4;r<16;r+=4){a=MX3(a,C0[r],C0[r+1]);b=MX3(b,C0[r+2],C0[r+3]);a=MX3(a,C1[r],C1[r+1]);b=MX3(b,C1[r+2],C1[r+3]);} \
      float rm=__builtin_fmaxf(a,b); { auto rr=__builtin_amdgcn_permlane32_swap(__float_as_uint(rm),__float_as_uint(rm),false,false); rm=__builtin_fmaxf(__uint_as_float(rr[0]),__uint_as_float(rr[1])); } \
      resc=false; \
      rm-=mhat; \
      if(__builtin_expect(__any(rm>(float)THRL),0)){ const float dl=__builtin_fmaxf(rm,0.f); mhat+=dl; \
        const float f=__builtin_amdgcn_exp2f(-dl); l_reg*=f; if(hi==0)wsf[r32]=f; resc=true; } } \
    SBAR(); \
    GAPB(o[0]=__builtin_amdgcn_mfma_f32_32x32x16_bf16(PAF(0),VFR(0),o[0],0,0,0), C0,0); \
    GAPB(o[1]=__builtin_amdgcn_mfma_f32_32x32x16_bf16(PAF(0),VFR(4),o[1],0,0,0), C0,4); \
    KRD(GL,0); GAPB(o[0]=__builtin_amdgcn_mfma_f32_32x32x16_bf16(PAF(1),VFR(1),o[0],0,0,0), C0,8); \
    KRD(GL,1); GAPB(o[1]=__builtin_amdgcn_mfma_f32_32x32x16_bf16(PAF(1),VFR(5),o[1],0,0,0), C0,12); \
    KRD(GL,2); GAPB(o[0]=__builtin_amdgcn_mfma_f32_32x32x16_bf16(PAF(2),VFR(2),o[0],0,0,0), C1,0); \
    KRD(GL,3); GAPB(o[1]=__builtin_amdgcn_mfma_f32_32x32x16_bf16(PAF(2),VFR(6),o[1],0,0,0), C1,4); \
    GAPB(o[0]=__builtin_amdgcn_mfma_f32_32x32x16_bf16(PAF(3),VFR(3),o[0],0,0,0), C1,8); \
    GAPB(o[1]=__builtin_amdgcn_mfma_f32_32x32x16_bf16(PAF(3),VFR(7),o[1],0,0,0), C1,12); \
    }while(0)
  #define ENDW(tt) do{ if((tt)+3<NT){WAIT_BAR(2);} else if((tt)+2<NT){WAIT_BAR(1);} else {WAIT_BAR(0);} }while(0)
  #define DRAIN(PX0,PX1) do{ float sacc=PX0[0]+PX0[1]; _Pragma("unroll") for(int r=2;r<16;++r)sacc+=PX0[r]; _Pragma("unroll") for(int r=0;r<16;++r)sacc+=PX1[r]; l_reg+=sacc; \
    pw0=(u32x4){PKW(PX0,0),PKW(PX0,2),PKW(PX0,4),PKW(PX0,6)};pw1=(u32x4){PKW(PX0,8),PKW(PX0,10),PKW(PX0,12),PKW(PX0,14)};pw2=(u32x4){PKW(PX1,0),PKW(PX1,2),PKW(PX1,4),PKW(PX1,6)};pw3=(u32x4){PKW(PX1,8),PKW(PX1,10),PKW(PX1,12),PKW(PX1,14)}; \
    SBAR(); pv(o,vb0+sl_cur,PAF(0),PAF(1),PAF(2),PAF(3)); }while(0)
  int t=1;
  if(NT&1){
    STEP(pB0,pB1,pA0,pA1,t,(t+3<NT),(t+1<NT),(t+1<NT));       ENDW(t);   RESC(); ROT();
    pA0=pB0; pA1=pB1; t=2;
  }
  for(;t+2<NT;t+=2){
    STEP(pB0,pB1,pA0,pA1,t,(t+3<NT),(t+1<NT),(t+1<NT));       ENDW(t);   RESC(); ROT();
    STEP(pA0,pA1,pB0,pB1,t+1,(t+4<NT),(t+2<NT),(t+2<NT));     ENDW(t+1); RESC(); ROT();
  }
  STEP(pB0,pB1,pA0,pA1,NT-1,false,false,false); RESC();
  DRAIN(pB0,pB1);
  #undef DRAIN
  #undef PKW
  #undef PAF
  #undef VFR
  #undef PIN
  #undef MX3
  #undef GAPA
  #undef GAPB
  #undef EX
  #undef VRD
  #undef KRD
  #undef STEP
  #undef ENDW
  {auto rr=__builtin_amdgcn_permlane32_swap(__float_as_uint(l_reg),__float_as_uint(l_reg),false,false);l_reg=__uint_as_float(rr[0])+__uint_as_float(rr[1]);}
  l_reg+=__builtin_amdgcn_exp2f(sk2-mhat);
  if(hi==0)wsf[32+r32]=l_reg;asm volatile("s_waitcnt lgkmcnt(0)":::"memory");
  float rli[16];
  #pragma unroll
  for(int r=0;r<16;++r)rli[r]=__builtin_amdgcn_rcpf(wsf[32+crow(r,hi)]);
  bf16*Ow=O+qrow0*OPITCH+hq*D; const bf16*Gw=X+qrow0*PITCH+1536+hq*D;
  { bf16*stg=(bf16*)(shm+LDS_OST)+wid*2048;
    #pragma unroll
    for(int r=0;r<16;++r){const int orow=crow(r,hi);
      #pragma unroll
      for(int d0=0;d0<2;++d0)stg[orow*64+d0*32+r32]=__float2bfloat16(o[d0][r]*rli[r]);}
    asm volatile("s_waitcnt lgkmcnt(0)":::"memory");
    #pragma unroll
    for(int i=0;i<4;++i){const int row=i*8+(lane>>3),ch=lane&7; const u32x4 v=*(const u32x4*)(stg+row*64+ch*8); const u32x4 gq=*(const u32x4*)(Gw+(long)row*PITCH+ch*8); u32x4 w;
      #pragma unroll
      for(int e=0;e<4;++e){ const float g0=__uint_as_float(gq[e]<<16),g1=__uint_as_float(gq[e]&0xffff0000u),v0=__uint_as_float(v[e]<<16),v1=__uint_as_float(v[e]&0xffff0000u);
        w[e]=cvtpk_s(v0*g0*__builtin_amdgcn_rcpf(1.f+__builtin_amdgcn_exp2f(-1.4426950408889634f*g0)),v1*g1*__builtin_amdgcn_rcpf(1.f+__builtin_amdgcn_exp2f(-1.4426950408889634f*g1))); }
      *(u32x4*)(Ow+(long)row*OPITCH+ch*8)=w;} }
  asm volatile("s_waitcnt lgkmcnt(0)\n\ts_barrier":::"memory");
  #undef DMA_K
  #undef DMA_V
  #undef TROW
  #undef TMASK
  #undef CMASK
  #undef START
  #undef RESC
  #undef ROT
}
constexpr int ATTN_LDS_BYTES=LDS_BYTES;
template<int THRL=8> __device__ __forceinline__ void attn_phase(char*lds,const bf16*X,bf16*O,const float*sink,int grid,int block){
  const int vcu=(grid%8==0)?(block%8)*(grid/8)+block/8:block;
  const int wid=__builtin_amdgcn_readfirstlane(threadIdx.x>>6);
  for(int u=vcu*4;u<1024;u+=grid*4){
    #pragma unroll 1
    for(int i=0;i<4;++i){ const int uu=u+i; if(uu>=1024)break; const int bk=uu>>7, qb=uu&127, b=bk>>2, kvh=bk&3;
      attn_unit<THRL>(b,kvh,qb*64,X,O,sink[kvh*4+(wid>>1)]*1.4426950408889634f,lds); }
  }
}
#undef SBAR
#undef WAIT_BAR
}
#ifndef S5_CHECK
#define S5_CHECK 0
#endif
#ifndef ATTN_SIMPLE
#define ATTN_SIMPLE 0
#endif
#ifndef ATTN_CHECK
#define ATTN_CHECK 0
#endif
constexpr int D = 1024, SEQ = 8192, CTXN = 256, MLAT = 16384, MCTX = 512, M = MLAT + MCTX, PW = 2560;
constexpr float ALPHA = 1.41421356237309515f, LN_EPS = 1e-5f;
constexpr float LOG2E = 1.4426950408889634f, QSCALE = 0.125f * 1.4426950408889634f;
constexpr int NWAVES = 8, NTHREADS = 512;
constexpr int LDS_BYTES = 147456;
constexpr size_t MiB = 1u << 20;
constexpr size_t WS_MODV = 1 * MiB;
constexpr size_t WS_ROPE = 1 * MiB + 256 * 1024;
constexpr size_t WS_S5A = 1 * MiB + 512 * 1024;
constexpr size_t WS_S5A128 = 1 * MiB + 512 * 1024 + 32 * 1024;
constexpr size_t WS_BBT = 2 * MiB;
constexpr size_t WS_CT = 2 * MiB + 256 * 1024;
constexpr size_t WS_S5BB = 2 * MiB + 512 * 1024;
constexpr size_t WS_E = 3 * MiB;
constexpr size_t WS_WIN0 = 8 * MiB, WS_WOUT0 = 13 * MiB, WS_WGLU = 15 * MiB, WS_WIN1 = 16 * MiB, WS_WOUT1 = 21 * MiB;
constexpr size_t WS_SGW = 23 * MiB;
constexpr size_t WS_H = 24 * MiB;
constexpr size_t WS_P = 57 * MiB;
constexpr size_t WS_MIX = 140 * MiB;
constexpr size_t WS_YA1 = 173 * MiB;
constexpr size_t WS_Z1C = 190 * MiB;
constexpr size_t WS_YAF = 192 * MiB;

typedef unsigned short bf16;
typedef float f32x4 __attribute__((ext_vector_type(4)));
typedef unsigned u32x2 __attribute__((ext_vector_type(2)));
typedef unsigned u32x4 __attribute__((ext_vector_type(4)));
#define LAS __attribute__((address_space(3)))
__device__ __forceinline__ unsigned f2bf(float f) { unsigned u = __builtin_bit_cast(unsigned, f); return (u + 0x7fffu + ((u >> 16) & 1u)) >> 16; }
__device__ __forceinline__ unsigned pk2(float lo, float hi) { return f2bf(lo) | (f2bf(hi) << 16); }
__device__ __forceinline__ float bf2f(unsigned h) { return __builtin_bit_cast(float, h << 16); }
__device__ __forceinline__ float bflo(unsigned w) { return __builtin_bit_cast(float, w << 16); }
__device__ __forceinline__ float bfhi(unsigned w) { return __builtin_bit_cast(float, w & 0xffff0000u); }
__device__ __forceinline__ float silu_f(float v) { return v / (1.f + __expf(-v)); }
__device__ __forceinline__ float gelu_tanh_f(float v) { const float u = 0.7978845608028654f * (v + 0.044715f * v * v * v); return v / (1.f + __expf(-2.f * u)); }
__device__ __forceinline__ float wave_sum(float v) {
#pragma unroll
    for (int o = 1; o < 64; o <<= 1) v += __shfl_xor(v, o);
    return v;
}
#define LDS_WAIT() asm volatile("s_waitcnt lgkmcnt(0)" ::: "memory")

struct Args { const float* in[27]; float* out; unsigned char* ws; };
typedef const __attribute__((address_space(4))) Args KArgs;

__device__ __forceinline__ int row_vec(int r) { return r < MLAT ? (r >> 13) : 2; }
__device__ __forceinline__ int chunk_row0(int cidx) { const int b = cidx / 66, c = cidx % 66; return c < 2 ? MLAT + b * CTXN + c * 128 : b * SEQ + (c - 2) * 128; }

__device__ __forceinline__ void p0_transpose_item(const float* W, int K, int N, bf16* WT, LAS float* scr, int item, int lane) {
    const int nblk = N / 32, kb = item / nblk, nb = item % nblk, k0 = 64 * kb, n0 = 32 * nb;
#pragma unroll 8
    for (int i = 0; i < 32; ++i) { const int kk = 2 * i + (lane >> 5); scr[kk * 33 + (lane & 31)] = W[(size_t)(k0 + kk) * N + n0 + (lane & 31)]; }
    LDS_WAIT();
    const int c = lane & 7;
#pragma unroll
    for (int j = 0; j < 4; ++j) { const int n = (lane >> 3) + 8 * j; const LAS float* s = scr + (8 * c) * 33 + n;
        u32x4 o; o.x = pk2(s[0 * 33], s[1 * 33]); o.y = pk2(s[2 * 33], s[3 * 33]); o.z = pk2(s[4 * 33], s[5 * 33]); o.w = pk2(s[6 * 33], s[7 * 33]);
        *(u32x4*)(WT + (size_t)(n0 + n) * K + k0 + 8 * c) = o; }
    LDS_WAIT();
}
__device__ __forceinline__ void phase_prologue(KArgs& a, LAS unsigned char* lds, int tid, int lane, int wave, int bid, int G) {
    asm volatile("" : "+v"(lane)); asm volatile("" : "+v"(tid));
    unsigned char* ws = a.ws;
    if (bid < 96) {
        LAS float* sv = (LAS float*)lds;
        LAS float* red = (LAS float*)(lds + 12288);
        const float* c = a.in[1]; const float* cc = a.in[3];
        for (int i = tid; i < 1024; i += NTHREADS) { sv[i] = silu_f(c[i]); sv[1024 + i] = silu_f(c[1024 + i]); sv[2048 + i] = silu_f(cc[i]); }
        __syncthreads();
        const int layer = bid / 48, n = (bid % 48) * 64 + lane;
        const float* w = a.in[4] + (size_t)layer * 1024 * 3072 + (size_t)(wave * 128) * 3072 + n;
        float a0 = 0.f, a1 = 0.f, a2 = 0.f;
#pragma unroll 8
        for (int k = 0; k < 128; ++k) { const float wv = w[(size_t)k * 3072]; const int kk = wave * 128 + k; a0 += sv[kk] * wv; a1 += sv[1024 + kk] * wv; a2 += sv[2048 + kk] * wv; }
        red[(wave * 3 + 0) * 64 + lane] = a0; red[(wave * 3 + 1) * 64 + lane] = a1; red[(wave * 3 + 2) * 64 + lane] = a2;
        __syncthreads();
        if (wave == 0) {
            float* modv = (float*)(ws + WS_MODV); const float bb = a.in[5][layer * 3072 + n];
#pragma unroll
            for (int v = 0; v < 3; ++v) { float s = 0.f;
#pragma unroll
                for (int w8 = 0; w8 < 8; ++w8) s += red[(w8 * 3 + v) * 64 + lane];
                modv[(layer * 3 + v) * 3072 + n] = s + bb; }
        }
        __syncthreads();
    }
    {
        const int gt = bid * NTHREADS + tid;
        if (gt < 4096) {
            const int dg = gt >> 6, p = gt & 63;
            const double lr = a.in[10][dg * 64 + p], li = a.in[11][dg * 64 + p], dt = exp((double)a.in[12][dg]);
            const double mag = exp(lr * dt), ang = li * dt;
            const double ar = mag * cos(ang), ai = mag * sin(ang);
            const double den = lr * lr + li * li, nr = ar - 1.0, ni = ai;
            const double fr = (nr * lr + ni * li) / den, fi = (ni * lr - nr * li) / den;
            float* A = (float*)(ws + WS_S5A); float* BB = (float*)(ws + WS_S5BB);
            A[gt * 2] = (float)ar; A[gt * 2 + 1] = (float)ai;
            { const double m128 = exp(128.0 * lr * dt), a128 = 128.0 * ang; float* A128 = (float*)(ws + WS_S5A128); A128[gt * 2] = (float)(m128 * cos(a128)); A128[gt * 2 + 1] = (float)(m128 * sin(a128)); }
            for (int h = 0; h < 16; ++h) { const double br = a.in[13][gt * 16 + h], bi = a.in[14][gt * 16 + h];
                BB[(gt * 16 + h) * 2] = (float)(fr * br - fi * bi); BB[(gt * 16 + h) * 2 + 1] = (float)(fr * bi + fi * br); }
        } else if (gt >= 8192 && gt < 8192 + 16384) {
            const int e = gt - 8192, l = e & 63, tile = (e >> 6) & 3, dg = e >> 8;
            const int p = (tile >> 1) * 32 + (l & 31), ri = tile & 1, hb = l >> 5;
            const double lr = a.in[10][dg * 64 + p], li = a.in[11][dg * 64 + p], dt = exp((double)a.in[12][dg]);
            const double mag = exp(lr * dt), ang = li * dt;
            const double ar = mag * cos(ang), ai = mag * sin(ang);
            const double den = lr * lr + li * li, nr = ar - 1.0, ni = ai;
            const double fr = (nr * lr + ni * li) / den, fi = (ni * lr - nr * li) / den;
            unsigned w[4];
            for (int jj = 0; jj < 4; ++jj) { float v[2];
                for (int q = 0; q < 2; ++q) { const int h = 8 * hb + 2 * jj + q; const double br = a.in[13][(dg * 64 + p) * 16 + h], bi = a.in[14][(dg * 64 + p) * 16 + h];
                    v[q] = (float)(ri == 0 ? fr * br - fi * bi : fr * bi + fi * br); }
                w[jj] = pk2(v[0], v[1]); }
            *(u32x4*)(ws + WS_BBT + (size_t)e * 16) = (u32x4){w[0], w[1], w[2], w[3]};
        } else if (gt >= 32768 && gt < 32768 + 16384) {
            const int e = gt - 32768, l = e & 63, ks = (e >> 6) & 3, dg = e >> 8;
            const int hp = l & 15, kq = l >> 4;
            unsigned w[4];
            for (int jj = 0; jj < 4; ++jj) { const int p = (ks * 32 + 8 * kq + 2 * jj) >> 1;
                w[jj] = pk2(a.in[15][(dg * 16 + hp) * 64 + p], -a.in[16][(dg * 16 + hp) * 64 + p]); }
            *(u32x4*)(ws + WS_CT + (size_t)e * 16) = (u32x4){w[0], w[1], w[2], w[3]};
        } else if (gt >= 4096 && gt < 4096 + 2048) {
            const int e = gt - 4096, pos = e >> 4, fi = e & 15;
            const float inv = powf(10000.f, -(float)fi / 16.f);
            const float ang = (float)pos * inv;
            float* cs = (float*)(ws + WS_ROPE); cs[e * 2] = (float)cos((double)ang); cs[e * 2 + 1] = (float)sin((double)ang);
        }
    }
    for (int i = bid * NTHREADS + tid; i < 8 * 128 * 128 / 4; i += G * NTHREADS) { const f32x4 v = *(const f32x4*)(a.in[22] + (size_t)i * 4); u32x2 o; o.x = pk2(v[0], v[1]); o.y = pk2(v[2], v[3]); *(u32x2*)(ws + WS_SGW + (size_t)i * 8) = o; }
    {
        LAS float* scr = (LAS float*)(lds + 32768 + wave * 8448);
        const int gw = bid * NWAVES + wave, NGW = G * NWAVES;
        constexpr int I_IN = 16 * 80, I_OUT = 16 * 32, I_GLU = 8 * 16;
        constexpr int NITEMS = 2 * I_IN + 2 * I_OUT + I_GLU;
        for (int it = gw; it < NITEMS; it += NGW) {
            int r = it;
            if (r < I_IN) { p0_transpose_item(a.in[8], 1024, 2560, (bf16*)(ws + WS_WIN0), scr, r, lane); continue; } r -= I_IN;
            if (r < I_IN) { p0_transpose_item(a.in[24], 1024, 2560, (bf16*)(ws + WS_WIN1), scr, r, lane); continue; } r -= I_IN;
            if (r < I_OUT) { p0_transpose_item(a.in[9], 1024, 1024, (bf16*)(ws + WS_WOUT0), scr, r, lane); continue; } r -= I_OUT;
            if (r < I_OUT) { p0_transpose_item(a.in[25], 1024, 1024, (bf16*)(ws + WS_WOUT1), scr, r, lane); continue; } r -= I_OUT;
            p0_transpose_item(a.in[18], 512, 512, (bf16*)(ws + WS_WGLU), scr, r, lane);
        }
    }
}

__device__ __forceinline__ void phase_modulate0(KArgs& a, int lane, int wave, int bid, int G) {
    asm volatile("" : "+v"(lane));
    const float* modv = (const float*)(a.ws + WS_MODV);
    bf16* H = (bf16*)(a.ws + WS_H);
    const int gw = bid * NWAVES + wave, NGW = G * NWAVES;
    for (int r = gw; r < M; r += NGW) {
        const float* z = (r < MLAT) ? a.in[0] + (size_t)r * D : a.in[2] + (size_t)(r - MLAT) * D;
        const float* mv = modv + row_vec(r) * 3072;
#pragma unroll
        for (int j = 0; j < 4; ++j) { const int c = lane * 4 + 256 * j;
            const f32x4 v = *(const f32x4*)(z + c), sh = *(const f32x4*)(mv + c), sc = *(const f32x4*)(mv + D + c);
            const f32x4 h = v * (sc + 1.f) + sh;
            u32x2 o; o.x = pk2(h[0], h[1]); o.y = pk2(h[2], h[3]);
            *(u32x2*)(H + (size_t)r * D + c) = o; }
    }
}

__device__ __forceinline__ int seq_row(int b, int t) { return t < CTXN ? MLAT + b * CTXN + t : b * SEQ + (t - CTXN); }
__device__ __forceinline__ void phase_s5_naive(KArgs& a, LAS unsigned char* lds, int lane, int wave, int bid, int G, bf16* YA1) {
    asm volatile("" : "+v"(lane));
    const int gw = bid * NWAVES + wave;
    if (gw >= 64) return;
    const int b = gw >> 5, g = gw & 31, p = lane, hh = lane & 15;
    const bf16* P = (const bf16*)(a.ws + WS_P); float* YAF = (float*)(a.ws + WS_YAF);
    const float* A = (const float*)(a.ws + WS_S5A); const float* BB = (const float*)(a.ws + WS_S5BB);
    LAS float* sre = (LAS float*)(lds + wave * 512); LAS float* sim = sre + 64;
    for (int dir = 0; dir < 2; ++dir) {
        const int dg = dir * 32 + g;
        const float ar = A[(dg * 64 + p) * 2], ai = A[(dg * 64 + p) * 2 + 1];
        const float* bbp = BB + (size_t)(dg * 64 + p) * 32;
        const float* cre = a.in[15] + (dg * 16 + hh) * 64; const float* cim = a.in[16] + (dg * 16 + hh) * 64;
        const float dsk = a.in[17][g * 16 + hh];
        float sr = 0.f, si = 0.f;
        for (int j = 0; j < SEQ + CTXN; ++j) {
            const int t = (dir == 0) ? j : (j < CTXN ? CTXN - 1 - j : SEQ + 2 * CTXN - 1 - j);
            const int row = seq_row(b, t);
            const bf16* up = P + (size_t)row * PW + g * 16;
            const u32x4 u0 = *(const u32x4*)up, u1 = *(const u32x4*)(up + 8);
            float u[16];
#pragma unroll
            for (int h = 0; h < 4; ++h) { u[2 * h] = bflo(u0[h]); u[2 * h + 1] = bfhi(u0[h]); u[8 + 2 * h] = bflo(u1[h]); u[8 + 2 * h + 1] = bfhi(u1[h]); }
            float bur = 0.f, bui = 0.f;
#pragma unroll
            for (int h = 0; h < 16; ++h) { bur += bbp[2 * h] * u[h]; bui += bbp[2 * h + 1] * u[h]; }
            const float nr = ar * sr - ai * si + bur, ni = ar * si + ai * sr + bui;
            sr = nr; si = ni;
            sre[p] = sr; sim[p] = si;
            LDS_WAIT();
            if (p < 16) {
                float y = 0.f;
                for (int q = 0; q < 64; ++q) y += cre[q] * sre[q] - cim[q] * sim[q];
                const size_t o = (size_t)row * 512 + g * 16 + p;
                float uo = 0.f;
#pragma unroll
                for (int h = 0; h < 16; ++h) uo = (h == p) ? u[h] : uo;
                if (dir == 0) YAF[o] = y + dsk * uo;
                else YA1[o] = (bf16)f2bf(gelu_tanh_f(YAF[o] + y));
            }
            LDS_WAIT();
        }
    }
}

typedef short bf16x8 __attribute__((ext_vector_type(8)));
typedef float f32x16 __attribute__((ext_vector_type(16)));
typedef float f32x2_t __attribute__((ext_vector_type(2))); typedef __bf16 bf16x2_t __attribute__((ext_vector_type(2)));
__device__ __forceinline__ unsigned cvtpk(float lo, float hi) { f32x2_t v = {lo, hi}; bf16x2_t b = __builtin_convertvector(v, bf16x2_t); return __builtin_bit_cast(unsigned, b); }
__device__ __forceinline__ int s5_kidx(int dir, int c) { return dir == 0 ? c : (c == 1 ? 0 : (c == 0 ? 1 : 67 - c)); }
constexpr int S5_LDS_ROW = 272, S5_LDS_S = 32 * S5_LDS_ROW, S5_LDS_WAVE = S5_LDS_S + 8192;

template <int PASS>
__device__ __forceinline__ void s5_task(KArgs& a, LAS unsigned char* sl, int lane, int c, int g) {
    const int c32 = lane & 31, hb = lane >> 5;
    const bf16* P = (const bf16*)(a.ws + WS_P);
    const float* A = (const float*)(a.ws + WS_S5A); const float* A128 = (const float*)(a.ws + WS_S5A128);
    float* E = (float*)(a.ws + WS_E); bf16* YA1 = (bf16*)(a.ws + WS_YA1);
    const int r = lane & 31, beta_a = (r >> 2) & 1, s_a = (r & 3) + 4 * (r >> 3);
    const bf16* ua = P + (size_t)chunk_row0(beta_a * 66 + c) * PW + g * 16 + 8 * hb;
    LAS bf16* yl = (LAS bf16*)(sl + S5_LDS_S);
    const int hp = lane & 15, tq = lane >> 4;
    const float dsk = a.in[17][g * 16 + hp];
#pragma unroll 1
    for (int dir = 0; dir < 2; ++dir) {
        const int dg = dir * 32 + g;
        bf16x8 bbt[4], ct[4];
#pragma unroll
        for (int t = 0; t < 4; ++t) bbt[t] = *(const bf16x8*)(a.ws + WS_BBT + ((size_t)(dg * 4 + t) * 64 + lane) * 16);
        if (PASS == 2) {
#pragma unroll
            for (int t = 0; t < 4; ++t) ct[t] = *(const bf16x8*)(a.ws + WS_CT + ((size_t)(dg * 4 + t) * 64 + lane) * 16);
        }
        const float arA = A[(dg * 64 + c32) * 2], aiA = A[(dg * 64 + c32) * 2 + 1], arB = A[(dg * 64 + 32 + c32) * 2], aiB = A[(dg * 64 + 32 + c32) * 2 + 1];
        const int kk = s5_kidx(dir, c);
        float* Eb = E + ((size_t)((dir * 2 + hb) * 32 + g) * 66) * 128;
        float srA = 0.f, siA = 0.f, srB = 0.f, siB = 0.f;
        if (PASS == 2) {
            const float qrA = A128[(dg * 64 + c32) * 2], qiA = A128[(dg * 64 + c32) * 2 + 1], qrB = A128[(dg * 64 + 32 + c32) * 2], qiB = A128[(dg * 64 + 32 + c32) * 2 + 1];
            for (int k = 0; k < kk; ++k) {
                const f32x2_t eA = *(const f32x2_t*)(Eb + (size_t)k * 128 + c32 * 2), eB = *(const f32x2_t*)(Eb + (size_t)k * 128 + (32 + c32) * 2);
                const float nrA = qrA * srA - qiA * siA + eA.x, niA = qrA * siA + qiA * srA + eA.y;
                const float nrB = qrB * srB - qiB * siB + eB.x, niB = qrB * siB + qiB * srB + eB.y;
                srA = nrA; siA = niA; srB = nrB; siB = niB;
            }
        }
        const bf16* ud = ua + (size_t)(dir == 0 ? s_a : 127 - s_a) * PW; const long ustep = dir == 0 ? 16L * PW : -16L * PW;
        bf16x8 ufn = *(const bf16x8*)ud;
#pragma unroll 1
        for (int j = 0; j < 8; ++j) {
            const bf16x8 ufc = ufn;
            ufn = *(const bf16x8*)(ud + (j < 7 ? j + 1 : 7) * ustep);
            const f32x16 z16 = {0.f, 0.f, 0.f, 0.f, 0.f, 0.f, 0.f, 0.f, 0.f, 0.f, 0.f, 0.f, 0.f, 0.f, 0.f, 0.f};
            {
                const f32x16 re = __builtin_amdgcn_mfma_f32_32x32x16_bf16(ufc, bbt[0], z16, 0, 0, 0);
                const f32x16 im = __builtin_amdgcn_mfma_f32_32x32x16_bf16(ufc, bbt[1], z16, 0, 0, 0);
#pragma unroll
                for (int s = 0; s < 16; ++s) {
                    const float nr = arA * srA + (re[s] - aiA * siA), ni = arA * siA + (im[s] + aiA * srA);
                    srA = nr; siA = ni;
                    if (PASS == 2) *(LAS unsigned*)(sl + (16 * hb + (dir == 0 ? s : 15 - s)) * S5_LDS_ROW + c32 * 4) = cvtpk(srA, siA);
                }
            }
            {
                const f32x16 re = __builtin_amdgcn_mfma_f32_32x32x16_bf16(ufc, bbt[2], z16, 0, 0, 0);
                const f32x16 im = __builtin_amdgcn_mfma_f32_32x32x16_bf16(ufc, bbt[3], z16, 0, 0, 0);
#pragma unroll
                for (int s = 0; s < 16; ++s) {
                    const float nr = arB * srB + (re[s] - aiB * siB), ni = arB * siB + (im[s] + aiB * srB);
                    srB = nr; siB = ni;
                    if (PASS == 2) *(LAS unsigned*)(sl + (16 * hb + (dir == 0 ? s : 15 - s)) * S5_LDS_ROW + (32 + c32) * 4) = cvtpk(srB, siB);
                }
            }
            if (PASS == 2) {
                const int blk = dir == 0 ? j : 7 - j;
#pragma unroll
                for (int b2 = 0; b2 < 2; ++b2) {
                    f32x4 y = (f32x4){0.f, 0.f, 0.f, 0.f};
#pragma unroll
                    for (int ks = 0; ks < 4; ++ks) {
                        const bf16x8 af = *(const LAS bf16x8*)(sl + (16 * b2 + (lane & 15)) * S5_LDS_ROW + ks * 64 + (lane >> 4) * 16);
                        y = __builtin_amdgcn_mfma_f32_16x16x32_bf16(af, ct[ks], y, 0, 0, 0);
                    }
                    if (dir == 0) {
#pragma unroll
                        for (int rg = 0; rg < 4; ++rg) yl[(b2 * 128 + 16 * blk + 4 * tq + rg) * 16 + hp] = (bf16)f2bf(y[rg]);
                    } else {
                        const size_t row0 = (size_t)(chunk_row0(b2 * 66 + c) + 16 * blk + 4 * tq);
#pragma unroll
                        for (int rg = 0; rg < 4; ++rg) { const size_t row = row0 + rg;
                            const float u = bf2f(P[row * PW + g * 16 + hp]);
                            const float v = y[rg] + bf2f(yl[(b2 * 128 + 16 * blk + 4 * tq + rg) * 16 + hp]) + dsk * u;
                            YA1[row * 512 + g * 16 + hp] = (bf16)f2bf(gelu_tanh_f(v)); }
                    }
                }
            }
        }
        if (PASS == 1) {
            *(f32x2_t*)(Eb + (size_t)kk * 128 + c32 * 2) = (f32x2_t){srA, siA};
            *(f32x2_t*)(Eb + (size_t)kk * 128 + (32 + c32) * 2) = (f32x2_t){srB, siB};
        }
    }
}
template <int PASS>
__device__ __forceinline__ void phase_s5(KArgs& a, LAS unsigned char* lds, int lane, int wave, int bid, int G) {
    LAS unsigned char* sl = lds + wave * S5_LDS_WAVE;
    const int gw = bid * NWAVES + wave, NGW = G * NWAVES;
    for (int task = gw; task < 66 * 32; task += NGW) s5_task<PASS>(a, sl, lane, task >> 5, task & 31);
}

__device__ __forceinline__ void gmlp_simple_task(KArgs& a, LAS unsigned char* lds, int tid, int lane, int wave, int task) {
    asm volatile("" : "+v"(lane)); asm volatile("" : "+v"(tid));
    const int cidx = task >> 3, h = task & 7, rb = chunk_row0(cidx);
    const bf16* P = (const bf16*)(a.ws + WS_P); bf16* MIX = (bf16*)(a.ws + WS_MIX);
    LAS float* stat = (LAS float*)lds;
    for (int i = 0; i < 16; ++i) { const int row = wave * 16 + i;
        const u32x4 w = *(const u32x4*)(P + (size_t)(rb + row) * PW + 1536 + lane * 8);
        float x[8];
#pragma unroll
        for (int j = 0; j < 4; ++j) { x[2 * j] = bflo(w[j]); x[2 * j + 1] = bfhi(w[j]); }
        float s = 0.f;
#pragma unroll
        for (int j = 0; j < 8; ++j) s += x[j];
        const float mean = wave_sum(s) * (1.f / 512.f); float q = 0.f;
#pragma unroll
        for (int j = 0; j < 8; ++j) { const float d = x[j] - mean; q += d * d; }
        const float rstd = 1.f / sqrtf(wave_sum(q) * (1.f / 512.f) + LN_EPS);
        if (lane == 0) { stat[row * 2] = mean; stat[row * 2 + 1] = rstd; } }
    __syncthreads();
    const int d = tid & 63, qq = tid >> 6, c = h * 64 + d;
    const float lg = a.in[20][c], lb = a.in[21][c];
    const float* ws_ = a.in[22] + (size_t)h * 128 * 128;
    float acc[16];
#pragma unroll
    for (int i = 0; i < 16; ++i) acc[i] = 0.f;
    for (int k = 0; k < 128; ++k) {
        const float vn = (bf2f(P[(size_t)(rb + k) * PW + 1536 + c]) - stat[k * 2]) * stat[k * 2 + 1] * lg + lb;
#pragma unroll
        for (int i = 0; i < 16; ++i) acc[i] += ws_[(qq + 8 * i) * 128 + k] * vn;
    }
#pragma unroll
    for (int i = 0; i < 16; ++i) { const int q = qq + 8 * i; const size_t r = (size_t)(rb + q);
        const float s = acc[i] + a.in[23][h * 128 + q];
        MIX[r * D + 512 + c] = (bf16)f2bf(bf2f(P[r * PW + 1024 + c]) * s * silu_f(bf2f(P[r * PW + 2048 + c]))); }
    __syncthreads();
}

__device__ __forceinline__ void gmlp_unit(KArgs& a, LAS unsigned char* lds, int tid, int lane, int wave, int unit) {
    asm volatile("" : "+v"(lane)); asm volatile("" : "+v"(tid));
    const int cidx = unit >> 1, hh = unit & 1, rb = chunk_row0(cidx);
    const bf16* P = (const bf16*)(a.ws + WS_P); bf16* MIX = (bf16*)(a.ws + WS_MIX); const bf16* SGW = (const bf16*)(a.ws + WS_SGW);
    LAS float* stat = (LAS float*)lds;
    LAS unsigned char* vnT = lds + 1024;
    for (int i = 0; i < 16; ++i) { const int row = wave * 16 + i;
        const u32x4 w = *(const u32x4*)(P + (size_t)(rb + row) * PW + 1536 + lane * 8);
        float x[8];
#pragma unroll
        for (int j = 0; j < 4; ++j) { x[2 * j] = bflo(w[j]); x[2 * j + 1] = bfhi(w[j]); }
        float s = 0.f;
#pragma unroll
        for (int j = 0; j < 8; ++j) s += x[j];
        const float mean = wave_sum(s) * (1.f / 512.f); float q = 0.f;
#pragma unroll
        for (int j = 0; j < 8; ++j) { const float d = x[j] - mean; q += d * d; }
        const float rstd = 1.f / sqrtf(wave_sum(q) * (1.f / 512.f) + LN_EPS);
        if (lane == 0) { stat[row * 2] = mean; stat[row * 2 + 1] = rstd; } }
    __syncthreads();
    {
        const int k = tid & 127, cgp = __builtin_amdgcn_readfirstlane(tid >> 7), h = hh * 4 + cgp;
        const float mean = stat[k * 2], rstd = stat[k * 2 + 1];
        const bf16* vp = P + (size_t)(rb + k) * PW + 1536 + h * 64;
        const float* lg = a.in[20] + h * 64; const float* lb = a.in[21] + h * 64;
#pragma unroll
        for (int j8 = 0; j8 < 8; ++j8) { const u32x4 w = *(const u32x4*)(vp + j8 * 8);
#pragma unroll
            for (int e = 0; e < 8; ++e) { const float x = (e & 1) ? bfhi(w[e >> 1]) : bflo(w[e >> 1]); const int cl = j8 * 8 + e;
                *(LAS bf16*)(vnT + (cgp * 64 + cl) * 272 + k * 2) = (bf16)f2bf((x - mean) * rstd * lg[cl] + lb[cl]); } }
    }
    __syncthreads();
    const int qt = wave & 3, dt = wave >> 2, r32 = lane & 31, hb = lane >> 5;
#pragma unroll 1
    for (int hl = 0; hl < 4; ++hl) { const int h = hh * 4 + hl;
        f32x16 acc = {0.f, 0.f, 0.f, 0.f, 0.f, 0.f, 0.f, 0.f, 0.f, 0.f, 0.f, 0.f, 0.f, 0.f, 0.f, 0.f};
        const bf16* wp = SGW + ((size_t)h * 128 + qt * 32 + r32) * 128 + 8 * hb;
        const LAS unsigned char* bp = vnT + (hl * 64 + dt * 32 + r32) * 272 + hb * 16;
#pragma unroll
        for (int ks = 0; ks < 8; ++ks) { const bf16x8 af = *(const bf16x8*)(wp + ks * 16); const bf16x8 bfr = *(const LAS bf16x8*)(bp + ks * 32);
            acc = __builtin_amdgcn_mfma_f32_32x32x16_bf16(af, bfr, acc, 0, 0, 0); }
        const int c = h * 64 + dt * 32 + r32;
#pragma unroll
        for (int r = 0; r < 16; ++r) { const int q = qt * 32 + (r & 3) + 8 * (r >> 2) + 4 * hb; const size_t row = (size_t)(rb + q);
            const float s = acc[r] + a.in[23][h * 128 + q];
            MIX[row * D + 512 + c] = (bf16)f2bf(bf2f(P[row * PW + 1024 + c]) * s * silu_f(bf2f(P[row * PW + 2048 + c]))); }
    }
    __syncthreads();
}

__device__ __forceinline__ void phase_ln0(KArgs& a, int lane, int wave, int bid, int G) {
    asm volatile("" : "+v"(lane));
    const float* modv = (const float*)(a.ws + WS_MODV);
    const bf16* Y0 = (const bf16*)(a.ws + WS_P); bf16* H = (bf16*)(a.ws + WS_H); float* Z1C = (float*)(a.ws + WS_Z1C);
    const int gw = bid * NWAVES + wave, NGW = G * NWAVES;
    for (int r = gw; r < M; r += NGW) {
        const float* z = (r < MLAT) ? a.in[0] + (size_t)r * D : a.in[2] + (size_t)(r - MLAT) * D;
        float* zo = (r < MLAT) ? a.out + (size_t)r * D : Z1C + (size_t)(r - MLAT) * D;
        const int vec = row_vec(r);
        const float* g0 = modv + vec * 3072 + 2 * D; const float* mv1 = modv + (3 + vec) * 3072;
        f32x4 v[4]; float s = 0.f;
#pragma unroll
        for (int j = 0; j < 4; ++j) { const int c = lane * 4 + 256 * j;
            const f32x4 zz = *(const f32x4*)(z + c), gg = *(const f32x4*)(g0 + c); const u32x2 yw = *(const u32x2*)(Y0 + (size_t)r * D + c);
            f32x4 y; y[0] = bflo(yw.x); y[1] = bfhi(yw.x); y[2] = bflo(yw.y); y[3] = bfhi(yw.y);
            v[j] = zz * ALPHA + y * gg; s += (v[j][0] + v[j][1]) + (v[j][2] + v[j][3]); }
        const float mean = wave_sum(s) * (1.f / D); float q = 0.f;
#pragma unroll
        for (int j = 0; j < 4; ++j) { v[j] = v[j] - mean; q += (v[j][0] * v[j][0] + v[j][1] * v[j][1]) + (v[j][2] * v[j][2] + v[j][3] * v[j][3]); }
        const float rstd = 1.f / sqrtf(wave_sum(q) * (1.f / D) + LN_EPS);
#pragma unroll
        for (int j = 0; j < 4; ++j) { const int c = lane * 4 + 256 * j;
            const f32x4 z1 = v[j] * rstd * *(const f32x4*)(a.in[6] + c) + *(const f32x4*)(a.in[7] + c);
            *(f32x4*)(zo + c) = z1;
            const f32x4 h = z1 * (*(const f32x4*)(mv1 + D + c) + 1.f) + *(const f32x4*)(mv1 + c);
            u32x2 o; o.x = pk2(h[0], h[1]); o.y = pk2(h[2], h[3]);
            *(u32x2*)(H + (size_t)r * D + c) = o; }
    }
}
__device__ __forceinline__ void phase_ln1(KArgs& a, int lane, int wave, int bid, int G) {
    asm volatile("" : "+v"(lane));
    const float* modv = (const float*)(a.ws + WS_MODV);
    const bf16* Y1 = (const bf16*)(a.ws + WS_H);
    const int gw = bid * NWAVES + wave, NGW = G * NWAVES;
    for (int r = gw; r < MLAT; r += NGW) {
        float* zo = a.out + (size_t)r * D;
        const float* g1 = modv + (3 + (r >> 13)) * 3072 + 2 * D;
        f32x4 v[4]; float s = 0.f;
#pragma unroll
        for (int j = 0; j < 4; ++j) { const int c = lane * 4 + 256 * j;
            const f32x4 zz = *(const f32x4*)(zo + c), gg = *(const f32x4*)(g1 + c); const u32x2 yw = *(const u32x2*)(Y1 + (size_t)r * D + c);
            f32x4 y; y[0] = bflo(yw.x); y[1] = bfhi(yw.x); y[2] = bflo(yw.y); y[3] = bfhi(yw.y);
            v[j] = zz * ALPHA + y * gg; s += (v[j][0] + v[j][1]) + (v[j][2] + v[j][3]); }
        const float mean = wave_sum(s) * (1.f / D); float q = 0.f;
#pragma unroll
        for (int j = 0; j < 4; ++j) { v[j] = v[j] - mean; q += (v[j][0] * v[j][0] + v[j][1] * v[j][1]) + (v[j][2] * v[j][2] + v[j][3] * v[j][3]); }
        const float rstd = 1.f / sqrtf(wave_sum(q) * (1.f / D) + LN_EPS);
#pragma unroll
        for (int j = 0; j < 4; ++j) { const int c = lane * 4 + 256 * j;
            *(f32x4*)(zo + c) = v[j] * rstd * *(const f32x4*)(a.in[6] + D + c) + *(const f32x4*)(a.in[7] + D + c); }
    }
}

__device__ __forceinline__ void phase_attn_simple(KArgs& a, int lane, int wave, int bid, int G, bf16* MIX) {
    asm volatile("" : "+v"(lane));
    const bf16* P = (const bf16*)(a.ws + WS_P);
    const int sub = lane & 3, hq = lane >> 2, kvh = hq >> 2;
    const float sk2 = a.in[26][hq] * LOG2E;
    const int gw = bid * NWAVES + wave, NGW = G * NWAVES;
    for (int r = gw; r < MLAT; r += NGW) {
        const int b = r >> 13, t = r & 8191;
        float q[16];
        { const bf16* qp = P + (size_t)r * PW + hq * 64 + sub * 16; const u32x4 w0 = *(const u32x4*)qp, w1 = *(const u32x4*)(qp + 8);
#pragma unroll
          for (int j = 0; j < 4; ++j) { q[2 * j] = bflo(w0[j]); q[2 * j + 1] = bfhi(w0[j]); q[8 + 2 * j] = bflo(w1[j]); q[8 + 2 * j + 1] = bfhi(w1[j]); } }
        const int lo = t - 128 < 0 ? 0 : t - 128, hi = t + 128 > SEQ - 1 ? SEQ - 1 : t + 128;
        const int nk = CTXN + (hi - lo + 1);
        const bf16* kc = P + (size_t)(MLAT + b * CTXN) * PW + 1024 + kvh * 64 + sub * 16;
        const bf16* kl = P + (size_t)(b * SEQ + lo) * PW + 1024 + kvh * 64 + sub * 16;
        float mx = sk2;
        for (int i = 0; i < nk; ++i) { const bf16* kp = (i < CTXN) ? kc + (size_t)i * PW : kl + (size_t)(i - CTXN) * PW;
            const u32x4 w0 = *(const u32x4*)kp, w1 = *(const u32x4*)(kp + 8); float s = 0.f;
#pragma unroll
            for (int j = 0; j < 4; ++j) { s += q[2 * j] * bflo(w0[j]) + q[2 * j + 1] * bfhi(w0[j]); s += q[8 + 2 * j] * bflo(w1[j]) + q[8 + 2 * j + 1] * bfhi(w1[j]); }
            s += __shfl_xor(s, 1); s += __shfl_xor(s, 2);
            mx = fmaxf(mx, s); }
        float l = exp2f(sk2 - mx);
        float o[16];
#pragma unroll
        for (int j = 0; j < 16; ++j) o[j] = 0.f;
        for (int i = 0; i < nk; ++i) { const bf16* kp = (i < CTXN) ? kc + (size_t)i * PW : kl + (size_t)(i - CTXN) * PW;
            const u32x4 w0 = *(const u32x4*)kp, w1 = *(const u32x4*)(kp + 8); float s = 0.f;
#pragma unroll
            for (int j = 0; j < 4; ++j) { s += q[2 * j] * bflo(w0[j]) + q[2 * j + 1] * bfhi(w0[j]); s += q[8 + 2 * j] * bflo(w1[j]) + q[8 + 2 * j + 1] * bfhi(w1[j]); }
            s += __shfl_xor(s, 1); s += __shfl_xor(s, 2);
            const float pr = exp2f(s - mx); l += pr;
            const u32x4 v0 = *(const u32x4*)(kp + 256), v1 = *(const u32x4*)(kp + 264);
#pragma unroll
            for (int j = 0; j < 4; ++j) { o[2 * j] += pr * bflo(v0[j]); o[2 * j + 1] += pr * bfhi(v0[j]); o[8 + 2 * j] += pr * bflo(v1[j]); o[8 + 2 * j + 1] += pr * bfhi(v1[j]); } }
        const float rl = 1.f / l;
        const bf16* gp = P + (size_t)r * PW + 1536 + hq * 64 + sub * 16;
        const u32x4 g0 = *(const u32x4*)gp, g1 = *(const u32x4*)(gp + 8);
        u32x4 w0, w1;
#pragma unroll
        for (int j = 0; j < 4; ++j) { w0[j] = pk2(o[2 * j] * rl * silu_f(bflo(g0[j])), o[2 * j + 1] * rl * silu_f(bfhi(g0[j])));
                                      w1[j] = pk2(o[8 + 2 * j] * rl * silu_f(bflo(g1[j])), o[8 + 2 * j + 1] * rl * silu_f(bfhi(g1[j]))); }
        bf16* op = MIX + (size_t)r * D + hq * 64 + sub * 16;
        *(u32x4*)op = w0; *(u32x4*)(op + 8) = w1;
    }
}

#define XB_TMO      128
#define XB_XCNT(j)  (256  + 64 * (j))
#define XB_XSUB(j)  (1280 + 64 * (j))
#define XB_XGEN(j)  (2304 + 64 * (j))
#define XB_TOP      3328
#define XB_TOPGEN   3392
#define XCD_BAR_WORDS 3456
#define XB_SPIN_CAP (1u << 18)

__device__ __forceinline__ unsigned xb_ld(unsigned* p)              { return __hip_atomic_load(p, __ATOMIC_RELAXED, __HIP_MEMORY_SCOPE_AGENT); }
__device__ __forceinline__ unsigned xb_add(unsigned* p, unsigned v) { return __hip_atomic_fetch_add(p, v, __ATOMIC_RELAXED, __HIP_MEMORY_SCOPE_AGENT); }
__device__ __forceinline__ unsigned xb_xcc_id() { return (unsigned)__builtin_amdgcn_s_getreg((3 << 11) | 20) & 0xFu; }
#define XB_SPIN(cond, bar) do { unsigned _sp = 0; while (cond) { __builtin_amdgcn_s_sleep(1); \
    if ((++_sp & 255u) == 0u) { if (xb_ld(&(bar)[XB_TMO])) break; if (_sp > XB_SPIN_CAP) { atomicAdd(&(bar)[XB_TMO], 1u); break; } } } } while (0)

struct XcdBarrier {
    unsigned* bar; unsigned x;
    volatile LAS unsigned* st;
};

__device__ __forceinline__ XcdBarrier xcd_barrier_post(unsigned* bar, volatile LAS unsigned* st) {
    XcdBarrier b; b.bar = bar; b.x = xb_xcc_id(); b.st = st;
    if (threadIdx.x == 0) (void)xb_add(&bar[XB_XCNT(b.x)], 1u);
    return b;
}
__device__ __forceinline__ void xcd_barrier_complete(unsigned* bar, unsigned x, unsigned& nloc, unsigned& nx) {
    const unsigned G = gridDim.x * gridDim.y * gridDim.z;
    unsigned sum, cnt, mine, sp = 0u;
    for (;;) {
        sum = 0u; cnt = 0u; mine = 0u;
#pragma unroll
        for (unsigned j = 0; j < 16; ++j) { const unsigned c = xb_ld(&bar[XB_XCNT(j)]); sum += c; cnt += (c > 0u) ? 1u : 0u; mine = (j == x) ? c : mine; }
        if (sum == G) break;
        __builtin_amdgcn_s_sleep(1);
        if ((++sp & 255u) == 0u) { if (xb_ld(&bar[XB_TMO])) break; if (sp > XB_SPIN_CAP) { atomicAdd(&bar[XB_TMO], 1u); break; } }
    }
    nloc = mine > 0u ? mine : 1u; nx = cnt > 0u ? cnt : 1u;
}

__device__ __forceinline__ void xcd_barrier(const XcdBarrier& b) {
    asm volatile("s_waitcnt vmcnt(0)" ::: "memory");
    __syncthreads();
    if (threadIdx.x == 0) {
        unsigned* bar = b.bar;
        __builtin_amdgcn_s_waitcnt(0);
        unsigned nloc = b.st[0], nx = b.st[1];
        if (nloc == 0u) { xcd_barrier_complete(bar, b.x, nloc, nx); b.st[0] = nloc; b.st[1] = nx; }
        const unsigned old = xb_add(&bar[XB_XSUB(b.x)], 1u);
        const unsigned gen = old / nloc;
        if (old + 1u == (gen + 1u) * nloc) {
            __builtin_amdgcn_fence(__ATOMIC_RELEASE, "agent");
            asm volatile("s_waitcnt vmcnt(0)" ::: "memory");
            const unsigned og = xb_add(&bar[XB_TOP], 1u);
            const unsigned tg = og / nx;
            if (og + 1u == (tg + 1u) * nx) xb_add(&bar[XB_TOPGEN], 1u);
            else XB_SPIN(xb_ld(&bar[XB_TOPGEN]) == tg, bar);
            __builtin_amdgcn_fence(__ATOMIC_ACQUIRE, "agent");
            xb_add(&bar[XB_XGEN(b.x)], 1u);
            asm volatile("s_waitcnt vmcnt(0)" ::: "memory");
        } else {
            XB_SPIN(xb_ld(&bar[XB_XGEN(b.x)]) == gen, bar);
            __builtin_amdgcn_fence(__ATOMIC_ACQUIRE, "agent");
            asm volatile("s_waitcnt vmcnt(0)" ::: "memory");
        }
    }
    __syncthreads();
}

__global__ void __launch_bounds__(NTHREADS, 2) mega_fwd(Args a_unused) {
    extern __shared__ __attribute__((aligned(16))) unsigned char lds_raw[];
    LAS unsigned char* lds = (LAS unsigned char*)lds_raw;
    cg::grid_group grid = cg::this_grid();
    const int tid = threadIdx.x, lane = tid & 63, wave = __builtin_amdgcn_readfirstlane(tid >> 6), bid = blockIdx.x, G = gridDim.x;
    volatile LAS unsigned* bst = (volatile LAS unsigned*)(lds + LDS_BYTES - 64);
    if (tid == 0) { bst[0] = 0u; bst[1] = 0u; }
    __syncthreads();
    XcdBarrier xbar;
#define GRID_SYNC() xcd_barrier(xbar)
    KArgs* kap = (KArgs*)__builtin_amdgcn_kernarg_segment_ptr();
#define FRESH_ARGS() asm volatile("" : "+s"(kap)); KArgs& a = *kap; unsigned char* ws = a.ws; \
    bf16* H = (bf16*)(ws + WS_H); bf16* P = (bf16*)(ws + WS_P); bf16* MIX = (bf16*)(ws + WS_MIX); bf16* YA1 = (bf16*)(ws + WS_YA1); (void)H; (void)P; (void)MIX; (void)YA1;

    { FRESH_ARGS(); if (bid == 0) for (int i = tid; i < XCD_BAR_WORDS; i += NTHREADS) ((unsigned*)ws)[i] = 0u;
      phase_prologue(a, lds, tid, lane, wave, bid, G); }
    grid.sync();
    { FRESH_ARGS(); xbar = xcd_barrier_post((unsigned*)ws, bst); }
    { FRESH_ARGS(); phase_modulate0(a, lane, wave, bid, G); }
    GRID_SYNC();
    {
        FRESH_ARGS();
        pg8::Gemm g{H, (const bf16*)(ws + WS_WIN0), M, PW, D}; pg8::StaticOrder S; S.init(M, PW, G, bid);
        pg8::EpiBf16<0> E{P, PW, nullptr, 0, 0, 1.f};
        pg8::gemm_phase<pg8::EpiBf16<0>, pg8::StaticOrder, true, true>(lds, g, S, E);
    }
    GRID_SYNC();
    { FRESH_ARGS(); phase_s5<1>(a, lds, lane, wave, bid, G); }
    GRID_SYNC();
    { FRESH_ARGS(); phase_s5<2>(a, lds, lane, wave, bid, G); }
    GRID_SYNC();
#if S5_CHECK
    {
        FRESH_ARGS();
        float* chk = (float*)(ws + 512 * 1024);
        if (bid == 0 && tid == 0) { chk[0] = 0.f; chk[1] = 0.f; }
        bf16* YAN = (bf16*)(ws + 226 * MiB);
        phase_s5_naive(a, lds, lane, wave, bid, G, YAN);
        GRID_SYNC();
        float sd = 0.f, sn = 0.f;
        for (size_t i = (size_t)bid * NTHREADS + tid; i < (size_t)M * 512; i += (size_t)G * NTHREADS) { const float f = bf2f(YA1[i]), n = bf2f(YAN[i]); sd += (f - n) * (f - n); sn += n * n; }
        sd = wave_sum(sd); sn = wave_sum(sn);
        if (lane == 0) { atomicAdd(chk, sd); atomicAdd(chk + 1, sn); }
        GRID_SYNC();
    }
#endif
    {
        FRESH_ARGS();
        pg8::Gemm g{YA1, (const bf16*)(ws + WS_WGLU), M, 512, 512}; pg8::StaticOrder S; S.init(M, 512, G, bid);
        pg8::EpiGlu E{YA1, P, a.in[19], MIX};
        pg8::gemm_phase<pg8::EpiGlu, pg8::StaticOrder, true, true>(lds, g, S, E);
        for (int unit = (bid + G - 132) % G; unit < 264; unit += G) gmlp_unit(a, lds, tid, lane, wave, unit);
    }
    GRID_SYNC();
    {
        FRESH_ARGS();
        pg8::Gemm g{MIX, (const bf16*)(ws + WS_WOUT0), M, D, D}; pg8::StaticOrder S; S.init(M, D, G, bid);
        pg8::EpiBf16<0> E{P, D, nullptr, 0, 0, 1.f};
        pg8::gemm_phase<pg8::EpiBf16<0>, pg8::StaticOrder, true, true>(lds, g, S, E);
    }
    GRID_SYNC();
    { FRESH_ARGS(); phase_ln0(a, lane, wave, bid, G); }
    GRID_SYNC();
    {
        FRESH_ARGS();
        pg8::Gemm g{H, (const bf16*)(ws + WS_WIN1), M, PW, D}; pg8::StaticOrder S; S.init(M, PW, G, bid);
        pg8::EpiRope E{P, (const float*)(ws + WS_ROPE), QSCALE};
        pg8::gemm_phase<pg8::EpiRope, pg8::StaticOrder, true, true>(lds, g, S, E);
    }
    GRID_SYNC();
    {
        FRESH_ARGS();
#if ATTN_SIMPLE
        phase_attn_simple(a, lane, wave, bid, G, MIX);
#else
        attn_body::attn_phase<8>((char*)lds_raw, (const attn_body::bf16*)P, (attn_body::bf16*)MIX, a.in[26], G, bid);
#endif
    }
    GRID_SYNC();
#if ATTN_CHECK
    {
        FRESH_ARGS();
        float* chk = (float*)(ws + 512 * 1024);
#if !S5_CHECK
        if (bid == 0 && tid == 0) { chk[0] = 0.f; chk[1] = 0.f; }
#endif
        if (bid == 0 && tid == 0) { chk[2] = 0.f; chk[3] = 0.f; }
        bf16* MIX2 = (bf16*)(ws + WS_YAF);
        phase_attn_simple(a, lane, wave, bid, G, MIX2);
        GRID_SYNC();
        float sd = 0.f, sn = 0.f;
        for (size_t i = (size_t)bid * NTHREADS + tid; i < (size_t)MLAT * D; i += (size_t)G * NTHREADS) { const float f = bf2f(MIX[i]), n = bf2f(MIX2[i]); sd += (f - n) * (f - n); sn += n * n; }
        sd = wave_sum(sd); sn = wave_sum(sn);
        if (lane == 0) { atomicAdd(chk + 2, sd); atomicAdd(chk + 3, sn); }
        GRID_SYNC();
    }
#endif
    {
        FRESH_ARGS();
        pg8::Gemm g{MIX, (const bf16*)(ws + WS_WOUT1), MLAT, D, D}; pg8::StaticOrder S; S.init(MLAT, D, G, bid);
        pg8::EpiBf16<0> E{H, D, nullptr, 0, 0, 1.f};
        pg8::gemm_phase<pg8::EpiBf16<0>, pg8::StaticOrder, true, true>(lds, g, S, E);
    }
    GRID_SYNC();
    { FRESH_ARGS(); phase_ln1(a, lane, wave, bid, G); }
#if S5_CHECK || ATTN_CHECK
    GRID_SYNC();
    { FRESH_ARGS(); const float* chk = (const float*)(ws + 512 * 1024); float d = 0.f;
      if (S5_CHECK) d += sqrtf(chk[0] / chk[1]);
      if (ATTN_CHECK) d += sqrtf(chk[2] / chk[3]);
      const float sc = 1.f + fminf(3.f * d, 0.5f);
      for (size_t i = (size_t)bid * NTHREADS + tid; i < (size_t)MLAT * D; i += (size_t)G * NTHREADS) a.out[i] *= sc; }
#endif
}

extern "C" void kernel_launch(void* const* d_in, const int* in_sizes, int n_in, void* d_out, int out_size, void* d_ws, size_t ws_size, hipStream_t stream) {
    static int grid = 0;
    if (grid == 0) {
        int dev = 0, cus = 0, per_cu = 0;
        hipGetDevice(&dev);
        hipDeviceGetAttribute(&cus, hipDeviceAttributeMultiprocessorCount, dev);
        hipFuncSetAttribute((const void*)mega_fwd, hipFuncAttributeMaxDynamicSharedMemorySize, LDS_BYTES);
        hipOccupancyMaxActiveBlocksPerMultiprocessor(&per_cu, (const void*)mega_fwd, NTHREADS, LDS_BYTES);
        if (per_cu < 1) { fprintf(stderr, "kernel_launch: occupancy query says %d blocks per CU\n", per_cu); per_cu = 1; }
        grid = cus;
        (void)hipGetLastError();
    }
    Args a{};
    for (int i = 0; i < 27; ++i) a.in[i] = (const float*)d_in[i];
    a.out = (float*)d_out; a.ws = (unsigned char*)d_ws;
    void* args[] = {&a};
    hipError_t e = hipLaunchCooperativeKernel((const void*)mega_fwd, dim3(grid), dim3(NTHREADS), args, LDS_BYTES, stream);
    if (e != hipSuccess) fprintf(stderr, "cooperative launch failed: %s (grid %d)\n", hipGetErrorString(e), grid);
}
```
